# Optimizing an MI355X kernel written in HIP

```python
import jax, jax.numpy as jnp
from jax import lax
import numpy as np

D_MODEL = 2048
BATCH = 16
SEQ = 256
DEPTH = 2
DEC_BATCH = 2
DEC_SEQ = 2048
PAST_LEN = 256

GRID_W = 64
ROPE_BASE = 10000.0
NORM_EPS = 1e-6
Q_BLOCK = 128
MLA_HEADS = 8
MLA_Q_LORA = 512
MLA_KV_LORA = 512
MLA_NOPE = 128
MLA_ROPE = 64
MLA_V = 128
MLA_QK = MLA_NOPE + MLA_ROPE
MLA_SCALE = MLA_QK ** -0.5
MLA_WIDTH = MLA_HEADS * MLA_V
GLA_HEADS = 4
GLA_DK = 128
GLA_DV = 256
GLA_GATE_RANK = 16
GLA_GATE_NORM = 16.0
GLA_CHUNK = 16
GLA_WIDTH = GLA_HEADS * GLA_DV
SWA_HEADS = 16
SWA_KV_HEADS = 4
SWA_GROUPS = SWA_HEADS // SWA_KV_HEADS
SWA_HEAD_DIM = 64
SWA_WINDOW = 128
SWA_SCALE = SWA_HEAD_DIM ** -0.5
SWA_WIDTH = SWA_HEADS * SWA_HEAD_DIM
D_FF = 5632
N_MOD = 9
IN_SPLITS = (MLA_Q_LORA, MLA_KV_LORA, MLA_ROPE,
             GLA_HEADS * GLA_DK, GLA_HEADS * GLA_DK, GLA_WIDTH, GLA_WIDTH, GLA_GATE_RANK, GLA_GATE_RANK,
             SWA_WIDTH, SWA_KV_HEADS * SWA_HEAD_DIM, SWA_KV_HEADS * SWA_HEAD_DIM,
             D_MODEL, D_MODEL, D_MODEL)
IN_COLS = sum(IN_SPLITS)

kernel_name = 'hybrid_mla_gla_swa_prefix_dit_step'


def rms_norm(x, g):
    xf = x.astype(jnp.float32)
    y = xf * lax.rsqrt(jnp.mean(xf * xf, axis=-1, keepdims=True) + NORM_EPS)
    return (y * g.astype(jnp.float32)).astype(x.dtype)


def adaln(cond, P):
    return jnp.split(jax.nn.silu(cond) @ P['w_ada'] + P['b_ada'], N_MOD, axis=-1)


def modulate(x, g, shift, scale):
    return rms_norm(x, g) * (1 + scale[..., None, :]) + shift[..., None, :]


def swiglu(h, w_gu, w_down):
    a, u = jnp.split(h @ w_gu, 2, axis=-1)
    return (jax.nn.silu(a) * u) @ w_down


def rope_rotate(x, pos):
    half = x.shape[-1] // 2
    inv_freq = ROPE_BASE ** (-jnp.arange(half, dtype=jnp.float32) / half)
    ang = pos.astype(jnp.float32)[:, None] * inv_freq[None, :]
    shape = (1, x.shape[1]) + (1,) * (x.ndim - 3) + (half,)
    cos = jnp.cos(ang).reshape(shape).astype(x.dtype)
    sin = jnp.sin(ang).reshape(shape).astype(x.dtype)
    x1, x2 = x[..., :half], x[..., half:]
    return jnp.concatenate([x1 * cos - x2 * sin, x1 * sin + x2 * cos], axis=-1)


def axial_rope(x):
    rows = x.shape[1] // GRID_W
    pos = jnp.arange(rows * GRID_W)
    r2 = x.shape[-1] // 2
    return jnp.concatenate([rope_rotate(x[..., :r2], pos // GRID_W),
                            rope_rotate(x[..., r2:], pos % GRID_W)], axis=-1)


def mla_rope(x):
    return jnp.concatenate([x[..., :MLA_NOPE], axial_rope(x[..., MLA_NOPE:])], axis=-1)


def block_softmax_attention(q, k, v, sink=None):
    B, Tq, Hk, G, d = q.shape
    nb = Tq // Q_BLOCK
    qb = jnp.moveaxis(q.reshape(B, nb, Q_BLOCK, Hk, G, d), 1, 0)

    def one_block(qblk):
        s = jnp.einsum('bqhgd,bkhd->bhgqk', qblk, k).astype(jnp.float32)
        if sink is not None:
            s_sink = jnp.broadcast_to(sink.astype(jnp.float32)[None, :, :, None, None], s.shape[:-1] + (1,))
            p = jax.nn.softmax(jnp.concatenate([s, s_sink], axis=-1), axis=-1)[..., :-1]
        else:
            p = jax.nn.softmax(s, axis=-1)
        return jnp.einsum('bhgqk,bkhv->bqhgv', p.astype(v.dtype), v)

    o = lax.map(one_block, qb)
    return jnp.moveaxis(o, 0, 1).reshape(B, Tq, Hk, G, v.shape[-1])


def banded_window_attention(q, k, v, k_ctx, v_ctx, sink):
    B, T, Hk, G, d = q.shape
    W = SWA_WINDOW
    nb = T // W
    L = k_ctx.shape[1]
    qb = q.reshape(B, nb, W, Hk, G, d)
    pad = ((0, 0), (W, W), (0, 0), (0, 0))
    kp = jnp.pad(k, pad).reshape(B, nb + 2, W, Hk, d)
    vp = jnp.pad(v, pad).reshape(B, nb + 2, W, Hk, d)
    kb = jnp.concatenate([kp[:, :-2], kp[:, 1:-1], kp[:, 2:]], axis=2)
    vb = jnp.concatenate([vp[:, :-2], vp[:, 1:-1], vp[:, 2:]], axis=2)
    qpos = jnp.arange(nb)[:, None] * W + jnp.arange(W)[None, :]
    kpos = jnp.arange(nb)[:, None] * W - W + jnp.arange(3 * W)[None, :]
    valid = ((kpos[:, None, :] >= 0) & (kpos[:, None, :] < T)
             & (jnp.abs(qpos[:, :, None] - kpos[:, None, :]) <= W))
    s_loc = jnp.einsum('bnqhgd,bnkhd->bnhgqk', qb, kb).astype(jnp.float32)
    s_loc = jnp.where(valid[None, :, None, None], s_loc, -jnp.inf)
    s_ctx = jnp.einsum('bnqhgd,bkhd->bnhgqk', qb, k_ctx).astype(jnp.float32)
    s_sink = jnp.broadcast_to(sink.astype(jnp.float32)[None, None, :, :, None, None], s_loc.shape[:-1] + (1,))
    p = jax.nn.softmax(jnp.concatenate([s_loc, s_ctx, s_sink], axis=-1), axis=-1)
    p_loc = p[..., :3 * W].astype(v.dtype)
    p_ctx = p[..., 3 * W:3 * W + L].astype(v.dtype)
    o = (jnp.einsum('bnhgqk,bnkhd->bnqhgd', p_loc, vb)
         + jnp.einsum('bnhgqk,bkhd->bnqhgd', p_ctx, v_ctx))
    return o.reshape(B, T, Hk, G, d)


def gla_chunked(q, k, v, log_a, s0):
    B, T, H, dk = q.shape
    C = GLA_CHUNK
    n = T // C

    def rs(a):
        return a.reshape(B, n, C, H, a.shape[-1])

    q, k, v, log_a = rs(q), rs(k), rs(v), rs(log_a)
    b = jnp.cumsum(log_a, axis=2)
    b_last = b[:, :, -1]
    causal = jnp.tril(jnp.ones((C, C), dtype=bool))
    diff = b[:, :, :, None] - b[:, :, None, :]
    decay = jnp.exp(jnp.where(causal[None, None, :, :, None, None], diff, -jnp.inf))
    A = jnp.einsum('bnthk,bnshk,bntshk->bnhts', q, k, decay)
    o_intra = jnp.einsum('bnhts,bnshv->bnthv', A, v)
    q_dec = q * jnp.exp(b)
    k_dec = k * jnp.exp(b_last[:, :, None] - b)
    a_chunk = jnp.exp(b_last)

    def step(S, xs):
        qd, kd, vv, ac = xs
        o = jnp.einsum('bthk,bhkv->bthv', qd, S)
        S = ac[..., None] * S + jnp.einsum('bthk,bthv->bhkv', kd, vv)
        return S, o

    xs = (jnp.moveaxis(q_dec, 1, 0), jnp.moveaxis(k_dec, 1, 0), jnp.moveaxis(v, 1, 0), jnp.moveaxis(a_chunk, 1, 0))
    s_fin, o_inter = lax.scan(step, s0, xs)
    o = o_intra + jnp.moveaxis(o_inter, 0, 1)
    return o.reshape(B, T, H, v.shape[-1]), s_fin


def gla_bidirectional(q, k, v, la_f, la_b, s0_f, s0_b):
    o_f, s_f = gla_chunked(q, k, v, la_f, s0_f)

    def fl(a):
        return jnp.flip(a, axis=1)

    o_b, s_b = gla_chunked(fl(q), fl(k), fl(v), fl(la_b), s0_b)
    return o_f + fl(o_b), s_f, s_b


def mla_query(cq, P):
    B, T, _ = cq.shape
    q = (rms_norm(cq, P['g_mla_q']) @ P['w_mla_uq']).reshape(B, T, MLA_HEADS, MLA_QK)
    return rms_norm(q, P['g_mla_qn'])


def mla_keys_values(c_kv, k_pe, P):
    B, L, _ = c_kv.shape
    kv = (c_kv @ P['w_mla_ukv']).reshape(B, L, MLA_HEADS, MLA_NOPE + MLA_V)
    k_nope, v = kv[..., :MLA_NOPE], kv[..., MLA_NOPE:]
    k = jnp.concatenate([k_nope, jnp.broadcast_to(k_pe[:, :, None, :], (B, L, MLA_HEADS, MLA_ROPE))], axis=-1)
    return rms_norm(k, P['g_mla_kn']), v


def swa_qkv(sq, sk, sv, P):
    B, T, _ = sq.shape
    q = rms_norm(sq.reshape(B, T, SWA_KV_HEADS, SWA_GROUPS, SWA_HEAD_DIM), P['g_swa_qn'])
    k = rms_norm(sk.reshape(B, T, SWA_KV_HEADS, SWA_HEAD_DIM), P['g_swa_kn'])
    v = sv.reshape(B, T, SWA_KV_HEADS, SWA_HEAD_DIM)
    return q, k, v


def token_mixer(h, P, ctx=None):
    B, T, _ = h.shape
    points = np.cumsum(IN_SPLITS)[:-1].tolist()
    (cq, ckv, kpe, gq, gk, gv, gout, ggf, ggb, sq, sk, sv,
     gate_mla, gate_gla, gate_swa) = jnp.split(h @ P['w_in'], points, axis=-1)
    sink = P['swa_sink'].reshape(SWA_KV_HEADS, SWA_GROUPS)
    q_m = mla_query(cq, P)
    c_kv = rms_norm(ckv, P['g_mla_kv'])
    k_m, v_m = mla_keys_values(c_kv, kpe, P)
    q_s, k_s, v_s = swa_qkv(sq, sk, sv, P)
    q_g = gq.reshape(B, T, GLA_HEADS, GLA_DK).astype(jnp.float32) * GLA_DK ** -0.5
    k_g = gk.reshape(B, T, GLA_HEADS, GLA_DK).astype(jnp.float32)
    v_g = gv.reshape(B, T, GLA_HEADS, GLA_DV).astype(jnp.float32)
    la_f = (jax.nn.log_sigmoid((ggf @ P['w_gla_gf'] + P['b_gla_gf']).astype(jnp.float32))
            / GLA_GATE_NORM).reshape(B, T, GLA_HEADS, GLA_DK)
    la_b = (jax.nn.log_sigmoid((ggb @ P['w_gla_gb'] + P['b_gla_gb']).astype(jnp.float32))
            / GLA_GATE_NORM).reshape(B, T, GLA_HEADS, GLA_DK)
    if ctx is None:
        o_mla = block_softmax_attention(q_m[:, :, :, None] * MLA_SCALE, k_m, v_m)
        o_swa = block_softmax_attention(q_s * SWA_SCALE, k_s, v_s, sink)
        s0 = jnp.zeros((B, 2, GLA_HEADS, GLA_DK, GLA_DV), jnp.float32)
    else:
        ctx_ckv, ctx_kpe, ctx_k, ctx_v, s0 = ctx
        k_mc, v_mc = mla_keys_values(ctx_ckv, ctx_kpe, P)
        o_mla = block_softmax_attention(mla_rope(q_m)[:, :, :, None] * MLA_SCALE,
                                        jnp.concatenate([mla_rope(k_m), k_mc], axis=1),
                                        jnp.concatenate([v_m, v_mc], axis=1))
        o_swa = banded_window_attention(axial_rope(q_s) * SWA_SCALE, axial_rope(k_s), v_s, ctx_k, ctx_v, sink)
    s0 = s0.astype(jnp.float32)
    o_g, s_f, s_b = gla_bidirectional(q_g, k_g, v_g, la_f, la_b, s0[:, 0], s0[:, 1])
    o_g = rms_norm(o_g.astype(h.dtype), P['g_gla_out']).reshape(B, T, GLA_WIDTH) * jax.nn.silu(gout)
    merged = (jax.nn.sigmoid(gate_mla) * (o_mla.reshape(B, T, MLA_WIDTH) @ P['w_br_mla'])
              + jax.nn.sigmoid(gate_gla) * (o_g @ P['w_br_gla'])
              + jax.nn.sigmoid(gate_swa) * (o_swa.reshape(B, T, SWA_WIDTH) @ P['w_br_swa']))
    out = merged @ P['w_out']
    if ctx is None:
        return out, (c_kv, kpe, k_s, v_s, jnp.stack([s_f, s_b], axis=1))
    return out, None


def trunk_layer(x, mod, P, ctx=None):
    sh1, sc1, gt1, sh2, sc2, gt2, sh3, sc3, gt3 = mod
    x = x + 0.5 * gt1[..., None, :] * swiglu(modulate(x, P['g_norm1'], sh1, sc1), P['w_ff1_gu'], P['w_ff1_down'])
    m, new_ctx = token_mixer(modulate(x, P['g_norm2'], sh2, sc2), P, ctx)
    x = x + gt2[..., None, :] * m
    x = x + 0.5 * gt3[..., None, :] * swiglu(modulate(x, P['g_norm3'], sh3, sc3), P['w_ff2_gu'], P['w_ff2_down'])
    return x, new_ctx


def setup_inputs(seed: int = 0) -> dict:
    key = jax.random.key(seed)
    ks = jax.random.split(key, 64)
    counter = iter(range(64))

    def nrm(shape, scale=1.0):
        return jax.random.normal(ks[next(counter)], shape, jnp.float32) * scale

    def gain(shape):
        return 1.0 + 0.02 * nrm(shape)

    return {
        'x_prompt': nrm((BATCH, SEQ, D_MODEL)),
        'x_sample': nrm((DEC_BATCH, DEC_SEQ, D_MODEL)),
        'cache_mla_ckv': nrm((DEC_BATCH, DEPTH, PAST_LEN, MLA_KV_LORA)),
        'cache_mla_kpe': nrm((DEC_BATCH, DEPTH, PAST_LEN, MLA_ROPE)),
        'cache_swa_k': nrm((DEC_BATCH, DEPTH, PAST_LEN, SWA_KV_HEADS, SWA_HEAD_DIM)),
        'cache_swa_v': nrm((DEC_BATCH, DEPTH, PAST_LEN, SWA_KV_HEADS, SWA_HEAD_DIM)),
        'state_gla': nrm((DEC_BATCH, DEPTH, 2, GLA_HEADS, GLA_DK, GLA_DV)),
        'c': nrm((DEC_BATCH, D_MODEL)),
        'c_ctx': nrm((D_MODEL,)),
        'w_ada': nrm((DEPTH, D_MODEL, N_MOD * D_MODEL), 0.5 * D_MODEL ** -0.5),
        'b_ada': nrm((DEPTH, N_MOD * D_MODEL), 0.02),
        'g_norm1': gain((DEPTH, D_MODEL)),
        'g_norm2': gain((DEPTH, D_MODEL)),
        'g_norm3': gain((DEPTH, D_MODEL)),
        'w_ff1_gu': nrm((DEPTH, D_MODEL, 2 * D_FF), D_MODEL ** -0.5),
        'w_ff1_down': nrm((DEPTH, D_FF, D_MODEL), D_FF ** -0.5),
        'w_ff2_gu': nrm((DEPTH, D_MODEL, 2 * D_FF), D_MODEL ** -0.5),
        'w_ff2_down': nrm((DEPTH, D_FF, D_MODEL), D_FF ** -0.5),
        'w_in': nrm((DEPTH, D_MODEL, IN_COLS), D_MODEL ** -0.5),
        'g_mla_q': gain((DEPTH, MLA_Q_LORA)),
        'w_mla_uq': nrm((DEPTH, MLA_Q_LORA, MLA_HEADS * MLA_QK), MLA_Q_LORA ** -0.5),
        'g_mla_kv': gain((DEPTH, MLA_KV_LORA)),
        'w_mla_ukv': nrm((DEPTH, MLA_KV_LORA, MLA_HEADS * (MLA_NOPE + MLA_V)), MLA_KV_LORA ** -0.5),
        'g_mla_qn': gain((DEPTH, MLA_QK)),
        'g_mla_kn': gain((DEPTH, MLA_QK)),
        'w_gla_gf': nrm((DEPTH, GLA_GATE_RANK, GLA_HEADS * GLA_DK), GLA_GATE_RANK ** -0.5),
        'b_gla_gf': nrm((DEPTH, GLA_HEADS * GLA_DK), 0.1),
        'w_gla_gb': nrm((DEPTH, GLA_GATE_RANK, GLA_HEADS * GLA_DK), GLA_GATE_RANK ** -0.5),
        'b_gla_gb': nrm((DEPTH, GLA_HEADS * GLA_DK), 0.1),
        'g_gla_out': gain((DEPTH, GLA_DV)),
        'g_swa_qn': gain((DEPTH, SWA_HEAD_DIM)),
        'g_swa_kn': gain((DEPTH, SWA_HEAD_DIM)),
        'swa_sink': nrm((DEPTH, SWA_HEADS)),
        'w_br_mla': nrm((DEPTH, MLA_WIDTH, D_MODEL), MLA_WIDTH ** -0.5),
        'w_br_gla': nrm((DEPTH, GLA_WIDTH, D_MODEL), GLA_WIDTH ** -0.5),
        'w_br_swa': nrm((DEPTH, SWA_WIDTH, D_MODEL), SWA_WIDTH ** -0.5),
        'w_out': nrm((DEPTH, D_MODEL, D_MODEL), D_MODEL ** -0.5),
    }


def reference(x_prompt, x_sample, cache_mla_ckv, cache_mla_kpe, cache_swa_k, cache_swa_v, state_gla,
              c, c_ctx, w_ada, b_ada, g_norm1, g_norm2, g_norm3,
              w_ff1_gu, w_ff1_down, w_ff2_gu, w_ff2_down, w_in,
              g_mla_q, w_mla_uq, g_mla_kv, w_mla_ukv, g_mla_qn, g_mla_kn,
              w_gla_gf, b_gla_gf, w_gla_gb, b_gla_gb, g_gla_out,
              g_swa_qn, g_swa_kn, swa_sink, w_br_mla, w_br_gla, w_br_swa, w_out):
    stacked = {
        'w_ada': w_ada, 'b_ada': b_ada, 'g_norm1': g_norm1, 'g_norm2': g_norm2, 'g_norm3': g_norm3,
        'w_ff1_gu': w_ff1_gu, 'w_ff1_down': w_ff1_down, 'w_ff2_gu': w_ff2_gu, 'w_ff2_down': w_ff2_down,
        'w_in': w_in, 'g_mla_q': g_mla_q, 'w_mla_uq': w_mla_uq, 'g_mla_kv': g_mla_kv,
        'w_mla_ukv': w_mla_ukv, 'g_mla_qn': g_mla_qn, 'g_mla_kn': g_mla_kn,
        'w_gla_gf': w_gla_gf, 'b_gla_gf': b_gla_gf, 'w_gla_gb': w_gla_gb, 'b_gla_gb': b_gla_gb,
        'g_gla_out': g_gla_out, 'g_swa_qn': g_swa_qn, 'g_swa_kn': g_swa_kn, 'swa_sink': swa_sink,
        'w_br_mla': w_br_mla, 'w_br_gla': w_br_gla, 'w_br_swa': w_br_swa, 'w_out': w_out,
    }
    new_ckv, new_kpe, new_sk, new_sv, new_sg = [], [], [], [], []
    y_p, y_s = x_prompt, x_sample
    for l in range(DEPTH):
        P = {name: arr[l] for name, arr in stacked.items()}
        y_p, (ckv, kpe, sk, sv, sg) = trunk_layer(y_p, adaln(c_ctx, P), P)
        new_ckv.append(ckv)
        new_kpe.append(kpe)
        new_sk.append(sk)
        new_sv.append(sv)
        new_sg.append(sg)
        ctx = (cache_mla_ckv[:, l], cache_mla_kpe[:, l], cache_swa_k[:, l], cache_swa_v[:, l], state_gla[:, l])
        y_s, _ = trunk_layer(y_s, adaln(c, P), P, ctx)
    return (y_p, y_s, jnp.stack(new_ckv, axis=1), jnp.stack(new_kpe, axis=1),
            jnp.stack(new_sk, axis=1), jnp.stack(new_sv, axis=1), jnp.stack(new_sg, axis=1))
```

```cpp
#include <hip/hip_runtime.h>
#include <cstdio>
#include <cstdint>

#define LAS __attribute__((address_space(3)))
typedef unsigned short bf16_t;
typedef short bf16x8 __attribute__((ext_vector_type(8)));
typedef float f32x4 __attribute__((ext_vector_type(4)));
typedef float f32x2 __attribute__((ext_vector_type(2)));
typedef unsigned u32x4 __attribute__((ext_vector_type(4)));
typedef unsigned u32x2 __attribute__((ext_vector_type(2)));
typedef LAS unsigned char* ldsp;

__device__ __forceinline__ unsigned cvt_pk_bf16(float lo, float hi) { unsigned r; asm volatile("v_cvt_pk_bf16_f32 %0, %1, %2" : "=v"(r) : "v"(lo), "v"(hi)); return r; }
__device__ __forceinline__ float bf_lo(unsigned w) { return __uint_as_float(w << 16); }
__device__ __forceinline__ float bf_hi(unsigned w) { return __uint_as_float(w & 0xffff0000u); }
__device__ __forceinline__ float bf1(bf16_t b) { return __uint_as_float(((unsigned)b) << 16); }
__device__ __forceinline__ bf16_t f2bf(float f) { return (bf16_t)(cvt_pk_bf16(f, 0.f) & 0xffffu); }
__device__ __forceinline__ float fast_rcp(float x) { return __builtin_amdgcn_rcpf(x); }
__device__ __forceinline__ float fast_exp2(float x) { return __builtin_amdgcn_exp2f(x); }
__device__ __forceinline__ float sigmoidf_(float a) { return fast_rcp(1.0f + fast_exp2(-1.44269504f * a)); }
__device__ __forceinline__ float siluf_(float a) { return a * sigmoidf_(a); }
__device__ __forceinline__ float wave_sum(float v) {
#pragma unroll
    for (int o = 1; o < 64; o <<= 1) v += __shfl_xor(v, o);
    return v;
}
namespace pg8 {
#define PG8_LAS __attribute__((address_space(3)))
constexpr int BM = 256, BK = 64, HALF = 128, HTB = HALF * BK * 2  , STAGE_BYTES = 8 * HTB, NXCD = 8, WGM = 8;

__host__ __device__ __forceinline__ int lds_byte(int r, int c) { const int st = (r >> 4) * 2 + (c >> 5), rr = r & 15, cc = c & 31, ob = rr * 64 + cc * 2; return st * 1024 + (ob ^ (((ob >> 9) & 1) << 5)); }
__host__ __device__ __forceinline__ void stage_rc(int b, int& R, int& C) { const int st = b / 1024, sb = b % 1024, swz = sb ^ (((sb >> 9) & 1) << 5); R = (st >> 1) * 16 + swz / 64; C = (st & 1) * 32 + (swz % 64) / 2; }
__host__ __device__ __forceinline__ int perm32(int rho) { const int n = rho >> 4, i = rho & 15; return 8 * (i >> 2) + 4 * n + (i & 3); }

template <class T> __device__ __forceinline__ T sel3(int s, T a, T b, T c) { T r = a; if (s == 1) r = b; if (s == 2) r = c; return r; }
struct Unit { int pm, pn, sub; };
__device__ __forceinline__ void tile_of(int wgid, int nwg, int nM, int nN, int& pm, int& pn) {
    { const int q = nwg / NXCD, r = nwg % NXCD, xcd = wgid % NXCD, off = wgid / NXCD; wgid = (xcd < r ? xcd * (q + 1) : r * (q + 1) + (xcd - r) * q) + off; }
    const int nig = WGM * nN, gid = wgid / nig, fm = gid * WGM, gsz = (nM - fm) < WGM ? (nM - fm) : WGM;
    pm = fm + ((wgid % nig) % gsz); pn = (wgid % nig) / gsz;
}
template <bool TILEMAJOR> struct MultiOrder {
    const bf16_t* A0; const bf16_t* A1; const bf16_t* A2; const bf16_t* B0; const bf16_t* B1; const bf16_t* B2;
    int nM0, nN0, nM1, nN1, nM2, nN2, nsub, G, c;
    __device__ __forceinline__ bool next(int i, Unit& u) const {
        if (TILEMAJOR) { const int j = i / nsub, s = i - j * nsub; const long L = (long)j * G + c; const int nwg = nM0 * nN0; if (L >= nwg) return false;
            u.sub = s; tile_of((int)L, nwg, nM0, nN0, u.pm, u.pn); return true; }
        long L = (long)i * G + c; const int w0 = nM0 * nN0, w1 = nM1 * nN1, w2 = nM2 * nN2;
        if (L < w0) { u.sub = 0; tile_of((int)L, w0, nM0, nN0, u.pm, u.pn); return true; } L -= w0;
        if (L < w1) { u.sub = 1; tile_of((int)L, w1, nM1, nN1, u.pm, u.pn); return true; } L -= w1;
        if (L < w2) { u.sub = 2; tile_of((int)L, w2, nM2, nN2, u.pm, u.pn); return true; }
        return false;
    }
    __device__ __forceinline__ const char* a_tile(const Unit& u, size_t tstep) const { const bf16_t* p = sel3<const bf16_t*>(u.sub, A0, A1, A2); return (const char*)p + (size_t)u.pm * tstep; }
    __device__ __forceinline__ const char* b_tile(const Unit& u, size_t tstep) const { const bf16_t* p = sel3<const bf16_t*>(u.sub, B0, B1, B2); return (const char*)p + (size_t)u.pn * tstep; }
    __device__ __forceinline__ void a_ready(const Unit&) const {}
    __device__ __forceinline__ void done(const Unit&) const {}
};

__device__ __forceinline__ int cond_of_tile(int pm) { return pm < 16 ? 0 : 1 + ((pm - 16) >> 3); }

struct EpiSwiglu {
    static constexpr bool PERM = true, AFTER_DRAIN = false, KEEP_ACC = false;
    bf16_t* O; int ldc; int skip;
    __device__ __forceinline__ void operator()(const f32x4 (&acc)[2][2][4][2], const Unit& u, int wr, int wc, int fr, int fq) const {
        if (skip) { asm volatile("" :: "v"(acc[0][0][0][0]), "v"(acc[1][1][3][1])); return; }
        const int row0 = u.pm * BM + wr * 64 + fr, col0 = u.pn * HALF + wc * 32 + 8 * fq;
#pragma unroll
        for (int ai = 0; ai < 2; ++ai)
#pragma unroll
            for (int m = 0; m < 4; ++m) {
                bf16_t* rowp = O + (size_t)(row0 + ai * HALF + m * 16) * ldc + col0;
                f32x4 r0, r1;
#pragma unroll
                for (int j = 0; j < 4; ++j) { r0[j] = siluf_(acc[ai][0][m][0][j]) * acc[ai][1][m][0][j]; r1[j] = siluf_(acc[ai][0][m][1][j]) * acc[ai][1][m][1][j]; }
                u32x4 w; w.x = cvt_pk_bf16(r0[0], r0[1]); w.y = cvt_pk_bf16(r0[2], r0[3]); w.z = cvt_pk_bf16(r1[0], r1[1]); w.w = cvt_pk_bf16(r1[2], r1[3]);
                *(u32x4*)rowp = w;
            }
    }
};
struct EpiResid {
    static constexpr bool PERM = false, AFTER_DRAIN = false, KEEP_ACC = false;
    float* X; const float* Xin0; const float* Xin1; const float* modl; int gidx; float coef;
    __device__ __forceinline__ void operator()(const f32x4 (&acc)[2][2][4][2], const Unit& u, int wr, int wc, int fr, int fq) const {
        const int row0 = u.pm * BM + wr * 64 + fr, col0 = u.pn * BM + wc * 32 + 4 * fq;
        const float* g = modl + cond_of_tile(u.pm) * 18432 + gidx * 2048 + col0;
        f32x4 gv[2][2];
#pragma unroll
        for (int bj = 0; bj < 2; ++bj)
#pragma unroll
            for (int n = 0; n < 2; ++n) gv[bj][n] = *(const f32x4*)(g + bj * HALF + n * 16) * coef;
#pragma unroll
        for (int ai = 0; ai < 2; ++ai)
#pragma unroll
            for (int m = 0; m < 4; ++m) { const size_t ro = (size_t)(row0 + ai * HALF + m * 16) * 2048 + col0; float* rowp = X + ro; const float* srcp = (u.pm < 16 ? Xin0 : Xin1) + ro;
#pragma unroll
                for (int bj = 0; bj < 2; ++bj)
#pragma unroll
                    for (int n = 0; n < 2; ++n) { *(f32x4*)(rowp + bj * HALF + n * 16) = *(const f32x4*)(srcp + bj * HALF + n * 16) + gv[bj][n] * acc[ai][bj][m][n]; } }
    }
};
struct EpiIn {
    static constexpr bool PERM = true, AFTER_DRAIN = false, KEEP_ACC = false;
    bf16_t* IN; float* INF; bf16_t* VT; int skip;
    __device__ __forceinline__ void operator()(const f32x4 (&acc)[2][2][4][2], const Unit& u, int wr, int wc, int fr, int fq) const {
        if (skip) { asm volatile("" :: "v"(acc[0][0][0][0]), "v"(acc[1][1][3][1])); return; }
        const int row0 = u.pm * BM + wr * 64 + fr, cin = wc * 32 + 8 * fq, pn = u.pn;
        if (u.sub == 1) {
#pragma unroll
            for (int ai = 0; ai < 2; ++ai)
#pragma unroll
                for (int m = 0; m < 4; ++m) { bf16_t* rowp = VT + (size_t)(row0 + ai * HALF + m * 16) * 8192 + pn * BM + cin;
#pragma unroll
                    for (int bj = 0; bj < 2; ++bj) { const f32x4 v0 = acc[ai][bj][m][0], v1 = acc[ai][bj][m][1];
                        u32x4 w; w.x = cvt_pk_bf16(v0[0], v0[1]); w.y = cvt_pk_bf16(v0[2], v0[3]); w.z = cvt_pk_bf16(v1[0], v1[1]); w.w = cvt_pk_bf16(v1[2], v1[3]);
                        *(u32x4*)(rowp + bj * HALF) = w; } }
            return; }
        int fbase = -1;
        if (pn == 2) fbase = 0; else if (pn == 3) fbase = 256; else if (pn == 4) fbase = 512; else if (pn == 17) fbase = 768; else if (pn == 18) fbase = 1024;
        if (fbase >= 0) {
#pragma unroll
            for (int ai = 0; ai < 2; ++ai)
#pragma unroll
                for (int m = 0; m < 4; ++m) { float* rowp = INF + (size_t)(row0 + ai * HALF + m * 16) * 1280 + fbase + cin;
#pragma unroll
                    for (int bj = 0; bj < 2; ++bj) { *(f32x4*)(rowp + bj * HALF) = acc[ai][bj][m][0]; *(f32x4*)(rowp + bj * HALF + 4) = acc[ai][bj][m][1]; } }
        } else {
#pragma unroll
            for (int ai = 0; ai < 2; ++ai)
#pragma unroll
                for (int m = 0; m < 4; ++m) { bf16_t* rowp = IN + (size_t)(row0 + ai * HALF + m * 16) * 11008 + pn * BM + cin;
#pragma unroll
                    for (int bj = 0; bj < 2; ++bj) { const f32x4 v0 = acc[ai][bj][m][0], v1 = acc[ai][bj][m][1];
                        u32x4 w; w.x = cvt_pk_bf16(v0[0], v0[1]); w.y = cvt_pk_bf16(v0[2], v0[3]); w.z = cvt_pk_bf16(v1[0], v1[1]); w.w = cvt_pk_bf16(v1[2], v1[3]);
                        *(u32x4*)(rowp + bj * HALF) = w; } }
        }
    }
};
struct EpiBf {
    static constexpr bool PERM = true, AFTER_DRAIN = false, KEEP_ACC = false;
    bf16_t* O0; bf16_t* O1; bf16_t* O2; int ld0, ld1, ld2;
    __device__ __forceinline__ void operator()(const f32x4 (&acc)[2][2][4][2], const Unit& u, int wr, int wc, int fr, int fq) const {
        const int row0 = u.pm * BM + wr * 64 + fr, col0 = u.pn * BM + wc * 32 + 8 * fq;
        bf16_t* O = sel3<bf16_t*>(u.sub, O0, O1, O2); const int ldc = sel3<int>(u.sub, ld0, ld1, ld2);
#pragma unroll
        for (int ai = 0; ai < 2; ++ai)
#pragma unroll
            for (int m = 0; m < 4; ++m) { bf16_t* rowp = O + (size_t)(row0 + ai * HALF + m * 16) * ldc + col0;
#pragma unroll
                for (int bj = 0; bj < 2; ++bj) { const f32x4 v0 = acc[ai][bj][m][0], v1 = acc[ai][bj][m][1];
                    u32x4 w; w.x = cvt_pk_bf16(v0[0], v0[1]); w.y = cvt_pk_bf16(v0[2], v0[3]); w.z = cvt_pk_bf16(v1[0], v1[1]); w.w = cvt_pk_bf16(v1[2], v1[3]);
                    *(u32x4*)(rowp + bj * HALF) = w; } }
    }
};
struct EpiBranch {
    static constexpr bool PERM = true, AFTER_DRAIN = false, KEEP_ACC = true;
    const bf16_t* gate0; int ldg; bf16_t* OUT;
    __device__ __forceinline__ float ratio(float a, float b, bool last) const {
        a = fminf(fmaxf(a, -30.f), 30.f); b = fminf(fmaxf(b, -30.f), 30.f);
        const float ia = fast_rcp(1.0f + fast_exp2(-1.44269504f * a)); return last ? ia : ia * (1.0f + fast_exp2(-1.44269504f * b)); }
    __device__ __forceinline__ void operator()(f32x4 (&acc)[2][2][4][2], const Unit& u, int wr, int wc, int fr, int fq) const {
        const int row0 = u.pm * BM + wr * 64 + fr, col0 = u.pn * BM + wc * 32 + 8 * fq; const int s = u.sub; const bool last = s == 2;
        const bf16_t* ga = gate0 + s * 2048; const bf16_t* gb = gate0 + (last ? s : s + 1) * 2048;
#pragma unroll
        for (int ai = 0; ai < 2; ++ai)
#pragma unroll
            for (int m = 0; m < 4; ++m) { const size_t row = (size_t)(row0 + ai * HALF + m * 16);
#pragma unroll
                for (int bj = 0; bj < 2; ++bj) {
                    const u32x4 wa = __builtin_nontemporal_load((const u32x4*)(ga + row * ldg + col0 + bj * HALF)), wb = __builtin_nontemporal_load((const u32x4*)(gb + row * ldg + col0 + bj * HALF));
                    f32x4 r0, r1;
                    r0[0] = ratio(bf_lo(wa.x), bf_lo(wb.x), last); r0[1] = ratio(bf_hi(wa.x), bf_hi(wb.x), last); r0[2] = ratio(bf_lo(wa.y), bf_lo(wb.y), last); r0[3] = ratio(bf_hi(wa.y), bf_hi(wb.y), last);
                    r1[0] = ratio(bf_lo(wa.z), bf_lo(wb.z), last); r1[1] = ratio(bf_hi(wa.z), bf_hi(wb.z), last); r1[2] = ratio(bf_lo(wa.w), bf_lo(wb.w), last); r1[3] = ratio(bf_hi(wa.w), bf_hi(wb.w), last);
                    const f32x4 v0 = acc[ai][bj][m][0] * r0, v1 = acc[ai][bj][m][1] * r1;
                    acc[ai][bj][m][0] = v0; acc[ai][bj][m][1] = v1;
                    if (last) { u32x4 w; w.x = cvt_pk_bf16(v0[0], v0[1]); w.y = cvt_pk_bf16(v0[2], v0[3]); w.z = cvt_pk_bf16(v1[0], v1[1]); w.w = cvt_pk_bf16(v1[2], v1[3]);
                        *(u32x4*)(OUT + row * 2048 + col0 + bj * HALF) = w; }
                } }
    }
};
template <class Epi, class Sched, bool ALIGN_EPI = false, bool SP2 = false>
__device__ __forceinline__ void gemm_phase(PG8_LAS unsigned char* lds, const int K, const Sched& S, const Epi& E) {
    int tid_ = threadIdx.x; asm volatile("" : "+v"(tid_));
    const int tid = tid_, wid = __builtin_amdgcn_readfirstlane(tid >> 6), lane = tid & 63, wr = wid >> 2, wc = wid & 3, fr = lane & 15, fq = lane >> 4;
    const int nt = K / BK;
    unsigned voffA[2], voffB[2];
#pragma unroll
    for (int i = 0; i < 2; ++i) { int R, C; stage_rc(tid * 16 + i * 8192, R, C); const int Rb = Epi::PERM ? ((R & ~31) + perm32(R & 31)) : R;
        voffA[i] = (unsigned)(R * K + C) * 2u; voffB[i] = (unsigned)(Rb * K + C) * 2u; }
    const size_t kstep = (size_t)(BK * 2);
    const size_t hstep = (size_t)HALF * K * 2;
    const size_t tstep = 2 * hstep;
    const unsigned ldsw = (unsigned)wid * 1024u;
    const int aoff = lds_byte(wr * 64 + fr, fq * 8), boff = lds_byte(wc * 32 + fr, fq * 8);
#define PG8_SA(b, h) (((b) * 2 + (h)) * HTB)
#define PG8_SB(b, h) ((4 + (b) * 2 + (h)) * HTB)
#define PG8_STAGE(bufoff, gbase, voff) do { _Pragma("unroll") for (int _i = 0; _i < 2; ++_i) \
        __builtin_amdgcn_global_load_lds((const unsigned*)((const char*)(gbase) + (voff)[_i]), (PG8_LAS unsigned*)(lds + (bufoff) + ldsw + _i * 8192), 16, 0, 0); } while (0)
#define PG8_LDA(dst, b, h) do { _Pragma("unroll") for (int m = 0; m < 4; ++m) _Pragma("unroll") for (int k = 0; k < 2; ++k) dst[m][k] = *(const PG8_LAS bf16x8*)(lds + PG8_SA(b, h) + aoff + m * 2048 + k * 1024); } while (0)
#define PG8_LDB(dst, b, h) do { _Pragma("unroll") for (int n = 0; n < 2; ++n) _Pragma("unroll") for (int k = 0; k < 2; ++k) dst[n][k] = *(const PG8_LAS bf16x8*)(lds + PG8_SB(b, h) + boff + n * 2048 + k * 1024); } while (0)
#define PG8_MMA(ai, bj, At, Bt) do { __builtin_amdgcn_s_setprio(1); _Pragma("unroll") for (int m = 0; m < 4; ++m) _Pragma("unroll") for (int n = 0; n < 2; ++n) _Pragma("unroll") for (int k = 0; k < 2; ++k) \
        acc[ai][bj][m][n] = __builtin_amdgcn_mfma_f32_16x16x32_bf16(Bt[n][k], At[m][k], acc[ai][bj][m][n], 0, 0, 0); __builtin_amdgcn_s_setprio(0); } while (0)
#define PG8_WAIT_V(n) asm volatile("s_waitcnt vmcnt(" #n ")" ::: "memory")
#define PG8_WAIT_L(n) asm volatile("s_waitcnt lgkmcnt(" #n ")" ::: "memory")
#define PG8_BAR __builtin_amdgcn_s_barrier()
#define PG8_SCHED __builtin_amdgcn_sched_barrier(0)
    Unit cur, nxt; int ui = 0;
    if (!S.next(0, cur)) return;
    f32x4 acc[2][2][4][2];
#pragma unroll
    for (int a = 0; a < 2; ++a)
#pragma unroll
        for (int b = 0; b < 2; ++b)
#pragma unroll
            for (int m = 0; m < 4; ++m)
#pragma unroll
                for (int n = 0; n < 2; ++n) acc[a][b][m][n] = (f32x4){0.f, 0.f, 0.f, 0.f};
    bf16x8 At[4][2], B0[2][2], B1[2][2];
    const char* cA = S.a_tile(cur, tstep); const char* cB = S.b_tile(cur, tstep);
    S.a_ready(cur);
    if constexpr (SP2) {
        PG8_STAGE(PG8_SB(0, 0), cB, voffB); PG8_STAGE(PG8_SB(0, 1), cB + hstep, voffB); PG8_STAGE(PG8_SA(0, 0), cA, voffA); PG8_STAGE(PG8_SA(0, 1), cA + hstep, voffA);
        if (wr == 1) PG8_BAR;
        PG8_WAIT_V(2); PG8_BAR;
        PG8_STAGE(PG8_SB(1, 0), cB + kstep, voffB); PG8_STAGE(PG8_SA(1, 0), cA + kstep, voffA); PG8_STAGE(PG8_SB(1, 1), cB + hstep + kstep, voffB);
        PG8_WAIT_V(6); PG8_BAR;
    } else {
        PG8_STAGE(PG8_SB(0, 0), cB, voffB); PG8_STAGE(PG8_SA(0, 0), cA, voffA); PG8_STAGE(PG8_SB(0, 1), cB + hstep, voffB); PG8_STAGE(PG8_SA(0, 1), cA + hstep, voffA);
        if (wr == 1) PG8_BAR;
        PG8_WAIT_V(4); PG8_BAR;
        PG8_STAGE(PG8_SB(1, 0), cB + kstep, voffB); PG8_STAGE(PG8_SA(1, 0), cA + kstep, voffA); PG8_STAGE(PG8_SB(1, 1), cB + hstep + kstep, voffB);
        PG8_WAIT_V(6); PG8_BAR;
    }
    for (;;) {
        const bool has_next = S.next(ui + 1, nxt);
        const char* nA = has_next ? S.a_tile(nxt, tstep) : cA; const char* nB = has_next ? S.b_tile(nxt, tstep) : cB;
        for (int t = 0; t < nt; t += 2) {
            const bool last = (t == nt - 2);
            const char* a1 = cA + (size_t)(t + 1) * kstep;
            const char* a2 = last ? nA : cA + (size_t)(t + 2) * kstep; const char* b2 = last ? nB : cB + (size_t)(t + 2) * kstep;
            const char* a3 = a2 + kstep; const char* b3 = b2 + kstep;
            if (last && has_next) S.a_ready(nxt);
            if constexpr (SP2) {
            PG8_LDB(B0, 0, 0); PG8_LDB(B1, 0, 1); PG8_SCHED; PG8_LDA(At, 0, 0); PG8_STAGE(PG8_SA(1, 1), a1 + hstep, voffA);
            PG8_WAIT_V(8); PG8_WAIT_L(0); PG8_BAR; PG8_MMA(0, 0, At, B0); PG8_MMA(0, 1, At, B1); PG8_BAR; PG8_SCHED;
            PG8_LDA(At, 0, 1); PG8_STAGE(PG8_SB(0, 0), b2, voffB); PG8_STAGE(PG8_SB(0, 1), b2 + hstep, voffB); PG8_STAGE(PG8_SA(0, 0), a2, voffA);
            PG8_WAIT_V(8); PG8_WAIT_L(0); PG8_BAR; PG8_MMA(1, 0, At, B0); PG8_MMA(1, 1, At, B1); PG8_BAR; PG8_SCHED;
            PG8_LDB(B0, 1, 0); PG8_LDB(B1, 1, 1); PG8_SCHED; PG8_LDA(At, 1, 0); PG8_STAGE(PG8_SA(0, 1), a2 + hstep, voffA);
            PG8_WAIT_V(8); PG8_WAIT_L(0); PG8_BAR; PG8_MMA(0, 0, At, B0); PG8_MMA(0, 1, At, B1); PG8_BAR; PG8_SCHED;
            PG8_LDA(At, 1, 1); PG8_STAGE(PG8_SB(1, 0), b3, voffB); PG8_STAGE(PG8_SB(1, 1), b3 + hstep, voffB); PG8_STAGE(PG8_SA(1, 0), a3, voffA);
            PG8_WAIT_V(8); PG8_WAIT_L(0); PG8_BAR; PG8_MMA(1, 0, At, B0); PG8_MMA(1, 1, At, B1); PG8_BAR; PG8_SCHED;
            } else {
            PG8_LDB(B0, 0, 0); PG8_SCHED; PG8_LDA(At, 0, 0); PG8_STAGE(PG8_SA(1, 1), a1 + hstep, voffA);
            PG8_WAIT_L(8); PG8_BAR; PG8_WAIT_L(0); PG8_MMA(0, 0, At, B0); PG8_BAR; PG8_SCHED;
            PG8_LDB(B1, 0, 1); PG8_STAGE(PG8_SB(0, 0), b2, voffB);
            PG8_BAR; PG8_WAIT_L(0); PG8_MMA(0, 1, At, B1); PG8_BAR;
            PG8_LDA(At, 0, 1); PG8_STAGE(PG8_SA(0, 0), a2, voffA);
            PG8_BAR; PG8_WAIT_L(0); PG8_MMA(1, 0, At, B0); PG8_BAR; PG8_SCHED;
            PG8_STAGE(PG8_SB(0, 1), b2 + hstep, voffB);
            PG8_WAIT_V(6); PG8_BAR; PG8_MMA(1, 1, At, B1); PG8_BAR;
            PG8_LDB(B0, 1, 0); PG8_SCHED; PG8_LDA(At, 1, 0); PG8_STAGE(PG8_SA(0, 1), a2 + hstep, voffA);
            PG8_WAIT_L(8); PG8_BAR; PG8_WAIT_L(0); PG8_MMA(0, 0, At, B0); PG8_BAR; PG8_SCHED;
            PG8_LDB(B1, 1, 1); PG8_STAGE(PG8_SB(1, 0), b3, voffB);
            PG8_BAR; PG8_WAIT_L(0); PG8_MMA(0, 1, At, B1); PG8_BAR;
            PG8_LDA(At, 1, 1); PG8_STAGE(PG8_SA(1, 0), a3, voffA);
            PG8_BAR; PG8_WAIT_L(0); PG8_MMA(1, 0, At, B0); PG8_BAR; PG8_SCHED;
            PG8_STAGE(PG8_SB(1, 1), b3 + hstep, voffB);
            PG8_WAIT_V(6); PG8_BAR; PG8_MMA(1, 1, At, B1); PG8_BAR;
            }
        }
        if constexpr (ALIGN_EPI) { if (wr == 0) PG8_BAR; }
        if constexpr (!Epi::AFTER_DRAIN) { E(acc, cur, wr, wc, fr, fq); S.done(cur); }
        if (!has_next) break;
        if (!(Epi::KEEP_ACC && nxt.sub != 0)) {
#pragma unroll
        for (int a = 0; a < 2; ++a)
#pragma unroll
            for (int b = 0; b < 2; ++b)
#pragma unroll
                for (int m = 0; m < 4; ++m)
#pragma unroll
                    for (int n = 0; n < 2; ++n) acc[a][b][m][n] = (f32x4){0.f, 0.f, 0.f, 0.f};
        }
        cur = nxt; cA = nA; cB = nB; ++ui;
        if constexpr (ALIGN_EPI) { if (wr == 1) PG8_BAR; }
    }
    PG8_WAIT_V(0);
    if constexpr (!ALIGN_EPI) { if (wr == 0) PG8_BAR; }
    PG8_BAR;
    if constexpr (Epi::AFTER_DRAIN) { E.fused(acc, cur, wr, wc, fr, fq, lds, wid, lane); S.done(cur); }
#undef PG8_SA
#undef PG8_SB
#undef PG8_STAGE
#undef PG8_LDA
#undef PG8_LDB
#undef PG8_MMA
#undef PG8_WAIT_V
#undef PG8_WAIT_L
#undef PG8_BAR
#undef PG8_SCHED
}
}

constexpr int NWAVES = 8, NTHR = 512;
constexpr int D = 2048, MROWS = 8192, MPROMPT = 4096, DFF = 5632, NGU = 11264, NMOD = 18432;
constexpr int NIN = 11008, LDF = 1280, NSW = 1280, MKV = 8704;
constexpr int C_CQ = 0, C_GQ = 1280, C_GK = 1792, C_GOUT = 2304, C_SQ = 3328, C_GATE = 4864;
constexpr int F_CKV = 0, F_KPE = 512, F_GG = 576, F_SK = 768, F_SV = 1024;
constexpr float EPS = 1e-6f, LOG2E = 1.4426950408889634f;
constexpr float MLA_QSCALE = 0.07216878364870322f * LOG2E;
constexpr float SWA_QSCALE = 0.125f * LOG2E;
constexpr float GLA_QSCALE = 0.08838834764831845f;
constexpr size_t O_X = 0, O_CKV = 16777216, O_KPE = 20971520, O_SK = 21495808, O_SV = 23592960, O_SG = 25690112, O_END = 34078720;
constexpr size_t al4k(size_t x) { return (x + 4095) & ~(size_t)4095; }
constexpr size_t WS_CTL = 0, SZ_CTL = 1u << 20;
constexpr size_t WS_MOD = WS_CTL + SZ_CTL;                 constexpr size_t SZ_MOD = al4k((size_t)2 * 3 * NMOD * 4);
constexpr size_t WS_ROPE = WS_MOD + SZ_MOD;                constexpr size_t SZ_ROPE = al4k(2 * 1024 * 4);
constexpr size_t WS_DEC = WS_ROPE + SZ_ROPE;               constexpr size_t SZ_DEC = al4k((size_t)128 * 2 * 512 * 4);
constexpr size_t WS_WGU1 = WS_DEC + SZ_DEC;                constexpr size_t SZ_WGU = (size_t)NGU * D * 2;
constexpr size_t WS_WD1 = WS_WGU1 + SZ_WGU;                constexpr size_t SZ_WD = (size_t)D * DFF * 2;
constexpr size_t WS_WGU2 = WS_WD1 + SZ_WD;
constexpr size_t WS_WD2 = WS_WGU2 + SZ_WGU;
constexpr size_t WS_WIN = WS_WD2 + SZ_WD;                  constexpr size_t SZ_WIN = (size_t)NIN * D * 2;
constexpr size_t WS_WINS = WS_WIN + SZ_WIN;                constexpr size_t SZ_WINS = (size_t)NSW * D * 2;
constexpr size_t WS_WUQ = WS_WINS + SZ_WINS;               constexpr size_t SZ_WUQ = (size_t)1536 * 512 * 2;
constexpr size_t WS_WUK = WS_WUQ + SZ_WUQ;                 constexpr size_t SZ_WUK = (size_t)1024 * 512 * 2;
constexpr size_t WS_WUV = WS_WUK + SZ_WUK;
constexpr size_t WS_WBR = WS_WUV + SZ_WUK;                 constexpr size_t SZ_WBR = (size_t)2048 * 1024 * 2;
constexpr size_t WS_WOUT = WS_WBR + 3 * SZ_WBR;            constexpr size_t SZ_WOUT = (size_t)2048 * 2048 * 2;
constexpr size_t SZ_WLAYER = WS_WOUT + SZ_WOUT - WS_WGU1;
constexpr size_t WS_H = WS_WGU1 + 2 * SZ_WLAYER;                 constexpr size_t SZ_H = (size_t)MROWS * D * 2;
constexpr size_t WS_ACT = WS_H + SZ_H;                     constexpr size_t SZ_ACT = (size_t)MROWS * DFF * 2;
constexpr size_t WS_MF = WS_ACT;                           constexpr size_t SZ_MF = (size_t)MROWS * 2048 * 4;
constexpr size_t WS_QRAW = WS_MF + SZ_MF;                  constexpr size_t SZ_QRAW = (size_t)MROWS * 1536 * 2;
static_assert(SZ_MF + SZ_QRAW <= SZ_ACT, "alias");
constexpr size_t WS_IN = WS_ACT + SZ_ACT;                  constexpr size_t SZ_IN = (size_t)MROWS * NIN * 2;
constexpr size_t WS_INF = WS_IN + SZ_IN;                   constexpr size_t SZ_INF = (size_t)MROWS * LDF * 4;
constexpr size_t WS_VT = WS_INF + SZ_INF;                  constexpr size_t SZ_VT = (size_t)NSW * MROWS * 2;
constexpr size_t WS_CQN = WS_VT + SZ_VT;                   constexpr size_t SZ_CQN = (size_t)MROWS * 512 * 2;
constexpr size_t WS_CKVN = WS_CQN + SZ_CQN;                constexpr size_t SZ_CKVN = (size_t)MKV * 512 * 2;
constexpr size_t WS_KNRAW = WS_CKVN + SZ_CKVN;             constexpr size_t SZ_KNRAW = (size_t)MKV * 1024 * 2;
constexpr size_t WS_QM = WS_KNRAW + SZ_KNRAW;              constexpr size_t SZ_QM = (size_t)MROWS * 1536 * 2;
constexpr size_t WS_KM = WS_QM + SZ_QM;                    constexpr size_t SZ_KM = (size_t)MKV * 1536 * 2;
constexpr size_t WS_VMT = WS_KM + SZ_KM;                   constexpr size_t SZ_VMT = (size_t)1024 * MKV * 2;
constexpr size_t WS_QS = WS_VMT + SZ_VMT;                  constexpr size_t SZ_QS = (size_t)MROWS * 1024 * 2;
constexpr size_t WS_KS = WS_QS + SZ_QS;                    constexpr size_t SZ_KS = (size_t)MKV * 256 * 2;
constexpr size_t WS_VSCT = WS_KS + SZ_KS;                  constexpr size_t SZ_VSCT = (size_t)2 * 256 * 256 * 2;
constexpr size_t WS_QG = WS_VSCT + SZ_VSCT;                constexpr size_t SZ_G1 = (size_t)MROWS * 512 * 2;
constexpr size_t WS_KG = WS_QG + 2 * SZ_G1;
constexpr size_t WS_KHT = WS_KG + 2 * SZ_G1;
constexpr size_t WS_OG = WS_KHT + 2 * SZ_G1;               constexpr size_t SZ_OG1 = (size_t)MROWS * 1024 * 4;
constexpr size_t WS_OMLA = WS_OG + 2 * SZ_OG1;             constexpr size_t SZ_O = (size_t)MROWS * 1024 * 2;
constexpr size_t WS_OGN = WS_OMLA + SZ_O;
constexpr size_t WS_OSWA = WS_OGN + SZ_O;
constexpr size_t WS_END = WS_OSWA + SZ_O;
static_assert(WS_END < (size_t)1150 * 1024 * 1024, "workspace budget");
constexpr int CW_BAR = 4096, CW_QUEUE = 16384, CW_PANEL = 32768;
constexpr int LDS_MISC = 131072, LDS_BYTES = 147456;

#define XB_TMO      128
#define XB_XCNT(j)  (256  + 64 * (j))
#define XB_XSUB(j)  (1280 + 64 * (j))
#define XB_XGEN(j)  (2304 + 64 * (j))
#define XB_TOP      3328
#define XB_TOPGEN   3392
#define XCD_BAR_WORDS 3456
#define XB_SPIN_CAP (1u << 18)
__device__ __forceinline__ unsigned xb_ld(unsigned* p)              { return __hip_atomic_load(p, __ATOMIC_RELAXED, __HIP_MEMORY_SCOPE_AGENT); }
__device__ __forceinline__ unsigned xb_add(unsigned* p, unsigned v) { return __hip_atomic_fetch_add(p, v, __ATOMIC_RELAXED, __HIP_MEMORY_SCOPE_AGENT); }
__device__ __forceinline__ unsigned xb_xcc_id() { return (unsigned)__builtin_amdgcn_s_getreg((3 << 11) | 20) & 0xFu; }
#define XB_SPIN(cond, bar) do { unsigned _sp = 0; while (cond) { __builtin_amdgcn_s_sleep(1); \
    if ((++_sp & 255u) == 0u) { if (xb_ld(&(bar)[XB_TMO])) break; if (_sp > XB_SPIN_CAP) { atomicAdd(&(bar)[XB_TMO], 1u); break; } } } } while (0)
struct XcdBarrier { unsigned* bar; unsigned x; volatile LAS unsigned* st; };
__device__ __forceinline__ XcdBarrier xcd_barrier_post(unsigned* bar, volatile LAS unsigned* st) {
    XcdBarrier b; b.bar = bar; b.x = xb_xcc_id(); b.st = st;
    if (threadIdx.x == 0) (void)xb_add(&bar[XB_XCNT(b.x)], 1u);
    return b;
}
__device__ __forceinline__ void xcd_barrier_complete(unsigned* bar, unsigned x, unsigned& nloc, unsigned& nx) {
    const unsigned G = gridDim.x * gridDim.y * gridDim.z;
    unsigned sum, cnt, mine, sp = 0u;
    for (;;) {
        sum = 0u; cnt = 0u; mine = 0u;
#pragma unroll
        for (unsigned j = 0; j < 16; ++j) { const unsigned c = xb_ld(&bar[XB_XCNT(j)]); sum += c; cnt += (c > 0u) ? 1u : 0u; mine = (j == x) ? c : mine; }
        if (sum == G) break;
        __builtin_amdgcn_s_sleep(1);
        if ((++sp & 255u) == 0u) { if (xb_ld(&bar[XB_TMO])) break; if (sp > XB_SPIN_CAP) { atomicAdd(&bar[XB_TMO], 1u); break; } }
    }
    nloc = mine > 0u ? mine : 1u; nx = cnt > 0u ? cnt : 1u;
}
__device__ __forceinline__ void xcd_barrier(const XcdBarrier& b) {
    asm volatile("s_waitcnt vmcnt(0)" ::: "memory");
    __syncthreads();
    if (threadIdx.x == 0) {
        unsigned* bar = b.bar;
        __builtin_amdgcn_s_waitcnt(0);
        unsigned nloc = b.st[0], nx = b.st[1];
        if (nloc == 0u) { xcd_barrier_complete(bar, b.x, nloc, nx); b.st[0] = nloc; b.st[1] = nx; }
        const unsigned old = xb_add(&bar[XB_XSUB(b.x)], 1u);
        const unsigned gen = old / nloc;
        if (old + 1u == (gen + 1u) * nloc) {
            __builtin_amdgcn_fence(__ATOMIC_RELEASE, "agent");
            asm volatile("s_waitcnt vmcnt(0)" ::: "memory");
            const unsigned og = xb_add(&bar[XB_TOP], 1u);
            const unsigned tg = og / nx;
            if (og + 1u == (tg + 1u) * nx) xb_add(&bar[XB_TOPGEN], 1u);
            else XB_SPIN(xb_ld(&bar[XB_TOPGEN]) == tg, bar);
            __builtin_amdgcn_fence(__ATOMIC_ACQUIRE, "agent");
            xb_add(&bar[XB_XGEN(b.x)], 1u);
            asm volatile("s_waitcnt vmcnt(0)" ::: "memory");
        } else {
            XB_SPIN(xb_ld(&bar[XB_XGEN(b.x)]) == gen, bar);
            __builtin_amdgcn_fence(__ATOMIC_ACQUIRE, "agent");
            asm volatile("s_waitcnt vmcnt(0)" ::: "memory");
        }
    }
    __syncthreads();
}

struct Ctx {
    const float* const* in; float* out; unsigned char* ws; ldsp lds;
    int tid, lane, wave, G, bid, l;
};
#define WSP(T, off) ((T*)(C.ws + (off)))
#define LIN(i, per) (C.in[i] + (size_t)C.l * (per))

template <int KIND> __device__ __forceinline__ int rowmap(int j) {
    if (KIND == 0) return j;
    if (KIND == 1) { const int p = j >> 8, q = j & 255; return q < 128 ? 128 * p + q : DFF + 128 * p + (q - 128); }
    if (KIND == 2) {
        if (j < 1024) return j;
        if (j < 1280) { const int m = j - 1024; return m < 64 ? 1024 + m : (m < 96 ? 4160 + (m - 64) : -1); }
        if (j < 1792) return 1088 + (j - 1280);
        if (j < 2304) return 1600 + (j - 1792);
        if (j < 3328) return 3136 + (j - 2304);
        if (j < 4352) return 4192 + (j - 3328);
        if (j < 4608) return 5216 + (j - 4352);
        if (j < 4864) return 5472 + (j - 4608);
        return 5728 + (j - 4864);
    }
    if (KIND == 3) return j < 1024 ? 2112 + j : 5472 + (j - 1024);
    if (KIND == 4) return (j >> 7) * 256 + (j & 127);
    return (j >> 7) * 256 + 128 + (j & 127);
}
template <int KIND> __device__ __forceinline__ void conv_item(const float* __restrict__ src, bf16_t* __restrict__ dst, int K, int N, int item, int tid) {
    const int nkb = K >> 8, jb = item / nkb, kb = item - jb * nkb, lane = tid & 63, w = tid >> 6;
    const int j = jb * 256 + lane * 4, sc = rowmap<KIND>(j);
#pragma unroll
    for (int hh = 0; hh < 2; ++hh) { const int k0 = kb * 256 + w * 32 + hh * 16;
        f32x4 v[16];
        if (sc >= 0) { const float* p = src + (size_t)k0 * N + sc;
#pragma unroll
            for (int i = 0; i < 16; ++i) v[i] = __builtin_nontemporal_load((const f32x4*)(p + (size_t)i * N)); }
        else {
#pragma unroll
            for (int i = 0; i < 16; ++i) v[i] = (f32x4){0.f, 0.f, 0.f, 0.f}; }
#pragma unroll
        for (int jj = 0; jj < 4; ++jj) { bf16_t* o = dst + (size_t)(j + jj) * K + k0;
#pragma unroll
            for (int g = 0; g < 2; ++g) { u32x4 wv; wv.x = cvt_pk_bf16(v[g * 8 + 0][jj], v[g * 8 + 1][jj]); wv.y = cvt_pk_bf16(v[g * 8 + 2][jj], v[g * 8 + 3][jj]); wv.z = cvt_pk_bf16(v[g * 8 + 4][jj], v[g * 8 + 5][jj]); wv.w = cvt_pk_bf16(v[g * 8 + 6][jj], v[g * 8 + 7][jj]);
                *(u32x4*)(o + g * 8) = wv; } } }
}
constexpr int I_GU = (NGU / 256) * 8, I_DN = (2048 / 256) * 22, I_IN = (NIN / 256) * 8, I_INS = (NSW / 256) * 8, I_UQ = 6 * 2, I_UK = 4 * 2, I_BR = 8 * 4, I_OUT = 8 * 8;
constexpr int NCONV_A = 2 * I_GU + I_DN, NCONV_B = I_DN + I_IN + I_INS + I_UQ + 2 * I_UK + 3 * I_BR + I_OUT;
#define LINW(i, per) (C.in[i] + (size_t)lw * (per))
#define WSW(off) ((bf16_t*)(C.ws + (off) + (size_t)lw * SZ_WLAYER))
__device__ __forceinline__ void conv_dispatch(const Ctx& C, const int lw, const int win, int r, const int tid) {
    if (win == 0) {
        if (r < I_GU) { conv_item<1>(LINW(14, (size_t)2048 * NGU), WSW(WS_WGU1), 2048, NGU, r, tid); return; } r -= I_GU;
        if (r < I_GU) { conv_item<1>(LINW(16, (size_t)2048 * NGU), WSW(WS_WGU2), 2048, NGU, r, tid); return; } r -= I_GU;
        conv_item<0>(LINW(17, (size_t)DFF * 2048), WSW(WS_WD2), DFF, 2048, r, tid); return;
    }
    if (r < I_DN) { conv_item<0>(LINW(15, (size_t)DFF * 2048), WSW(WS_WD1), DFF, 2048, r, tid); return; } r -= I_DN;
    if (r < I_IN) { conv_item<2>(LINW(18, (size_t)2048 * 11872), WSW(WS_WIN), 2048, 11872, r, tid); return; } r -= I_IN;
    if (r < I_INS) { conv_item<3>(LINW(18, (size_t)2048 * 11872), WSW(WS_WINS), 2048, 11872, r, tid); return; } r -= I_INS;
    if (r < I_UQ) { conv_item<0>(LINW(20, (size_t)512 * 1536), WSW(WS_WUQ), 512, 1536, r, tid); return; } r -= I_UQ;
    if (r < I_UK) { conv_item<4>(LINW(22, (size_t)512 * 2048), WSW(WS_WUK), 512, 2048, r, tid); return; } r -= I_UK;
    if (r < I_UK) { conv_item<5>(LINW(22, (size_t)512 * 2048), WSW(WS_WUV), 512, 2048, r, tid); return; } r -= I_UK;
    if (r < I_BR) { conv_item<0>(LINW(33, (size_t)1024 * 2048), WSW(WS_WBR), 1024, 2048, r, tid); return; } r -= I_BR;
    if (r < I_BR) { conv_item<0>(LINW(34, (size_t)1024 * 2048), WSW(WS_WBR + SZ_WBR), 1024, 2048, r, tid); return; } r -= I_BR;
    if (r < I_BR) { conv_item<0>(LINW(35, (size_t)1024 * 2048), WSW(WS_WBR + 2 * SZ_WBR), 1024, 2048, r, tid); return; } r -= I_BR;
    conv_item<0>(LINW(36, (size_t)2048 * 2048), WSW(WS_WOUT), 2048, 2048, r, tid);
}
__device__ __forceinline__ void conv_queue(const Ctx& C, const int lw, const int win, const int q, const int maxitems) {
    unsigned* head = WSP(unsigned, WS_CTL) + CW_QUEUE + 64 * q; volatile LAS int* slot = (volatile LAS int*)(C.lds + LDS_MISC + 16);
    const int n = win == 0 ? NCONV_A : NCONV_B;
    for (int cnt = 0; cnt < maxitems; ++cnt) {
        __syncthreads();
        if (C.tid == 0) *slot = (int)__hip_atomic_fetch_add(head, 1u, __ATOMIC_RELAXED, __HIP_MEMORY_SCOPE_AGENT);
        __syncthreads();
        const int it = *slot;
        if (it >= n) break;
        int tid = C.tid; asm volatile("" : "+v"(tid));
        conv_dispatch(C, lw, win, it, tid);
    }
}
__device__ __forceinline__ void phase_prep(const Ctx& C) {
    const int tid = C.tid, lane = C.lane, w = C.wave;
    LAS float* sc = (LAS float*)C.lds; LAS float* red = (LAS float*)(C.lds + 24576);
    for (int i = tid; i < 3 * 2048; i += NTHR) { const int c = i >> 11, k = i & 2047; const float v = (c == 0) ? C.in[8][k] : C.in[7][(c - 1) * 2048 + k]; sc[i] = siluf_(v); }
    __syncthreads();
    constexpr int I_ADA = 2 * (NMOD / 64);
    for (int it = C.bid; it < I_ADA + NCONV_A; it += C.G) {
        if (it < I_ADA) {
            const int la = it / (NMOD / 64), r = it - la * (NMOD / 64);
            const float* Wada = C.in[9] + (size_t)la * 2048 * NMOD; const float* bada = C.in[10] + (size_t)la * NMOD; float* modl = WSP(float, WS_MOD) + (size_t)la * 3 * NMOD;
            const int col = r * 64 + lane; float a0 = 0.f, a1 = 0.f, a2 = 0.f; const float* p = Wada + (size_t)(w * 256) * NMOD + col;
            for (int k = 0; k < 256; k += 32) { float wv[32];
#pragma unroll
                for (int i = 0; i < 32; ++i) wv[i] = __builtin_nontemporal_load(p + (size_t)(k + i) * NMOD);
#pragma unroll
                for (int i = 0; i < 32; ++i) { const int kk = w * 256 + k + i; a0 += sc[kk] * wv[i]; a1 += sc[2048 + kk] * wv[i]; a2 += sc[4096 + kk] * wv[i]; } }
            red[(w * 3 + 0) * 64 + lane] = a0; red[(w * 3 + 1) * 64 + lane] = a1; red[(w * 3 + 2) * 64 + lane] = a2;
            __syncthreads();
            if (w < 3) { float s = bada[col]; for (int ww = 0; ww < 8; ++ww) s += red[(ww * 3 + w) * 64 + lane]; modl[w * NMOD + col] = s; }
            __syncthreads();
            continue; }
        conv_dispatch(C, 0, 0, it - I_ADA, tid);
    }
    if (C.bid == 0) { float* rp = WSP(float, WS_ROPE);
        for (int i = tid; i < 1024; i += NTHR) { const int pos = i >> 4, f = i & 15; const float inv = fast_exp2(-(float)f * (13.287712379549449f / 16.0f));
            float rev = (float)pos * inv * 0.15915494309189535f; rev -= floorf(rev);
            rp[i] = __builtin_amdgcn_cosf(rev); rp[1024 + i] = __builtin_amdgcn_sinf(rev); } }
}

__device__ __forceinline__ void phase_norm(const Ctx& C, int gin, int mi, bool from_input) {
    const float* g = LIN(gin, D); const float* modl = WSP(float, WS_MOD) + (size_t)C.l * 3 * NMOD; bf16_t* H = WSP(bf16_t, WS_H);
    const int lane = C.lane; const float* x0 = from_input ? C.in[0] : C.out; const float* x1 = from_input ? C.in[1] - (size_t)MPROMPT * D : C.out;
    constexpr int U = 4;
    for (int q = C.bid * NWAVES + C.wave; q < MROWS / U; q += C.G * NWAVES) {
        const int r = U * q; const int c = r < MPROMPT ? 0 : 1 + ((r - MPROMPT) >> 11);
        const float* sh = modl + c * NMOD + (3 * mi) * 2048; const float* scl = sh + 2048;
        const f32x4* xr = (const f32x4*)((r < MPROMPT ? x0 : x1) + (size_t)r * D) + lane;
        f32x4 v[U][8]; float ss[U];
#pragma unroll
        for (int u = 0; u < U; ++u)
#pragma unroll
            for (int j = 0; j < 8; ++j) v[u][j] = __builtin_nontemporal_load(xr + u * 512 + 64 * j);
#pragma unroll
        for (int u = 0; u < U; ++u) { ss[u] = 0.f;
#pragma unroll
            for (int j = 0; j < 8; ++j) ss[u] += (v[u][j][0] * v[u][j][0] + v[u][j][1] * v[u][j][1]) + (v[u][j][2] * v[u][j][2] + v[u][j][3] * v[u][j][3]); }
#pragma unroll
        for (int o = 1; o < 64; o <<= 1) {
#pragma unroll
            for (int u = 0; u < U; ++u) ss[u] += __shfl_xor(ss[u], o); }
        float rs[U];
#pragma unroll
        for (int u = 0; u < U; ++u) rs[u] = rsqrtf(ss[u] * (1.0f / D) + EPS);
        u32x2* o = (u32x2*)(H + (size_t)r * D) + lane;
#pragma unroll
        for (int j = 0; j < 8; ++j) { const int col = 4 * lane + 256 * j; const f32x4 gg = *(const f32x4*)(g + col), s1 = *(const f32x4*)(scl + col), s0 = *(const f32x4*)(sh + col);
            f32x4 gm;
#pragma unroll
            for (int e = 0; e < 4; ++e) gm[e] = gg[e] * (1.0f + s1[e]);
#pragma unroll
            for (int u = 0; u < U; ++u) { const f32x4 y = v[u][j] * rs[u] * gm + s0; u32x2 w; w.x = cvt_pk_bf16(y[0], y[1]); w.y = cvt_pk_bf16(y[2], y[3]); o[u * 512 + 64 * j] = w; } }
    }
}

__device__ __forceinline__ float logsig16(float z) { return (fminf(z, 0.f) - __logf(1.0f + __expf(-fabsf(z)))) * (1.0f / 16.0f); }
__device__ __forceinline__ void prepa_gla_item(const Ctx& C, int chunk, int h) {
    const int tid = C.tid, l = C.l, k = tid & 127, tq = tid >> 7, r0 = chunk * 64;
    LAS float* gg = (LAS float*)C.lds; LAS float* tot = (LAS float*)(C.lds + 8192);
    const float* INF = WSP(float, WS_INF); const bf16_t* IN = WSP(bf16_t, WS_IN);
    { const int idx = tid * 4, t = idx >> 5, j = idx & 31; *(LAS f32x4*)(gg + idx) = *(const f32x4*)(INF + (size_t)(r0 + t) * LDF + F_GG + j); }
    __syncthreads();
    const float* wgf = LIN(25, 16 * 512) + h * 128 + k; const float* wgb = LIN(27, 16 * 512) + h * 128 + k;
    float wf[16], wb[16];
#pragma unroll
    for (int j = 0; j < 16; ++j) { wf[j] = wgf[j * 512]; wb[j] = wgb[j * 512]; }
    const float bfv = LIN(26, 512)[h * 128 + k], bbv = LIN(28, 512)[h * 128 + k];
    float cf[16], cb[16];
#pragma unroll
    for (int i = 0; i < 16; ++i) { const LAS float* gr = gg + (tq * 16 + i) * 32; float zf = bfv, zb = bbv;
#pragma unroll
        for (int j = 0; j < 16; ++j) { zf += gr[j] * wf[j]; zb += gr[16 + j] * wb[j]; }
        cf[i] = logsig16(zf); cb[i] = logsig16(zb); }
#pragma unroll
    for (int i = 1; i < 16; ++i) cf[i] += cf[i - 1];
#pragma unroll
    for (int i = 14; i >= 0; --i) cb[i] += cb[i + 1];
    tot[(0 * 4 + tq) * 128 + k] = cf[15]; tot[(1 * 4 + tq) * 128 + k] = cb[0];
    __syncthreads();
    float off_f = 0.f, off_b = 0.f, bl_f = 0.f, bl_b = 0.f;
#pragma unroll
    for (int q = 0; q < 4; ++q) { const float tf = tot[q * 128 + k], tb = tot[(4 + q) * 128 + k]; bl_f += tf; bl_b += tb; if (q < tq) off_f += tf; if (q > tq) off_b += tb; }
    bf16_t* QG0 = WSP(bf16_t, WS_QG); bf16_t* QG1 = WSP(bf16_t, WS_QG + SZ_G1); bf16_t* KG0 = WSP(bf16_t, WS_KG); bf16_t* KG1 = WSP(bf16_t, WS_KG + SZ_G1);
    bf16_t* KHT0 = WSP(bf16_t, WS_KHT); bf16_t* KHT1 = WSP(bf16_t, WS_KHT + SZ_G1);
    float khf[16], khb[16];
#pragma unroll
    for (int i = 0; i < 16; ++i) { const size_t r = (size_t)(r0 + tq * 16 + i);
        const float q = bf1(IN[r * NIN + C_GQ + h * 128 + k]) * GLA_QSCALE, kk = bf1(IN[r * NIN + C_GK + h * 128 + k]);
        const float bf_ = off_f + cf[i], bb_ = off_b + cb[i];
        const size_t o = r * 512 + h * 128 + k;
        QG0[o] = f2bf(q * __expf(bf_)); KG0[o] = f2bf(kk * __expf(-bf_)); khf[i] = kk * __expf(bl_f - bf_);
        QG1[o] = f2bf(q * __expf(bb_)); KG1[o] = f2bf(kk * __expf(-bb_)); khb[i] = kk * __expf(bl_b - bb_); }
    { u32x4 a, b; a.x = cvt_pk_bf16(khf[0], khf[1]); a.y = cvt_pk_bf16(khf[2], khf[3]); a.z = cvt_pk_bf16(khf[4], khf[5]); a.w = cvt_pk_bf16(khf[6], khf[7]);
      b.x = cvt_pk_bf16(khf[8], khf[9]); b.y = cvt_pk_bf16(khf[10], khf[11]); b.z = cvt_pk_bf16(khf[12], khf[13]); b.w = cvt_pk_bf16(khf[14], khf[15]);
      u32x4* p = (u32x4*)(KHT0 + (size_t)(h * 128 + k) * MROWS + r0 + tq * 16); p[0] = a; p[1] = b; }
    { u32x4 a, b; a.x = cvt_pk_bf16(khb[0], khb[1]); a.y = cvt_pk_bf16(khb[2], khb[3]); a.z = cvt_pk_bf16(khb[4], khb[5]); a.w = cvt_pk_bf16(khb[6], khb[7]);
      b.x = cvt_pk_bf16(khb[8], khb[9]); b.y = cvt_pk_bf16(khb[10], khb[11]); b.z = cvt_pk_bf16(khb[12], khb[13]); b.w = cvt_pk_bf16(khb[14], khb[15]);
      u32x4* p = (u32x4*)(KHT1 + (size_t)(h * 128 + k) * MROWS + r0 + tq * 16); p[0] = a; p[1] = b; }
    if (tq == 0) { float* DEC = WSP(float, WS_DEC); DEC[(size_t)(chunk * 2 + 0) * 512 + h * 128 + k] = __expf(bl_f); DEC[(size_t)(chunk * 2 + 1) * 512 + h * 128 + k] = __expf(bl_b); }
    __syncthreads();
}
template <int U> __device__ __forceinline__ void prepa_tokens(const Ctx& C, int r0) {
    const int lane = C.lane, l = C.l; const bool prompt = r0 < MPROMPT;
    const float* ROPE = WSP(float, WS_ROPE);
    u32x4 wq[U], ws0[U], ws1[U]; f32x4 a[U], bb[U], kv[U], sv[U]; float kp[U];
#pragma unroll
    for (int u = 0; u < U; ++u) { const int r = r0 + u; const float* INF = WSP(float, WS_INF) + (size_t)r * LDF; const bf16_t* IN = WSP(bf16_t, WS_IN) + (size_t)r * NIN;
        wq[u] = __builtin_nontemporal_load((const u32x4*)(IN + C_CQ + lane * 8)); a[u] = __builtin_nontemporal_load((const f32x4*)(INF + F_CKV + lane * 8)); bb[u] = __builtin_nontemporal_load((const f32x4*)(INF + F_CKV + lane * 8 + 4));
        ws0[u] = __builtin_nontemporal_load((const u32x4*)(IN + C_SQ + lane * 16)); ws1[u] = __builtin_nontemporal_load((const u32x4*)(IN + C_SQ + lane * 16 + 8)); kv[u] = *(const f32x4*)(INF + F_SK + lane * 4);
        if (prompt) { kp[u] = INF[F_KPE + lane]; sv[u] = __builtin_nontemporal_load((const f32x4*)(INF + F_SV + lane * 4)); } }
    float vq[U][8], vs[U][16], s1[U], s2[U], s3[U], s4[U];
#pragma unroll
    for (int u = 0; u < U; ++u) {
        vq[u][0] = bf_lo(wq[u].x); vq[u][1] = bf_hi(wq[u].x); vq[u][2] = bf_lo(wq[u].y); vq[u][3] = bf_hi(wq[u].y); vq[u][4] = bf_lo(wq[u].z); vq[u][5] = bf_hi(wq[u].z); vq[u][6] = bf_lo(wq[u].w); vq[u][7] = bf_hi(wq[u].w);
        vs[u][0] = bf_lo(ws0[u].x); vs[u][1] = bf_hi(ws0[u].x); vs[u][2] = bf_lo(ws0[u].y); vs[u][3] = bf_hi(ws0[u].y); vs[u][4] = bf_lo(ws0[u].z); vs[u][5] = bf_hi(ws0[u].z); vs[u][6] = bf_lo(ws0[u].w); vs[u][7] = bf_hi(ws0[u].w);
        vs[u][8] = bf_lo(ws1[u].x); vs[u][9] = bf_hi(ws1[u].x); vs[u][10] = bf_lo(ws1[u].y); vs[u][11] = bf_hi(ws1[u].y); vs[u][12] = bf_lo(ws1[u].z); vs[u][13] = bf_hi(ws1[u].z); vs[u][14] = bf_lo(ws1[u].w); vs[u][15] = bf_hi(ws1[u].w);
        s1[u] = 0.f; s3[u] = 0.f;
#pragma unroll
        for (int i = 0; i < 8; ++i) s1[u] += vq[u][i] * vq[u][i];
#pragma unroll
        for (int i = 0; i < 16; ++i) s3[u] += vs[u][i] * vs[u][i];
        s2[u] = (a[u][0] * a[u][0] + a[u][1] * a[u][1]) + (a[u][2] * a[u][2] + a[u][3] * a[u][3]) + (bb[u][0] * bb[u][0] + bb[u][1] * bb[u][1]) + (bb[u][2] * bb[u][2] + bb[u][3] * bb[u][3]);
        s4[u] = (kv[u][0] * kv[u][0] + kv[u][1] * kv[u][1]) + (kv[u][2] * kv[u][2] + kv[u][3] * kv[u][3]); }
#pragma unroll
    for (int o = 1; o < 64; o <<= 1) {
#pragma unroll
        for (int u = 0; u < U; ++u) { s1[u] += __shfl_xor(s1[u], o); s2[u] += __shfl_xor(s2[u], o); if (o < 4) s3[u] += __shfl_xor(s3[u], o); if (o < 16) s4[u] += __shfl_xor(s4[u], o); } }
    const float* gq = LIN(19, 512) + lane * 8; const float* gk = LIN(21, 512) + lane * 8;
    const int sub = lane & 3, s16 = lane & 15; const float* g = LIN(30, 64) + sub * 16; const f32x4 gkn = *(const f32x4*)(LIN(31, 64) + s16 * 4);
#pragma unroll
    for (int u = 0; u < U; ++u) { const int r = r0 + u; const size_t orow = (size_t)(((r >> 8) * 2 + l) * 256 + (r & 255)); const int t = (r - MPROMPT) & 2047, trow = t >> 6, tcol = t & 63;
        const float rs1 = rsqrtf(s1[u] * (1.0f / 512.0f) + EPS), rs2 = rsqrtf(s2[u] * (1.0f / 512.0f) + EPS), rs3 = rsqrtf(s3[u] * (1.0f / 64.0f) + EPS), rs4 = rsqrtf(s4[u] * (1.0f / 64.0f) + EPS);
        {
            u32x4 o; o.x = cvt_pk_bf16(vq[u][0] * rs1 * gq[0], vq[u][1] * rs1 * gq[1]); o.y = cvt_pk_bf16(vq[u][2] * rs1 * gq[2], vq[u][3] * rs1 * gq[3]); o.z = cvt_pk_bf16(vq[u][4] * rs1 * gq[4], vq[u][5] * rs1 * gq[5]); o.w = cvt_pk_bf16(vq[u][6] * rs1 * gq[6], vq[u][7] * rs1 * gq[7]);
            *(u32x4*)(WSP(bf16_t, WS_CQN) + (size_t)r * 512 + lane * 8) = o; }
        {
            const f32x4 ya = a[u] * rs2 * *(const f32x4*)gk, yb = bb[u] * rs2 * *(const f32x4*)(gk + 4);
            if (prompt) { float* op = C.out + O_CKV + orow * 512 + lane * 8; *(f32x4*)op = ya; *(f32x4*)(op + 4) = yb; }
            u32x4 o2; o2.x = cvt_pk_bf16(ya[0], ya[1]); o2.y = cvt_pk_bf16(ya[2], ya[3]); o2.z = cvt_pk_bf16(yb[0], yb[1]); o2.w = cvt_pk_bf16(yb[2], yb[3]);
            *(u32x4*)(WSP(bf16_t, WS_CKVN) + (size_t)r * 512 + lane * 8) = o2; }
        if (prompt) { C.out[O_KPE + orow * 64 + lane] = kp[u]; *(f32x4*)(C.out + O_SV + orow * 256 + lane * 4) = sv[u]; }
        {
#pragma unroll
            for (int i = 0; i < 16; ++i) vs[u][i] = vs[u][i] * rs3 * g[i];
            if (!prompt) { const int pos = sub < 2 ? trow : tcol; const float* cp = ROPE + pos * 16; const float* sp = cp + 1024;
#pragma unroll
                for (int i = 0; i < 16; ++i) { const float oth = __shfl_xor(vs[u][i], 1), c = cp[i], sn = sp[i]; vs[u][i] = (sub & 1) ? (oth * sn + vs[u][i] * c) : (vs[u][i] * c - oth * sn); } }
            u32x4 o0, o1;
            o0.x = cvt_pk_bf16(vs[u][0] * SWA_QSCALE, vs[u][1] * SWA_QSCALE); o0.y = cvt_pk_bf16(vs[u][2] * SWA_QSCALE, vs[u][3] * SWA_QSCALE); o0.z = cvt_pk_bf16(vs[u][4] * SWA_QSCALE, vs[u][5] * SWA_QSCALE); o0.w = cvt_pk_bf16(vs[u][6] * SWA_QSCALE, vs[u][7] * SWA_QSCALE);
            o1.x = cvt_pk_bf16(vs[u][8] * SWA_QSCALE, vs[u][9] * SWA_QSCALE); o1.y = cvt_pk_bf16(vs[u][10] * SWA_QSCALE, vs[u][11] * SWA_QSCALE); o1.z = cvt_pk_bf16(vs[u][12] * SWA_QSCALE, vs[u][13] * SWA_QSCALE); o1.w = cvt_pk_bf16(vs[u][14] * SWA_QSCALE, vs[u][15] * SWA_QSCALE);
            u32x4* op = (u32x4*)(WSP(bf16_t, WS_QS) + (size_t)r * 1024 + lane * 16); op[0] = o0; op[1] = o1; }
        {
            f32x4 kk = kv[u] * rs4 * gkn;
            if (prompt) *(f32x4*)(C.out + O_SK + orow * 256 + lane * 4) = kk;
            else { const int pos = s16 < 8 ? trow : tcol; const f32x4 c = *(const f32x4*)(ROPE + pos * 16 + (lane & 3) * 4), sn = *(const f32x4*)(ROPE + 1024 + pos * 16 + (lane & 3) * 4);
#pragma unroll
                for (int j = 0; j < 4; ++j) { const float oth = __shfl_xor(kk[j], 4); kk[j] = (s16 & 4) ? (oth * sn[j] + kk[j] * c[j]) : (kk[j] * c[j] - oth * sn[j]); } }
            u32x2 o; o.x = cvt_pk_bf16(kk[0], kk[1]); o.y = cvt_pk_bf16(kk[2], kk[3]);
            *(u32x2*)(WSP(bf16_t, WS_KS) + (size_t)r * 256 + lane * 4) = o; } }
}
__device__ __forceinline__ void prepa_ctx_item(const Ctx& C, int j) {
    const int tid = C.tid, l = C.l;
    {   bf16_t* CKVN = WSP(bf16_t, WS_CKVN) + (size_t)(MROWS + j * 64) * 512;
        const int b = (j * 64) >> 8, key0 = (j * 64) & 255; const float* src = C.in[2] + ((size_t)(b * 2 + l) * 256 + key0) * 512;
#pragma unroll
        for (int i = 0; i < 8; ++i) { const int idx = (i * NTHR + tid) * 8; const f32x4 a = *(const f32x4*)(src + idx), bb = *(const f32x4*)(src + idx + 4);
            u32x4 o; o.x = cvt_pk_bf16(a[0], a[1]); o.y = cvt_pk_bf16(a[2], a[3]); o.z = cvt_pk_bf16(bb[0], bb[1]); o.w = cvt_pk_bf16(bb[2], bb[3]); *(u32x4*)(CKVN + idx) = o; }
        bf16_t* KS = WSP(bf16_t, WS_KS) + (size_t)(MROWS + j * 64) * 256; const float* sk = C.in[4] + ((size_t)(b * 2 + l) * 256 + key0) * 256;
#pragma unroll
        for (int i = 0; i < 4; ++i) { const int idx = (i * NTHR + tid) * 8; const f32x4 a = *(const f32x4*)(sk + idx), bb = *(const f32x4*)(sk + idx + 4);
            u32x4 o; o.x = cvt_pk_bf16(a[0], a[1]); o.y = cvt_pk_bf16(a[2], a[3]); o.z = cvt_pk_bf16(bb[0], bb[1]); o.w = cvt_pk_bf16(bb[2], bb[3]); *(u32x4*)(KS + idx) = o; }
        const int c = tid & 255, kh = tid >> 8; const float* sv = C.in[5] + ((size_t)(b * 2 + l) * 256 + key0 + kh * 32) * 256 + c;
        float v[32];
#pragma unroll
        for (int i = 0; i < 32; ++i) v[i] = sv[(size_t)i * 256];
        u32x4* op = (u32x4*)(WSP(bf16_t, WS_VSCT) + ((size_t)b * 256 + c) * 256 + key0 + kh * 32);
#pragma unroll
        for (int g = 0; g < 4; ++g) { u32x4 o; o.x = cvt_pk_bf16(v[g * 8], v[g * 8 + 1]); o.y = cvt_pk_bf16(v[g * 8 + 2], v[g * 8 + 3]); o.z = cvt_pk_bf16(v[g * 8 + 4], v[g * 8 + 5]); o.w = cvt_pk_bf16(v[g * 8 + 6], v[g * 8 + 7]); op[g] = o; }
    }
}
__device__ __forceinline__ void phase_prepa(const Ctx& C, const int mask) {
    constexpr int I_GLA = 512, I_TOK = 256, I_CTX = 8;
    for (int it = C.bid; it < I_GLA + I_TOK + I_CTX; it += C.G) {
        if (it < I_GLA) { if (mask & 1) prepa_gla_item(C, it >> 2, it & 3); continue; }
        if (it < I_GLA + I_TOK) { const int r0 = (it - I_GLA) * 32 + C.wave * 4;
            if (mask & 2) { prepa_tokens<2>(C, r0); prepa_tokens<2>(C, r0 + 2); }
            continue; }
        if (mask & 4) prepa_ctx_item(C, it - I_GLA - I_TOK);
    }
}

__device__ __forceinline__ void prepb_unpack(const u32x4 w, float (&v)[8]) { v[0] = bf_lo(w.x); v[1] = bf_hi(w.x); v[2] = bf_lo(w.y); v[3] = bf_hi(w.y); v[4] = bf_lo(w.z); v[5] = bf_hi(w.z); v[6] = bf_lo(w.w); v[7] = bf_hi(w.w); }
__device__ __forceinline__ u32x4 prepb_pack(const float (&v)[8], float s) { u32x4 o; o.x = cvt_pk_bf16(v[0] * s, v[1] * s); o.y = cvt_pk_bf16(v[2] * s, v[3] * s); o.z = cvt_pk_bf16(v[4] * s, v[5] * s); o.w = cvt_pk_bf16(v[6] * s, v[7] * s); return o; }
__device__ __forceinline__ void phase_prepb(const Ctx& C) {
    const int lane = C.lane, l = C.l, h = lane >> 3, sub = lane & 7; const float* ROPE = WSP(float, WS_ROPE);
    constexpr int NT = MROWS + MKV, U = 2; const int nw = C.G * NWAVES;
    float gq[3][8], gk[3][8];
#pragma unroll
    for (int c = 0; c < 3; ++c)
#pragma unroll
        for (int j = 0; j < 8; ++j) { gq[c][j] = LIN(23, 192)[64 * c + 8 * sub + j]; gk[c][j] = LIN(24, 192)[64 * c + 8 * sub + j]; }
    const bf16_t* QRAW = WSP(bf16_t, WS_QRAW); const bf16_t* KNRAW = WSP(bf16_t, WS_KNRAW); const float* INF = WSP(float, WS_INF);
    for (int t0 = C.bid * NWAVES + C.wave; t0 < NT; t0 += U * nw) {
        float v[U][3][8];
#pragma unroll
        for (int u = 0; u < U; ++u) { const int task = (t0 + u * nw < NT) ? t0 + u * nw : t0; const bool isq = task < MROWS; const int r = isq ? task : task - MROWS;
            if (isq) {
#pragma unroll
                for (int c = 0; c < 3; ++c) prepb_unpack(__builtin_nontemporal_load((const u32x4*)(QRAW + (size_t)r * 1536 + h * 192 + 64 * c + 8 * sub)), v[u][c]); }
            else {
#pragma unroll
                for (int c = 0; c < 2; ++c) prepb_unpack(__builtin_nontemporal_load((const u32x4*)(KNRAW + (size_t)r * 1024 + h * 128 + 64 * c + 8 * sub)), v[u][c]);
                const float* kp = (r < MROWS) ? INF + (size_t)r * LDF + F_KPE + 8 * sub : C.in[3] + ((size_t)(((r - MROWS) >> 8) * 2 + l) * 256 + ((r - MROWS) & 255)) * 64 + 8 * sub;
                const f32x4 a = *(const f32x4*)kp, b = *(const f32x4*)(kp + 4);
                v[u][2][0] = a[0]; v[u][2][1] = a[1]; v[u][2][2] = a[2]; v[u][2][3] = a[3]; v[u][2][4] = b[0]; v[u][2][5] = b[1]; v[u][2][6] = b[2]; v[u][2][7] = b[3]; } }
        float ss[U];
#pragma unroll
        for (int u = 0; u < U; ++u) { ss[u] = 0.f;
#pragma unroll
            for (int c = 0; c < 3; ++c)
#pragma unroll
                for (int j = 0; j < 8; ++j) ss[u] += v[u][c][j] * v[u][c][j]; }
#pragma unroll
        for (int o = 1; o < 8; o <<= 1) {
#pragma unroll
            for (int u = 0; u < U; ++u) ss[u] += __shfl_xor(ss[u], o); }
#pragma unroll
        for (int u = 0; u < U; ++u) { const int task = t0 + u * nw; const bool isq = task < MROWS; const int r = isq ? task : task - MROWS;
            const float rs = rsqrtf(ss[u] * (1.0f / 192.0f) + EPS);
#pragma unroll
            for (int c = 0; c < 3; ++c)
#pragma unroll
                for (int j = 0; j < 8; ++j) v[u][c][j] *= rs * (isq ? gq[c][j] : gk[c][j]);
            const bool rope = (r >= MPROMPT) && (r < MROWS);
            const int t = (r - MPROMPT) & 2047, pos = (sub & 4) ? (t & 63) : (t >> 6);
            const float* cp = ROPE + pos * 16 + 8 * (sub & 1); const f32x4 c0 = *(const f32x4*)cp, c1 = *(const f32x4*)(cp + 4), s0 = *(const f32x4*)(cp + 1024), s1 = *(const f32x4*)(cp + 1028);
            float y[8];
#pragma unroll
            for (int j = 0; j < 8; ++j) { const float x = v[u][2][j], oth = __shfl_xor(x, 2), cc = j < 4 ? c0[j & 3] : c1[j & 3], sn = j < 4 ? s0[j & 3] : s1[j & 3];
                const float rot = (sub & 2) ? (oth * sn + x * cc) : (x * cc - oth * sn); y[j] = rope ? rot : x; }
            if (task < NT) {
                bf16_t* o = (isq ? WSP(bf16_t, WS_QM) : WSP(bf16_t, WS_KM)) + (size_t)r * 1536 + h * 192 + 8 * sub; const float sc = isq ? MLA_QSCALE : 1.0f;
                *(u32x4*)o = prepb_pack(v[u][0], sc); *(u32x4*)(o + 64) = prepb_pack(v[u][1], sc); *(u32x4*)(o + 128) = prepb_pack(y, sc); } }
    }
}

__device__ __forceinline__ void phase_post(const Ctx& C) {
    const int lane = C.lane; const float* g = LIN(29, 256) + lane * 4;
    const float* OF = WSP(float, WS_OG); const float* OB = WSP(float, WS_OG + SZ_OG1); const bf16_t* IN = WSP(bf16_t, WS_IN); bf16_t* OGN = WSP(bf16_t, WS_OGN);
    const f32x4 gv = *(const f32x4*)g; constexpr int U = 4, NT = MROWS * 4; const int nw = C.G * NWAVES;
    for (int t0 = C.bid * NWAVES + C.wave; t0 < NT; t0 += U * nw) {
        f32x4 v[U]; u32x2 gw[U]; float ss[U];
#pragma unroll
        for (int u = 0; u < U; ++u) { const int task = t0 + u * nw < NT ? t0 + u * nw : t0; const int r = task >> 2, h = task & 3; const size_t o = (size_t)r * 1024 + h * 256 + lane * 4;
            v[u] = __builtin_nontemporal_load((const f32x4*)(OF + o)) + __builtin_nontemporal_load((const f32x4*)(OB + o)); gw[u] = __builtin_nontemporal_load((const u32x2*)(IN + (size_t)r * NIN + C_GOUT + h * 256 + lane * 4));
            ss[u] = (v[u][0] * v[u][0] + v[u][1] * v[u][1]) + (v[u][2] * v[u][2] + v[u][3] * v[u][3]); }
#pragma unroll
        for (int o = 1; o < 64; o <<= 1) {
#pragma unroll
            for (int u = 0; u < U; ++u) ss[u] += __shfl_xor(ss[u], o); }
#pragma unroll
        for (int u = 0; u < U; ++u) { const int task = t0 + u * nw; if (task < NT) { const int r = task >> 2, h = task & 3; const size_t o = (size_t)r * 1024 + h * 256 + lane * 4;
            const float rs = rsqrtf(ss[u] * (1.0f / 256.0f) + EPS);
            const f32x4 y = v[u] * rs * gv * (f32x4){siluf_(bf_lo(gw[u].x)), siluf_(bf_hi(gw[u].x)), siluf_(bf_lo(gw[u].y)), siluf_(bf_hi(gw[u].y))};
            u32x2 ow; ow.x = cvt_pk_bf16(y[0], y[1]); ow.y = cvt_pk_bf16(y[2], y[3]); *(u32x2*)(OGN + o) = ow; } }
    }
}

struct AttnSeg { const bf16_t* K; const bf16_t* VT; int kstride, vtstride, nk, kpos0; };
template <int DQK, int DV>
__device__ __forceinline__ void attn_item(ldsp lds, int tid, const bf16_t* Qw, int qstride, int qpos0, const AttnSeg s0, const AttnSeg s1, bool window,
                                          float m_init, float l_init, bf16_t* Ow, int ostride, const int variant = 0  ) {
    constexpr int KST = DQK * 2 + 32  , VST = 160, KT_BYTES = 64 * KST, VT_BYTES = DV * VST, BUF = KT_BYTES + VT_BYTES;
    constexpr int NKK = DQK / 32, NDVB = DV / 16, KPR = DQK / 8, KP = (64 * KPR) / NTHR, VP = (DV * 8) / NTHR;
    static_assert((64 * KPR) % NTHR == 0 && (DV * 8) % NTHR == 0 && 2 * BUF <= 131072, "attn tile geometry");
    const int lane = tid & 63, fr = lane & 15, fq = lane >> 4;
    bf16x8 qf[2][NKK];
#pragma unroll
    for (int rb = 0; rb < 2; ++rb)
#pragma unroll
        for (int kk = 0; kk < NKK; ++kk) qf[rb][kk] = *(const bf16x8*)(Qw + (size_t)(rb * 16 + fr) * qstride + kk * 32 + fq * 8);
    f32x4 o[NDVB][2];
#pragma unroll
    for (int d = 0; d < NDVB; ++d) { o[d][0] = (f32x4){0.f, 0.f, 0.f, 0.f}; o[d][1] = (f32x4){0.f, 0.f, 0.f, 0.f}; }
    float mrun[2] = {m_init, m_init}, lrun[2] = {fq == 0 ? l_init : 0.f, fq == 0 ? l_init : 0.f};
    const int nt0 = s0.nk >> 6, nt = nt0 + (s1.nk >> 6);
    u32x4 kreg[KP], vreg[VP];
#define ATT_LOAD(t) do { const bool _a = (t) < nt0; const bf16_t* _K = _a ? s0.K : s1.K; const bf16_t* _V = _a ? s0.VT : s1.VT; const int _ks = _a ? s0.kstride : s1.kstride, _vs = _a ? s0.vtstride : s1.vtstride; \
        const int _k0 = (_a ? (t) : (t) - nt0) * 64; \
        _Pragma("unroll") for (int _j = 0; _j < KP; ++_j) { const int _pi = tid + NTHR * _j, _row = _pi / KPR, _cp = _pi - _row * KPR; kreg[_j] = *(const u32x4*)(_K + (size_t)(_k0 + _row) * _ks + _cp * 8); } \
        _Pragma("unroll") for (int _j = 0; _j < VP; ++_j) { const int _pi = tid + NTHR * _j, _row = _pi >> 3, _cp = _pi & 7; vreg[_j] = *(const u32x4*)(_V + (size_t)_row * _vs + _k0 + _cp * 8); } } while (0)
#define ATT_STORE(buf) do { ldsp _b = lds + (buf) * BUF; \
        _Pragma("unroll") for (int _j = 0; _j < KP; ++_j) { const int _pi = tid + NTHR * _j, _row = _pi / KPR, _cp = _pi - _row * KPR; *(LAS u32x4*)(_b + ATT_KROW(_row) * KST + _cp * 16) = kreg[_j]; } \
        _Pragma("unroll") for (int _j = 0; _j < VP; ++_j) { const int _pi = tid + NTHR * _j, _row = _pi >> 3, _cp = _pi & 7; *(LAS u32x4*)(_b + KT_BYTES + _row * VST + _cp * 16) = vreg[_j]; } } while (0)
#define ATT_KROW(key) (((((key) >> 5) * 2 + (((key) >> 2) & 1)) << 4) + ((((key) >> 3) & 3) << 2) + ((key) & 3))
    ATT_LOAD(0); ATT_STORE(0);
    __syncthreads();
    for (int t = 0; t < nt; ++t) {
        if (t + 1 < nt && !(variant & 4)) ATT_LOAD(t + 1);
        ldsp kb_ = lds + (t & 1) * BUF; ldsp vb_ = kb_ + KT_BYTES;
        f32x4 s[4][2];
#pragma unroll
        for (int kb = 0; kb < 4; ++kb) { s[kb][0] = (f32x4){0.f, 0.f, 0.f, 0.f}; s[kb][1] = (f32x4){0.f, 0.f, 0.f, 0.f}; }
        __builtin_amdgcn_s_setprio(1);
        {
            constexpr int NG = 4 * NKK, KD = 4; bf16x8 af[KD + 1];
#define ATT_KOFF(g) ((((g) / (2 * NKK)) * 2 + ((g) & 1)) * 16 * KST + (((g) >> 1) % NKK) * 64)
#pragma unroll
            for (int j = 0; j < KD; ++j) af[j] = *(const LAS bf16x8*)(kb_ + ATT_KOFF(j) + fr * KST + fq * 16);
#pragma unroll
            for (int g = 0; g < NG; ++g) {
                if (g + KD < NG) af[(g + KD) % (KD + 1)] = *(const LAS bf16x8*)(kb_ + ATT_KOFF(g + KD) + fr * KST + fq * 16);
                __builtin_amdgcn_sched_barrier(0);
                { const int kb = (g / (2 * NKK)) * 2 + (g & 1), kk = (g >> 1) % NKK;
                  if (variant & 2) { s[kb][0][0] += (float)af[g % (KD + 1)][0]; }
                  else { s[kb][0] = __builtin_amdgcn_mfma_f32_16x16x32_bf16(af[g % (KD + 1)], qf[0][kk], s[kb][0], 0, 0, 0);
                         s[kb][1] = __builtin_amdgcn_mfma_f32_16x16x32_bf16(af[g % (KD + 1)], qf[1][kk], s[kb][1], 0, 0, 0); } }
                __builtin_amdgcn_sched_barrier(0);
            }
#undef ATT_KOFF
        }
        __builtin_amdgcn_s_setprio(0);
#pragma unroll
        for (int hf = 0; hf < 2; ++hf) {
            if (window && t < nt0) {
                const int kp0 = s0.kpos0 + t * 64 + fq * 8;
#pragma unroll
                for (int rb = 0; rb < 2; ++rb) { const int qp = qpos0 + rb * 16 + fr;
#pragma unroll
                    for (int kb = 2 * hf; kb < 2 * hf + 2; ++kb)
#pragma unroll
                        for (int i = 0; i < 4; ++i) { const int dlt = qp - (kp0 + (kb >> 1) * 32 + (kb & 1) * 4 + i); if (dlt > 128 || dlt < -128) s[kb][rb][i] = -1e30f; } }
            }
            bf16x8 pb[2];
#pragma unroll
            for (int rb = 0; rb < 2; ++rb) {
                if (variant & 1) { union { u32x4 u; bf16x8 b; } cv; cv.u.x = cvt_pk_bf16(s[2 * hf][rb][0], s[2 * hf][rb][1]); cv.u.y = cvt_pk_bf16(s[2 * hf][rb][2], s[2 * hf][rb][3]);
                    cv.u.z = cvt_pk_bf16(s[2 * hf + 1][rb][0], s[2 * hf + 1][rb][1]); cv.u.w = cvt_pk_bf16(s[2 * hf + 1][rb][2], s[2 * hf + 1][rb][3]); pb[rb] = cv.b; continue; }
                float mx = fmaxf(fmaxf(fmaxf(s[2 * hf][rb][0], s[2 * hf][rb][1]), fmaxf(s[2 * hf][rb][2], s[2 * hf][rb][3])), fmaxf(fmaxf(s[2 * hf + 1][rb][0], s[2 * hf + 1][rb][1]), fmaxf(s[2 * hf + 1][rb][2], s[2 * hf + 1][rb][3])));
                mx = fmaxf(mx, __shfl_xor(mx, 16)); mx = fmaxf(mx, __shfl_xor(mx, 32));
                const float mn = fmaxf(mrun[rb], mx);
                if (__builtin_amdgcn_ballot_w64(mn > mrun[rb]) != 0ull) {
                    const float alpha = fast_exp2(mrun[rb] - mn); lrun[rb] *= alpha;
#pragma unroll
                    for (int d = 0; d < NDVB; ++d) o[d][rb] = o[d][rb] * alpha; }
                mrun[rb] = mn;
                float ps = 0.f;
#pragma unroll
                for (int kb = 2 * hf; kb < 2 * hf + 2; ++kb)
#pragma unroll
                    for (int i = 0; i < 4; ++i) { const float p = fast_exp2(s[kb][rb][i] - mn); s[kb][rb][i] = p; ps += p; }
                lrun[rb] += ps;
                union { u32x4 u; bf16x8 b; } cv;
                cv.u.x = cvt_pk_bf16(s[2 * hf][rb][0], s[2 * hf][rb][1]); cv.u.y = cvt_pk_bf16(s[2 * hf][rb][2], s[2 * hf][rb][3]);
                cv.u.z = cvt_pk_bf16(s[2 * hf + 1][rb][0], s[2 * hf + 1][rb][1]); cv.u.w = cvt_pk_bf16(s[2 * hf + 1][rb][2], s[2 * hf + 1][rb][3]);
                pb[rb] = cv.b;
            }
            __builtin_amdgcn_sched_barrier(0);
            __builtin_amdgcn_s_setprio(1);
            {
                constexpr int VD = NDVB < 4 ? NDVB : 4; bf16x8 vf[VD + 1];
#define ATT_VREAD(d) (*(const LAS bf16x8*)(vb_ + ((d) * 16 + fr) * VST + (hf * 32 + fq * 8) * 2))
#pragma unroll
                for (int j = 0; j < VD; ++j) vf[j] = ATT_VREAD(j);
#pragma unroll
                for (int d = 0; d < NDVB; ++d) {
                    if (d + VD < NDVB) vf[(d + VD) % (VD + 1)] = ATT_VREAD(d + VD);
                    __builtin_amdgcn_sched_barrier(0);
                    if (variant & 2) { o[d][0][0] += (float)vf[d % (VD + 1)][0]; }
                    else { o[d][0] = __builtin_amdgcn_mfma_f32_16x16x32_bf16(vf[d % (VD + 1)], pb[0], o[d][0], 0, 0, 0);
                           o[d][1] = __builtin_amdgcn_mfma_f32_16x16x32_bf16(vf[d % (VD + 1)], pb[1], o[d][1], 0, 0, 0); }
                    __builtin_amdgcn_sched_barrier(0);
                }
#undef ATT_VREAD
            }
            __builtin_amdgcn_s_setprio(0);
        }
        if (t + 1 < nt && !(variant & 4)) ATT_STORE((t + 1) & 1);
        __syncthreads();
    }
#undef ATT_LOAD
#undef ATT_STORE
#undef ATT_KROW
#pragma unroll
    for (int rb = 0; rb < 2; ++rb) { float lt = lrun[rb]; lt += __shfl_xor(lt, 16); lt += __shfl_xor(lt, 32); const float inv = 1.0f / lt;
        bf16_t* orow = Ow + (size_t)(rb * 16 + fr) * ostride + fq * 4;
#pragma unroll
        for (int d = 0; d < NDVB; ++d) { const f32x4 v = o[d][rb] * inv; u32x2 w; w.x = cvt_pk_bf16(v[0], v[1]); w.y = cvt_pk_bf16(v[2], v[3]); *(u32x2*)(orow + d * 16) = w; } }
}

namespace gla {
constexpr int QST = 288, HST = 160, VST = 144, SST = 288;
constexpr int OFF_Q = 0, OFF_K = 64 * QST, OFF_KH = OFF_K + 64 * QST, OFF_V = OFF_KH + 128 * HST, OFF_S = OFF_V + 64 * VST, SBYTES = 64 * SST;
static_assert(OFF_S + 2 * SBYTES <= 131072, "gla lds");
struct Regs { u32x4 q[2], k[2], h[2], v; float dec; };
__device__ __forceinline__ void load(Regs& R, const bf16_t* QG, const bf16_t* KG, const bf16_t* KHT, const bf16_t* VT, const float* DEC, size_t r0, int h, int tid) {
    R.dec = DEC[(r0 >> 6) * 1024];
#pragma unroll
    for (int j = 0; j < 2; ++j) { const int pi = tid + NTHR * j, row = pi >> 4, cp = pi & 15;
        R.q[j] = *(const u32x4*)(QG + (r0 + row) * 512 + h * 128 + cp * 8); R.k[j] = *(const u32x4*)(KG + (r0 + row) * 512 + h * 128 + cp * 8);
        const int hr = pi >> 3, hc = pi & 7; R.h[j] = *(const u32x4*)(KHT + (size_t)(h * 128 + hr) * MROWS + r0 + hc * 8); }
    { const int row = tid >> 3, cp = tid & 7; R.v = *(const u32x4*)(VT + (size_t)row * MROWS + r0 + cp * 8); }
}
__device__ __forceinline__ void store(const Regs& R, ldsp lds, int tid) {
#pragma unroll
    for (int j = 0; j < 2; ++j) { const int pi = tid + NTHR * j, row = pi >> 4, cp = pi & 15;
        *(LAS u32x4*)(lds + OFF_Q + row * QST + cp * 16) = R.q[j]; *(LAS u32x4*)(lds + OFF_K + row * QST + cp * 16) = R.k[j];
        const int hr = pi >> 3, hc = pi & 7; *(LAS u32x4*)(lds + OFF_KH + hr * HST + hc * 16) = R.h[j]; }
    { const int row = tid >> 3, cp = tid & 7; *(LAS u32x4*)(lds + OFF_V + row * VST + cp * 16) = R.v; }
}
__device__ __forceinline__ void puts(const f32x4 (&st)[4], ldsp lds, int buf, int w, int fr, int fq) {
    ldsp s = lds + OFF_S + buf * SBYTES;
#pragma unroll
    for (int d = 0; d < 4; ++d)
#pragma unroll
        for (int i = 0; i < 4; ++i) *(LAS bf16_t*)(s + (d * 16 + fq * 4 + i) * SST + (w * 16 + fr) * 2) = f2bf(st[d][i]);
}
__device__ __forceinline__ void chunk(f32x4 (&st)[4], ldsp lds, int cur, float dec, int dir, float* og  , int w, int fr, int fq) {
    const int pbk = w >> 1, dh = w & 1;
    bf16x8 qf[4];
#pragma unroll
    for (int kk = 0; kk < 4; ++kk) qf[kk] = *(const LAS bf16x8*)(lds + OFF_Q + (pbk * 16 + fr) * QST + kk * 64 + fq * 16);
    f32x4 at[4];
#pragma unroll
    for (int sb = 0; sb < 4; ++sb) { at[sb] = (f32x4){0.f, 0.f, 0.f, 0.f};
#pragma unroll
        for (int kk = 0; kk < 4; ++kk) { const bf16x8 a = *(const LAS bf16x8*)(lds + OFF_K + (sb * 16 + fr) * QST + kk * 64 + fq * 16); at[sb] = __builtin_amdgcn_mfma_f32_16x16x32_bf16(a, qf[kk], at[sb], 0, 0, 0); }
        const int pt = pbk * 16 + fr;
#pragma unroll
        for (int i = 0; i < 4; ++i) { const int stok = sb * 16 + fq * 4 + i; const bool keep = dir ? (stok >= pt) : (stok <= pt); if (!keep) at[sb][i] = 0.f; } }
    bf16x8 pT[2];
#pragma unroll
    for (int ks = 0; ks < 2; ++ks) { union { u32x4 u; bf16x8 b; } cv;
        cv.u.x = cvt_pk_bf16(at[2 * ks][0], at[2 * ks][1]); cv.u.y = cvt_pk_bf16(at[2 * ks][2], at[2 * ks][3]); cv.u.z = cvt_pk_bf16(at[2 * ks + 1][0], at[2 * ks + 1][1]); cv.u.w = cvt_pk_bf16(at[2 * ks + 1][2], at[2 * ks + 1][3]); pT[ks] = cv.b; }
    const ldsp sb_ = lds + OFF_S + cur * SBYTES;
#pragma unroll
    for (int dd = 0; dd < 2; ++dd) { const int dvb = dh * 2 + dd; f32x4 oacc = (f32x4){0.f, 0.f, 0.f, 0.f};
#pragma unroll
        for (int ks = 0; ks < 2; ++ks) { union { u32x4 u; bf16x8 b; } av;
            const u32x2 lo = *(const LAS u32x2*)(lds + OFF_V + (dvb * 16 + fr) * VST + ((2 * ks) * 16 + fq * 4) * 2), hi = *(const LAS u32x2*)(lds + OFF_V + (dvb * 16 + fr) * VST + ((2 * ks + 1) * 16 + fq * 4) * 2);
            av.u.x = lo.x; av.u.y = lo.y; av.u.z = hi.x; av.u.w = hi.y;
            oacc = __builtin_amdgcn_mfma_f32_16x16x32_bf16(av.b, pT[ks], oacc, 0, 0, 0); }
#pragma unroll
        for (int kk = 0; kk < 4; ++kk) { const bf16x8 a = *(const LAS bf16x8*)(sb_ + (dvb * 16 + fr) * SST + kk * 64 + fq * 16); oacc = __builtin_amdgcn_mfma_f32_16x16x32_bf16(a, qf[kk], oacc, 0, 0, 0); }
        *(f32x4*)(og + (size_t)(pbk * 16 + fr) * 1024 + dvb * 16 + fq * 4) = oacc; }
    bf16x8 hb[2];
#pragma unroll
    for (int ks = 0; ks < 2; ++ks) hb[ks] = *(const LAS bf16x8*)(lds + OFF_KH + (w * 16 + fr) * HST + ks * 64 + fq * 16);
#pragma unroll
    for (int d = 0; d < 4; ++d) { st[d] = st[d] * dec;
#pragma unroll
        for (int ks = 0; ks < 2; ++ks) { const bf16x8 a = *(const LAS bf16x8*)(lds + OFF_V + (d * 16 + fr) * VST + ks * 64 + fq * 16); st[d] = __builtin_amdgcn_mfma_f32_16x16x32_bf16(a, hb[ks], st[d], 0, 0, 0); } }
    puts(st, lds, cur ^ 1, w, fr, fq);
}
}
__device__ __forceinline__ void gla_item(const Ctx& C, const int tid, int row0, int nchunk  , int h, int dir, int dvs, const float* s0, float* sout) {
    ldsp lds = C.lds; const int lane = tid & 63, w = C.wave, fr = lane & 15, fq = lane >> 4;
    const bf16_t* QG = WSP(bf16_t, WS_QG + (size_t)dir * SZ_G1); const bf16_t* KG = WSP(bf16_t, WS_KG + (size_t)dir * SZ_G1); const bf16_t* KHT = WSP(bf16_t, WS_KHT + (size_t)dir * SZ_G1);
    const bf16_t* VT = WSP(bf16_t, WS_VT) + (size_t)(h * 256 + dvs * 64) * MROWS; const float* DEC = WSP(float, WS_DEC) + (size_t)dir * 512 + h * 128 + w * 16 + fr;
    float* OG = WSP(float, WS_OG + (size_t)dir * SZ_OG1) + h * 256 + dvs * 64;
    f32x4 st[4];
#pragma unroll
    for (int d = 0; d < 4; ++d) st[d] = s0 ? *(const f32x4*)(s0 + (size_t)(w * 16 + fr) * 256 + dvs * 64 + d * 16 + fq * 4) : (f32x4){0.f, 0.f, 0.f, 0.f};
    const int c_first = dir ? nchunk - 1 : 0, c_step = dir ? -1 : 1;
#define GLA_ROW(n) ((size_t)row0 + (size_t)(c_first + (n) * c_step) * 64)
    gla::Regs RA, RB;
    gla::load(RA, QG, KG, KHT, VT, DEC, GLA_ROW(0), h, tid); gla::store(RA, lds, tid); float dec_cur = RA.dec;
    gla::load(RA, QG, KG, KHT, VT, DEC, GLA_ROW(1), h, tid);
    if (nchunk > 2) gla::load(RB, QG, KG, KHT, VT, DEC, GLA_ROW(2), h, tid);
    gla::puts(st, lds, 0, w, fr, fq);
    __syncthreads();
    for (int n = 0; n < nchunk; n += 2) {
        gla::chunk(st, lds, 0, dec_cur, dir, OG + GLA_ROW(n) * 1024, w, fr, fq);
        __syncthreads();
        gla::store(RA, lds, tid); dec_cur = RA.dec;
        if (n + 3 < nchunk) gla::load(RA, QG, KG, KHT, VT, DEC, GLA_ROW(n + 3), h, tid);
        __syncthreads();
        gla::chunk(st, lds, 1, dec_cur, dir, OG + GLA_ROW(n + 1) * 1024, w, fr, fq);
        __syncthreads();
        if (n + 2 < nchunk) { gla::store(RB, lds, tid); dec_cur = RB.dec;
            if (n + 4 < nchunk) gla::load(RB, QG, KG, KHT, VT, DEC, GLA_ROW(n + 4), h, tid); }
        __syncthreads();
    }
#undef GLA_ROW
    if (sout) {
#pragma unroll
        for (int d = 0; d < 4; ++d) *(f32x4*)(sout + (size_t)(w * 16 + fr) * 256 + dvs * 64 + d * 16 + fq * 4) = st[d]; }
}

#ifdef MIX_ONLY
#define MIXEN(k) ((k) == MIX_ONLY)
#else
#define MIXEN(k) true
#endif
__device__ __forceinline__ void phase_mixer(const Ctx& C, const int rep, const int mask, const int variant) {
    const int w = C.wave, l = C.l;
    unsigned* head = WSP(unsigned, WS_CTL) + CW_QUEUE + 64 * (l + 2 * rep);
    volatile LAS int* slot = (volatile LAS int*)(C.lds + LDS_MISC + 16);
    constexpr int N_GS = 64, N_MS = 128, N_SS = 256, N_GP = 512, N_MP = 128, N_SP = 256, NTOT = N_GS + N_MS + N_SS + N_GP + N_MP + N_SP;
    const bf16_t* QM = WSP(bf16_t, WS_QM); const bf16_t* KM = WSP(bf16_t, WS_KM); const bf16_t* VMT = WSP(bf16_t, WS_VMT); bf16_t* OMLA = WSP(bf16_t, WS_OMLA);
    const bf16_t* QS = WSP(bf16_t, WS_QS); const bf16_t* KS = WSP(bf16_t, WS_KS); const bf16_t* VT = WSP(bf16_t, WS_VT); const bf16_t* VSCT = WSP(bf16_t, WS_VSCT); bf16_t* OSWA = WSP(bf16_t, WS_OSWA);
    for (;;) {
        __syncthreads();
        if (C.tid == 0) *slot = (int)__hip_atomic_fetch_add(head, 1u, __ATOMIC_RELAXED, __HIP_MEMORY_SCOPE_AGENT);
        __syncthreads();
        int it = *slot;
        if (it >= NTOT) break;
        int tid = C.tid; asm volatile("" : "+v"(tid));
        if (it < N_MS + N_GS) it = (it < N_MS) ? it + N_GS : it - N_MS;
        if (it < N_GS) {
            const int b = it >> 5, h = (it >> 3) & 3, dir = (it >> 2) & 1, dvs = it & 3;
            if (MIXEN(0) && (mask & 1)) gla_item(C, tid, MPROMPT + b * 2048, 32, h, dir, dvs, C.in[6] + ((((size_t)(b * 2 + l) * 2 + dir) * 4 + h) * 128) * 256, nullptr);
            continue; }
        it -= N_GS;
        if (it < N_MS) {
            const int b = it >> 6, h = (it >> 3) & 7, qt = it & 7; const int rq = MPROMPT + b * 2048 + qt * 256 + w * 32;
            AttnSeg a0{KM + (size_t)(MPROMPT + b * 2048) * 1536 + h * 192, VMT + (size_t)(h * 128) * MKV + MPROMPT + b * 2048, 1536, MKV, 2048, 0};
            AttnSeg a1{KM + (size_t)(MROWS + b * 256) * 1536 + h * 192, VMT + (size_t)(h * 128) * MKV + MROWS + b * 256, 1536, MKV, 256, 0};
            if (MIXEN(1) && (mask & 2)) attn_item<192, 128>(C.lds, tid, QM + (size_t)rq * 1536 + h * 192, 1536, 0, a0, a1, false, -1e30f, 0.f, (rep ? WSP(bf16_t, WS_ACT) : OMLA) + (size_t)rq * 1024 + h * 128, 1024, rep ? variant : 0);
            continue; }
        it -= N_MS;
        if (it < N_SS) {
            const int b = it >> 7, kvh = (it >> 5) & 3, qt = it & 31; const int g = w >> 1, t0 = qt * 64, tq0 = t0 + (w & 1) * 32; const int rq = MPROMPT + b * 2048 + tq0, hd = kvh * 4 + g;
            const int tlo = (qt - 2 < 0 ? 0 : qt - 2), thi = (qt + 2 > 31 ? 31 : qt + 2);
            AttnSeg a0{KS + (size_t)(MPROMPT + b * 2048 + tlo * 64) * 256 + kvh * 64, VT + (size_t)(1024 + kvh * 64) * MROWS + MPROMPT + b * 2048 + tlo * 64, 256, MROWS, (thi - tlo + 1) * 64, tlo * 64};
            AttnSeg a1{KS + (size_t)(MROWS + b * 256) * 256 + kvh * 64, VSCT + ((size_t)b * 256 + kvh * 64) * 256, 256, 256, 256, 0};
            if (MIXEN(2) && (mask & 4)) attn_item<64, 64>(C.lds, tid, QS + (size_t)rq * 1024 + hd * 64, 1024, tq0, a0, a1, true, LIN(32, 16)[hd] * LOG2E, 1.0f, OSWA + (size_t)rq * 1024 + hd * 64, 1024);
            continue; }
        it -= N_SS;
        if (it < N_GP) {
            const int b = it >> 5, h = (it >> 3) & 3, dir = (it >> 2) & 1, dvs = it & 3;
            if (MIXEN(0) && (mask & 1)) gla_item(C, tid, b * 256, 4, h, dir, dvs, nullptr, C.out + O_SG + ((((size_t)(b * 2 + l) * 2 + dir) * 4 + h) * 128) * 256);
            continue; }
        it -= N_GP;
        if (it < N_MP) {
            const int b = it >> 3, h = it & 7; const int rq = b * 256 + w * 32;
            AttnSeg a0{KM + (size_t)(b * 256) * 1536 + h * 192, VMT + (size_t)(h * 128) * MKV + b * 256, 1536, MKV, 256, 0};
            AttnSeg a1{KM, VMT, 1536, MKV, 0, 0};
            if (MIXEN(1) && (mask & 2)) attn_item<192, 128>(C.lds, tid, QM + (size_t)rq * 1536 + h * 192, 1536, 0, a0, a1, false, -1e30f, 0.f, OMLA + (size_t)rq * 1024 + h * 128, 1024);
            continue; }
        it -= N_MP;
        {
            const int b = it >> 4, kvh = (it >> 2) & 3, qt = it & 3; const int g = w >> 1, tq0 = qt * 64 + (w & 1) * 32; const int rq = b * 256 + tq0, hd = kvh * 4 + g;
            AttnSeg a0{KS + (size_t)(b * 256) * 256 + kvh * 64, VT + (size_t)(1024 + kvh * 64) * MROWS + b * 256, 256, MROWS, 256, 0};
            AttnSeg a1{KS, VT, 256, MROWS, 0, 0};
            if (MIXEN(2) && (mask & 4)) attn_item<64, 64>(C.lds, tid, QS + (size_t)rq * 1024 + hd * 64, 1024, tq0, a0, a1, false, LIN(32, 16)[hd] * LOG2E, 1.0f, OSWA + (size_t)rq * 1024 + hd * 64, 1024);
        }
    }
}
#define MK_PER_PHASE 0

#ifndef PREP_REP_MODE
#define PREP_REP_MODE 0
#endif
#ifndef MK_PER_PHASE
#define MK_PER_PHASE 0
#endif
constexpr int NPH = 16;
struct Args { const float* in[37]; float* out; unsigned char* ws; int ph_lo, ph_hi; };

__global__ void __launch_bounds__(NTHR, 2) fwd_kernel(Args a) {
    extern __shared__ __attribute__((aligned(16))) unsigned char lds_raw[];
    Ctx C{a.in, a.out, a.ws, (ldsp)lds_raw, 0, 0, 0, 0, 0, 0};
    C.tid = threadIdx.x; C.lane = C.tid & 63; C.wave = __builtin_amdgcn_readfirstlane(C.tid >> 6); C.G = gridDim.x; C.bid = blockIdx.x; C.l = 0;
    if (C.tid < 16) ((LAS unsigned*)(C.lds + LDS_MISC))[C.tid] = 0u;
    __syncthreads();
    unsigned* ctl = (unsigned*)(a.ws + WS_CTL);
    XcdBarrier bar = xcd_barrier_post(ctl + CW_BAR, (volatile LAS unsigned*)(C.lds + LDS_MISC));
    const int lo = a.ph_lo, hi = a.ph_hi;
#define SITE(L) Ctx L = C; { int t_ = C.tid; asm volatile("" : "+v"(t_)); L.tid = t_; L.lane = t_ & 63; L.wave = __builtin_amdgcn_readfirstlane(t_ >> 6); }
    bf16_t* H = WSP(bf16_t, WS_H); bf16_t* ACT = WSP(bf16_t, WS_ACT); bf16_t* IN = WSP(bf16_t, WS_IN);
    for (int l = 0; l < 2; ++l) {
        C.l = l;
        const float* modl = WSP(float, WS_MOD) + (size_t)l * 3 * NMOD; const size_t wl = (size_t)l * SZ_WLAYER;
#ifdef ONLY_SITE
#define EN(s) ((s) == ONLY_SITE)
#else
#define EN(s) true
#endif
#define PH(k) (lo <= l * NPH + (k) && l * NPH + (k) < hi)
#define SEAM(k) do { if (PH(k) && (l * NPH + (k) + 1 < hi)) xcd_barrier(bar); } while (0)
#ifdef REPEAT_SITE
#define REPBEGIN(s) for (int rep = 0; rep < ((s) == REPEAT_SITE ? 2 : 1); ++rep) { if (rep) xcd_barrier(bar);
#define REPEND }
#else
#define REPBEGIN(s) { const int rep = 0; (void)rep;
#define REPEND }
#endif
        REPBEGIN(0) if (EN(0) && PH(0) && l == 0) { SITE(L); phase_prep(L); };
        REPEND if (l == 0) SEAM(0);
        for (int f = 0; f < 2; ++f) {
            const int kb = f ? 13 : 1;
            REPBEGIN(1) if (EN(1) && PH(kb)) { SITE(L); phase_norm(L, f ? 13 : 11, f ? 2 : 0, l == 0 && f == 0); }
            REPEND SEAM(kb);
            REPBEGIN(2) if (EN(2) && PH(kb + 1)) { pg8::MultiOrder<false> S{H, H, H, WSP(bf16_t, (f ? WS_WGU2 : WS_WGU1) + wl), nullptr, nullptr, MROWS / 256, NGU / 256, 0, 0, 0, 0, 1, C.G, C.bid}; pg8::EpiSwiglu E{ACT, DFF, rep};
                pg8::gemm_phase<pg8::EpiSwiglu, pg8::MultiOrder<false>, true, true>(C.lds, 2048, S, E);
                { const int ci = 2 * l + f; if (rep == 0 && ci < 3) { SITE(L); conv_queue(L, (ci + 1) >> 1, ci == 1 ? 0 : 1, 8 + ci, 1 << 30); } } }
            REPEND SEAM(kb + 1);
            REPBEGIN(3) if (EN(3) && PH(kb + 2)) { pg8::MultiOrder<false> S{ACT, ACT, ACT, WSP(bf16_t, (f ? WS_WD2 : WS_WD1) + wl), nullptr, nullptr, MROWS / 256, 2048 / 256, 0, 0, 0, 0, 1, C.G, C.bid}; const bool first = (l == 0 && f == 0 && rep == 0); pg8::EpiResid E{C.out, first ? a.in[0] : C.out, first ? a.in[1] - (size_t)MPROMPT * D : C.out, modl, f ? 8 : 2, rep ? 0.f : 0.5f};
                pg8::gemm_phase<pg8::EpiResid, pg8::MultiOrder<false>, true, true>(C.lds, DFF, S, E); }
            REPEND SEAM(kb + 2);
            if (f == 1) break;
#if defined(REPEAT_SITE) && REPEAT_SITE == 20
            for (int xb = 0; xb < 10; ++xb) xcd_barrier(bar);
#endif
            REPBEGIN(4) if (EN(4) && PH(4)) { SITE(L); phase_norm(L, 12, 1, false); }
            REPEND SEAM(4);
            REPBEGIN(5) if (EN(5) && PH(5)) {
                pg8::MultiOrder<false> S{H, WSP(bf16_t, WS_WINS + wl), nullptr, WSP(bf16_t, WS_WIN + wl), H, nullptr, MROWS / 256, NIN / 256, NSW / 256, MROWS / 256, 0, 0, 2, C.G, C.bid};
                pg8::EpiIn E{IN, WSP(float, WS_INF), WSP(bf16_t, WS_VT), rep};
                pg8::gemm_phase<pg8::EpiIn, pg8::MultiOrder<false>, true, true>(C.lds, 2048, S, E); }
            REPEND SEAM(5);
            REPBEGIN(6) if (EN(6) && PH(6)) { SITE(L); phase_prepa(L, rep ? PREP_REP_MODE : 7); };
            REPEND SEAM(6);
            REPBEGIN(7) if (EN(7) && PH(7)) {
                pg8::MultiOrder<false> S{WSP(bf16_t, WS_CQN), WSP(bf16_t, WS_CKVN), WSP(bf16_t, WS_WUV + wl), WSP(bf16_t, WS_WUQ + wl), WSP(bf16_t, WS_WUK + wl), WSP(bf16_t, WS_CKVN),
                                         MROWS / 256, 1536 / 256, MKV / 256, 1024 / 256, 1024 / 256, MKV / 256, 3, C.G, C.bid};
                pg8::EpiBf E{WSP(bf16_t, WS_QRAW), WSP(bf16_t, WS_KNRAW), WSP(bf16_t, WS_VMT), 1536, 1024, MKV};
                pg8::gemm_phase<pg8::EpiBf, pg8::MultiOrder<false>, true, true>(C.lds, 512, S, E); }
            REPEND SEAM(7);
            REPBEGIN(8) if (EN(8) && PH(8)) { SITE(L); phase_prepb(L); };
            REPEND SEAM(8);
            REPBEGIN(9) if (EN(9) && PH(9)) { SITE(L); phase_mixer(L, rep, rep ? (PREP_REP_MODE & 7) : 7, PREP_REP_MODE >> 4); };
            REPEND SEAM(9);
            REPBEGIN(10) if (EN(10) && PH(10)) { SITE(L); phase_post(L); };
            REPEND SEAM(10);
            REPBEGIN(11) if (EN(11) && PH(11)) {
                pg8::MultiOrder<true> S{WSP(bf16_t, WS_OMLA), WSP(bf16_t, WS_OGN), WSP(bf16_t, WS_OSWA), WSP(bf16_t, WS_WBR + wl), WSP(bf16_t, WS_WBR + SZ_WBR + wl), WSP(bf16_t, WS_WBR + 2 * SZ_WBR + wl),
                                        MROWS / 256, 2048 / 256, MROWS / 256, 2048 / 256, MROWS / 256, 2048 / 256, 3, C.G, C.bid};
                pg8::EpiBranch E{IN + C_GATE, NIN, H};
                pg8::gemm_phase<pg8::EpiBranch, pg8::MultiOrder<true>, true, true>(C.lds, 1024, S, E); }
            REPEND SEAM(11);
            REPBEGIN(12) if (EN(12) && PH(12)) { pg8::MultiOrder<false> S{H, H, H, WSP(bf16_t, WS_WOUT + wl), nullptr, nullptr, MROWS / 256, 2048 / 256, 0, 0, 0, 0, 1, C.G, C.bid}; pg8::EpiResid E{C.out, C.out, C.out, modl, 5, rep ? 0.f : 1.0f};
                pg8::gemm_phase<pg8::EpiResid, pg8::MultiOrder<false>, true, true>(C.lds, 2048, S, E); }
            REPEND SEAM(12);
        }
#undef PH
#undef EN
#undef SEAM
    }
}

extern "C" void kernel_launch(void* const* d_in, const int* in_sizes, int n_in, void* d_out, int out_size, void* d_ws, size_t ws_size, hipStream_t stream) {
    static int grid = 0;
    if (grid == 0) {
        if (n_in != 37 || out_size != (int)O_END || ws_size < WS_END) { fprintf(stderr, "kernel_launch: unexpected sizes n_in %d out %d ws %zu (need %zu)\n", n_in, out_size, ws_size, (size_t)WS_END); grid = -1; return; }
        int dev = 0, cus = 0, per_cu = 0;
        if (hipGetDevice(&dev) != hipSuccess || hipDeviceGetAttribute(&cus, hipDeviceAttributeMultiprocessorCount, dev) != hipSuccess) { grid = -1; return; }
        if (hipFuncSetAttribute((const void*)fwd_kernel, hipFuncAttributeMaxDynamicSharedMemorySize, LDS_BYTES) != hipSuccess) { fprintf(stderr, "kernel_launch: hipFuncSetAttribute failed\n"); grid = -1; return; }
        if (hipOccupancyMaxActiveBlocksPerMultiprocessor(&per_cu, (const void*)fwd_kernel, NTHR, LDS_BYTES) != hipSuccess || per_cu < 1) { fprintf(stderr, "kernel_launch: occupancy query says %d blocks per CU\n", per_cu); }
        (void)hipGetLastError();
        grid = cus;
    }
    if (grid < 0) return;
    if (hipMemsetAsync((char*)d_ws + WS_CTL, 0, SZ_CTL, stream) != hipSuccess) return;
    Args a{};
    for (int i = 0; i < 37; ++i) a.in[i] = (const float*)d_in[i];
    a.out = (float*)d_out; a.ws = (unsigned char*)d_ws;
#if MK_PER_PHASE
    for (int p = 0; p < 2 * NPH; ++p) { a.ph_lo = p; a.ph_hi = p + 1; hipLaunchKernelGGL(fwd_kernel, dim3(grid), dim3(NTHR), LDS_BYTES, stream, a); }
#else
    a.ph_lo = 0; a.ph_hi = 2 * NPH;
    hipLaunchKernelGGL(fwd_kernel, dim3(grid), dim3(NTHR), LDS_BYTES, stream, a);
#endif
    (void)in_sizes;
}
```

```cpp
#include <hip/hip_runtime.h>
#include <cstdio>
#include <cstdint>

#define LAS __attribute__((address_space(3)))
typedef unsigned short bf16_t;
typedef short bf16x8 __attribute__((ext_vector_type(8)));
typedef float f32x4 __attribute__((ext_vector_type(4)));
typedef float f32x2 __attribute__((ext_vector_type(2)));
typedef unsigned u32x4 __attribute__((ext_vector_type(4)));
typedef unsigned u32x2 __attribute__((ext_vector_type(2)));
typedef LAS unsigned char* ldsp;

__device__ __forceinline__ unsigned cvt_pk_bf16(float lo, float hi) { unsigned r; asm volatile("v_cvt_pk_bf16_f32 %0, %1, %2" : "=v"(r) : "v"(lo), "v"(hi)); return r; }
__device__ __forceinline__ float bf_lo(unsigned w) { return __uint_as_float(w << 16); }
__device__ __forceinline__ float bf_hi(unsigned w) { return __uint_as_float(w & 0xffff0000u); }
__device__ __forceinline__ float bf1(bf16_t b) { return __uint_as_float(((unsigned)b) << 16); }
__device__ __forceinline__ bf16_t f2bf(float f) { return (bf16_t)(cvt_pk_bf16(f, 0.f) & 0xffffu); }
__device__ __forceinline__ float fast_rcp(float x) { return __builtin_amdgcn_rcpf(x); }
__device__ __forceinline__ float fast_exp2(float x) { return __builtin_amdgcn_exp2f(x); }
__device__ __forceinline__ float sigmoidf_(float a) { return fast_rcp(1.0f + fast_exp2(-1.44269504f * a)); }
__device__ __forceinline__ float siluf_(float a) { return a * sigmoidf_(a); }
__device__ __forceinline__ float wave_sum(float v) {
#pragma unroll
    for (int o = 1; o < 64; o <<= 1) v += __shfl_xor(v, o);
    return v;
}
namespace pg8 {
#define PG8_LAS __attribute__((address_space(3)))
constexpr int BM = 256, BK = 64, HALF = 128, HTB = HALF * BK * 2  , STAGE_BYTES = 8 * HTB, NXCD = 8, WGM = 8;

__host__ __device__ __forceinline__ int lds_byte(int r, int c) { const int st = (r >> 4) * 2 + (c >> 5), rr = r & 15, cc = c & 31, ob = rr * 64 + cc * 2; return st * 1024 + (ob ^ (((ob >> 9) & 1) << 5)); }
__host__ __device__ __forceinline__ void stage_rc(int b, int& R, int& C) { const int st = b / 1024, sb = b % 1024, swz = sb ^ (((sb >> 9) & 1) << 5); R = (st >> 1) * 16 + swz / 64; C = (st & 1) * 32 + (swz % 64) / 2; }
__host__ __device__ __forceinline__ int perm32(int rho) { const int n = rho >> 4, i = rho & 15; return 8 * (i >> 2) + 4 * n + (i & 3); }

template <class T> __device__ __forceinline__ T sel3(int s, T a, T b, T c) { T r = a; if (s == 1) r = b; if (s == 2) r = c; return r; }
struct Unit { int pm, pn, sub; };
__device__ __forceinline__ void tile_of(int wgid, int nwg, int nM, int nN, int& pm, int& pn) {
    { const int q = nwg / NXCD, r = nwg % NXCD, xcd = wgid % NXCD, off = wgid / NXCD; wgid = (xcd < r ? xcd * (q + 1) : r * (q + 1) + (xcd - r) * q) + off; }
    const int nig = WGM * nN, gid = wgid / nig, fm = gid * WGM, gsz = (nM - fm) < WGM ? (nM - fm) : WGM;
    pm = fm + ((wgid % nig) % gsz); pn = (wgid % nig) / gsz;
}
template <bool TILEMAJOR> struct MultiOrder {
    const bf16_t* A0; const bf16_t* A1; const bf16_t* A2; const bf16_t* B0; const bf16_t* B1; const bf16_t* B2;
    int nM0, nN0, nM1, nN1, nM2, nN2, nsub, G, c;
    __device__ __forceinline__ bool next(int i, Unit& u) const {
        if (TILEMAJOR) { const int j = i / nsub, s = i - j * nsub; const long L = (long)j * G + c; const int nwg = nM0 * nN0; if (L >= nwg) return false;
            u.sub = s; tile_of((int)L, nwg, nM0, nN0, u.pm, u.pn); return true; }
        long L = (long)i * G + c; const int w0 = nM0 * nN0, w1 = nM1 * nN1, w2 = nM2 * nN2;
        if (L < w0) { u.sub = 0; tile_of((int)L, w0, nM0, nN0, u.pm, u.pn); return true; } L -= w0;
        if (L < w1) { u.sub = 1; tile_of((int)L, w1, nM1, nN1, u.pm, u.pn); return true; } L -= w1;
        if (L < w2) { u.sub = 2; tile_of((int)L, w2, nM2, nN2, u.pm, u.pn); return true; }
        return false;
    }
    __device__ __forceinline__ const char* a_tile(const Unit& u, size_t tstep) const { const bf16_t* p = sel3<const bf16_t*>(u.sub, A0, A1, A2); return (const char*)p + (size_t)u.pm * tstep; }
    __device__ __forceinline__ const char* b_tile(const Unit& u, size_t tstep) const { const bf16_t* p = sel3<const bf16_t*>(u.sub, B0, B1, B2); return (const char*)p + (size_t)u.pn * tstep; }
    __device__ __forceinline__ void a_ready(const Unit&) const {}
    __device__ __forceinline__ void done(const Unit&) const {}
};

__device__ __forceinline__ int cond_of_tile(int pm) { return pm < 16 ? 0 : 1 + ((pm - 16) >> 3); }

struct EpiSwiglu {
    static constexpr bool PERM = true, AFTER_DRAIN = false, KEEP_ACC = false;
    bf16_t* O; int ldc; int skip;
    __device__ __forceinline__ void operator()(const f32x4 (&acc)[2][2][4][2], const Unit& u, int wr, int wc, int fr, int fq) const {
        if (skip) { asm volatile("" :: "v"(acc[0][0][0][0]), "v"(acc[1][1][3][1])); return; }
        const int row0 = u.pm * BM + wr * 64 + fr, col0 = u.pn * HALF + wc * 32 + 8 * fq;
#pragma unroll
        for (int ai = 0; ai < 2; ++ai)
#pragma unroll
            for (int m = 0; m < 4; ++m) {
                bf16_t* rowp = O + (size_t)(row0 + ai * HALF + m * 16) * ldc + col0;
                f32x4 r0, r1;
#pragma unroll
                for (int j = 0; j < 4; ++j) { r0[j] = siluf_(acc[ai][0][m][0][j]) * acc[ai][1][m][0][j]; r1[j] = siluf_(acc[ai][0][m][1][j]) * acc[ai][1][m][1][j]; }
                u32x4 w; w.x = cvt_pk_bf16(r0[0], r0[1]); w.y = cvt_pk_bf16(r0[2], r0[3]); w.z = cvt_pk_bf16(r1[0], r1[1]); w.w = cvt_pk_bf16(r1[2], r1[3]);
                *(u32x4*)rowp = w;
            }
    }
};
struct EpiResid {
    static constexpr bool PERM = false, AFTER_DRAIN = false, KEEP_ACC = false;
    float* X; const float* Xin0; const float* Xin1; const float* modl; int gidx; float coef;
    __device__ __forceinline__ void operator()(const f32x4 (&acc)[2][2][4][2], const Unit& u, int wr, int wc, int fr, int fq) const {
        const int row0 = u.pm * BM + wr * 64 + fr, col0 = u.pn * BM + wc * 32 + 4 * fq;
        const float* g = modl + cond_of_tile(u.pm) * 18432 + gidx * 2048 + col0;
        f32x4 gv[2][2];
#pragma unroll
        for (int bj = 0; bj < 2; ++bj)
#pragma unroll
            for (int n = 0; n < 2; ++n) gv[bj][n] = *(const f32x4*)(g + bj * HALF + n * 16) * coef;
#pragma unroll
        for (int ai = 0; ai < 2; ++ai)
#pragma unroll
            for (int m = 0; m < 4; ++m) { const size_t ro = (size_t)(row0 + ai * HALF + m * 16) * 2048 + col0; float* rowp = X + ro; const float* srcp = (u.pm < 16 ? Xin0 : Xin1) + ro;
#pragma unroll
                for (int bj = 0; bj < 2; ++bj)
#pragma unroll
                    for (int n = 0; n < 2; ++n) { *(f32x4*)(rowp + bj * HALF + n * 16) = *(const f32x4*)(srcp + bj * HALF + n * 16) + gv[bj][n] * acc[ai][bj][m][n]; } }
    }
};
struct EpiIn {
    static constexpr bool PERM = true, AFTER_DRAIN = false, KEEP_ACC = false;
    bf16_t* IN; float* INF; bf16_t* VT; int skip;
    __device__ __forceinline__ void operator()(const f32x4 (&acc)[2][2][4][2], const Unit& u, int wr, int wc, int fr, int fq) const {
        if (skip) { asm volatile("" :: "v"(acc[0][0][0][0]), "v"(acc[1][1][3][1])); return; }
        const int row0 = u.pm * BM + wr * 64 + fr, cin = wc * 32 + 8 * fq, pn = u.pn;
        if (u.sub == 1) {
#pragma unroll
            for (int ai = 0; ai < 2; ++ai)
#pragma unroll
                for (int m = 0; m < 4; ++m) { bf16_t* rowp = VT + (size_t)(row0 + ai * HALF + m * 16) * 8192 + pn * BM + cin;
#pragma unroll
                    for (int bj = 0; bj < 2; ++bj) { const f32x4 v0 = acc[ai][bj][m][0], v1 = acc[ai][bj][m][1];
                        u32x4 w; w.x = cvt_pk_bf16(v0[0], v0[1]); w.y = cvt_pk_bf16(v0[2], v0[3]); w.z = cvt_pk_bf16(v1[0], v1[1]); w.w = cvt_pk_bf16(v1[2], v1[3]);
                        *(u32x4*)(rowp + bj * HALF) = w; } }
            return; }
        int fbase = -1;
        if (pn == 2) fbase = 0; else if (pn == 3) fbase = 256; else if (pn == 4) fbase = 512; else if (pn == 17) fbase = 768; else if (pn == 18) fbase = 1024;
        if (fbase >= 0) {
#pragma unroll
            for (int ai = 0; ai < 2; ++ai)
#pragma unroll
                for (int m = 0; m < 4; ++m) { float* rowp = INF + (size_t)(row0 + ai * HALF + m * 16) * 1280 + fbase + cin;
#pragma unroll
                    for (int bj = 0; bj < 2; ++bj) { *(f32x4*)(rowp + bj * HALF) = acc[ai][bj][m][0]; *(f32x4*)(rowp + bj * HALF + 4) = acc[ai][bj][m][1]; } }
        } else {
#pragma unroll
            for (int ai = 0; ai < 2; ++ai)
#pragma unroll
                for (int m = 0; m < 4; ++m) { bf16_t* rowp = IN + (size_t)(row0 + ai * HALF + m * 16) * 11008 + pn * BM + cin;
#pragma unroll
                    for (int bj = 0; bj < 2; ++bj) { const f32x4 v0 = acc[ai][bj][m][0], v1 = acc[ai][bj][m][1];
                        u32x4 w; w.x = cvt_pk_bf16(v0[0], v0[1]); w.y = cvt_pk_bf16(v0[2], v0[3]); w.z = cvt_pk_bf16(v1[0], v1[1]); w.w = cvt_pk_bf16(v1[2], v1[3]);
                        *(u32x4*)(rowp + bj * HALF) = w; } }
        }
    }
};
struct EpiBf {
    static constexpr bool PERM = true, AFTER_DRAIN = false, KEEP_ACC = false;
    bf16_t* O0; bf16_t* O1; bf16_t* O2; int ld0, ld1, ld2;
    __device__ __forceinline__ void operator()(const f32x4 (&acc)[2][2][4][2], const Unit& u, int wr, int wc, int fr, int fq) const {
        const int row0 = u.pm * BM + wr * 64 + fr, col0 = u.pn * BM + wc * 32 + 8 * fq;
        bf16_t* O = sel3<bf16_t*>(u.sub, O0, O1, O2); const int ldc = sel3<int>(u.sub, ld0, ld1, ld2);
#pragma unroll
        for (int ai = 0; ai < 2; ++ai)
#pragma unroll
            for (int m = 0; m < 4; ++m) { bf16_t* rowp = O + (size_t)(row0 + ai * HALF + m * 16) * ldc + col0;
#pragma unroll
                for (int bj = 0; bj < 2; ++bj) { const f32x4 v0 = acc[ai][bj][m][0], v1 = acc[ai][bj][m][1];
                    u32x4 w; w.x = cvt_pk_bf16(v0[0], v0[1]); w.y = cvt_pk_bf16(v0[2], v0[3]); w.z = cvt_pk_bf16(v1[0], v1[1]); w.w = cvt_pk_bf16(v1[2], v1[3]);
                    *(u32x4*)(rowp + bj * HALF) = w; } }
    }
};
struct EpiBranch {
    static constexpr bool PERM = true, AFTER_DRAIN = false, KEEP_ACC = true;
    const bf16_t* gate0; int ldg; bf16_t* OUT;
    __device__ __forceinline__ float ratio(float a, float b, bool last) const {
        a = fminf(fmaxf(a, -30.f), 30.f); b = fminf(fmaxf(b, -30.f), 30.f);
        const float ia = fast_rcp(1.0f + fast_exp2(-1.44269504f * a)); return last ? ia : ia * (1.0f + fast_exp2(-1.44269504f * b)); }
    __device__ __forceinline__ void operator()(f32x4 (&acc)[2][2][4][2], const Unit& u, int wr, int wc, int fr, int fq) const {
        const int row0 = u.pm * BM + wr * 64 + fr, col0 = u.pn * BM + wc * 32 + 8 * fq; const int s = u.sub; const bool last = s == 2;
        const bf16_t* ga = gate0 + s * 2048; const bf16_t* gb = gate0 + (last ? s : s + 1) * 2048;
#pragma unroll
        for (int ai = 0; ai < 2; ++ai)
#pragma unroll
            for (int m = 0; m < 4; ++m) { const size_t row = (size_t)(row0 + ai * HALF + m * 16);
#pragma unroll
                for (int bj = 0; bj < 2; ++bj) {
                    const u32x4 wa = __builtin_nontemporal_load((const u32x4*)(ga + row * ldg + col0 + bj * HALF)), wb = __builtin_nontemporal_load((const u32x4*)(gb + row * ldg + col0 + bj * HALF));
                    f32x4 r0, r1;
                    r0[0] = ratio(bf_lo(wa.x), bf_lo(wb.x), last); r0[1] = ratio(bf_hi(wa.x), bf_hi(wb.x), last); r0[2] = ratio(bf_lo(wa.y), bf_lo(wb.y), last); r0[3] = ratio(bf_hi(wa.y), bf_hi(wb.y), last);
                    r1[0] = ratio(bf_lo(wa.z), bf_lo(wb.z), last); r1[1] = ratio(bf_hi(wa.z), bf_hi(wb.z), last); r1[2] = ratio(bf_lo(wa.w), bf_lo(wb.w), last); r1[3] = ratio(bf_hi(wa.w), bf_hi(wb.w), last);
                    const f32x4 v0 = acc[ai][bj][m][0] * r0, v1 = acc[ai][bj][m][1] * r1;
                    acc[ai][bj][m][0] = v0; acc[ai][bj][m][1] = v1;
                    if (last) { u32x4 w; w.x = cvt_pk_bf16(v0[0], v0[1]); w.y = cvt_pk_bf16(v0[2], v0[3]); w.z = cvt_pk_bf16(v1[0], v1[1]); w.w = cvt_pk_bf16(v1[2], v1[3]);
                        *(u32x4*)(OUT + row * 2048 + col0 + bj * HALF) = w; }
                } }
    }
};
template <class Epi, class Sched, bool ALIGN_EPI = false, bool SP2 = false>
__device__ __forceinline__ void gemm_phase(PG8_LAS unsigned char* lds, const int K, const Sched& S, const Epi& E) {
    int tid_ = threadIdx.x; asm volatile("" : "+v"(tid_));
    const int tid = tid_, wid = __builtin_amdgcn_readfirstlane(tid >> 6), lane = tid & 63, wr = wid >> 2, wc = wid & 3, fr = lane & 15, fq = lane >> 4;
    const int nt = K / BK;
    unsigned voffA[2], voffB[2];
#pragma unroll
    for (int i = 0; i < 2; ++i) { int R, C; stage_rc(tid * 16 + i * 8192, R, C); const int Rb = Epi::PERM ? ((R & ~31) + perm32(R & 31)) : R;
        voffA[i] = (unsigned)(R * K + C) * 2u; voffB[i] = (unsigned)(Rb * K + C) * 2u; }
    const size_t kstep = (size_t)(BK * 2);
    const size_t hstep = (size_t)HALF * K * 2;
    const size_t tstep = 2 * hstep;
    const unsigned ldsw = (unsigned)wid * 1024u;
    const int aoff = lds_byte(wr * 64 + fr, fq * 8), boff = lds_byte(wc * 32 + fr, fq * 8);
#define PG8_SA(b, h) (((b) * 2 + (h)) * HTB)
#define PG8_SB(b, h) ((4 + (b) * 2 + (h)) * HTB)
#define PG8_STAGE(bufoff, gbase, voff) do { _Pragma("unroll") for (int _i = 0; _i < 2; ++_i) \
        __builtin_amdgcn_global_load_lds((const unsigned*)((const char*)(gbase) + (voff)[_i]), (PG8_LAS unsigned*)(lds + (bufoff) + ldsw + _i * 8192), 16, 0, 0); } while (0)
#define PG8_LDA(dst, b, h) do { _Pragma("unroll") for (int m = 0; m < 4; ++m) _Pragma("unroll") for (int k = 0; k < 2; ++k) dst[m][k] = *(const PG8_LAS bf16x8*)(lds + PG8_SA(b, h) + aoff + m * 2048 + k * 1024); } while (0)
#define PG8_LDB(dst, b, h) do { _Pragma("unroll") for (int n = 0; n < 2; ++n) _Pragma("unroll") for (int k = 0; k < 2; ++k) dst[n][k] = *(const PG8_LAS bf16x8*)(lds + PG8_SB(b, h) + boff + n * 2048 + k * 1024); } while (0)
#define PG8_MMA(ai, bj, At, Bt) do { __builtin_amdgcn_s_setprio(1); _Pragma("unroll") for (int m = 0; m < 4; ++m) _Pragma("unroll") for (int n = 0; n < 2; ++n) _Pragma("unroll") for (int k = 0; k < 2; ++k) \
        acc[ai][bj][m][n] = __builtin_amdgcn_mfma_f32_16x16x32_bf16(Bt[n][k], At[m][k], acc[ai][bj][m][n], 0, 0, 0); __builtin_amdgcn_s_setprio(0); } while (0)
#define PG8_WAIT_V(n) asm volatile("s_waitcnt vmcnt(" #n ")" ::: "memory")
#define PG8_WAIT_L(n) asm volatile("s_waitcnt lgkmcnt(" #n ")" ::: "memory")
#define PG8_BAR __builtin_amdgcn_s_barrier()
#define PG8_SCHED __builtin_amdgcn_sched_barrier(0)
    Unit cur, nxt; int ui = 0;
    if (!S.next(0, cur)) return;
    f32x4 acc[2][2][4][2];
#pragma unroll
    for (int a = 0; a < 2; ++a)
#pragma unroll
        for (int b = 0; b < 2; ++b)
#pragma unroll
            for (int m = 0; m < 4; ++m)
#pragma unroll
                for (int n = 0; n < 2; ++n) acc[a][b][m][n] = (f32x4){0.f, 0.f, 0.f, 0.f};
    bf16x8 At[4][2], B0[2][2], B1[2][2];
    const char* cA = S.a_tile(cur, tstep); const char* cB = S.b_tile(cur, tstep);
    S.a_ready(cur);
    if constexpr (SP2) {
        PG8_STAGE(PG8_SB(0, 0), cB, voffB); PG8_STAGE(PG8_SB(0, 1), cB + hstep, voffB); PG8_STAGE(PG8_SA(0, 0), cA, voffA); PG8_STAGE(PG8_SA(0, 1), cA + hstep, voffA);
        if (wr == 1) PG8_BAR;
        PG8_WAIT_V(2); PG8_BAR;
        PG8_STAGE(PG8_SB(1, 0), cB + kstep, voffB); PG8_STAGE(PG8_SA(1, 0), cA + kstep, voffA); PG8_STAGE(PG8_SB(1, 1), cB + hstep + kstep, voffB);
        PG8_WAIT_V(6); PG8_BAR;
    } else {
        PG8_STAGE(PG8_SB(0, 0), cB, voffB); PG8_STAGE(PG8_SA(0, 0), cA, voffA); PG8_STAGE(PG8_SB(0, 1), cB + hstep, voffB); PG8_STAGE(PG8_SA(0, 1), cA + hstep, voffA);
        if (wr == 1) PG8_BAR;
        PG8_WAIT_V(4); PG8_BAR;
        PG8_STAGE(PG8_SB(1, 0), cB + kstep, voffB); PG8_STAGE(PG8_SA(1, 0), cA + kstep, voffA); PG8_STAGE(PG8_SB(1, 1), cB + hstep + kstep, voffB);
        PG8_WAIT_V(6); PG8_BAR;
    }
    for (;;) {
        const bool has_next = S.next(ui + 1, nxt);
        const char* nA = has_next ? S.a_tile(nxt, tstep) : cA; const char* nB = has_next ? S.b_tile(nxt, tstep) : cB;
        for (int t = 0; t < nt; t += 2) {
            const bool last = (t == nt - 2);
            const char* a1 = cA + (size_t)(t + 1) * kstep;
            const char* a2 = last ? nA : cA + (size_t)(t + 2) * kstep; const char* b2 = last ? nB : cB + (size_t)(t + 2) * kstep;
            const char* a3 = a2 + kstep; const char* b3 = b2 + kstep;
            if (last && has_next) S.a_ready(nxt);
            if constexpr (SP2) {
            PG8_LDB(B0, 0, 0); PG8_LDB(B1, 0, 1); PG8_SCHED; PG8_LDA(At, 0, 0); PG8_STAGE(PG8_SA(1, 1), a1 + hstep, voffA);
            PG8_WAIT_V(8); PG8_WAIT_L(0); PG8_BAR; PG8_MMA(0, 0, At, B0); PG8_MMA(0, 1, At, B1); PG8_BAR; PG8_SCHED;
            PG8_LDA(At, 0, 1); PG8_STAGE(PG8_SB(0, 0), b2, voffB); PG8_STAGE(PG8_SB(0, 1), b2 + hstep, voffB); PG8_STAGE(PG8_SA(0, 0), a2, voffA);
            PG8_WAIT_V(8); PG8_WAIT_L(0); PG8_BAR; PG8_MMA(1, 0, At, B0); PG8_MMA(1, 1, At, B1); PG8_BAR; PG8_SCHED;
            PG8_LDB(B0, 1, 0); PG8_LDB(B1, 1, 1); PG8_SCHED; PG8_LDA(At, 1, 0); PG8_STAGE(PG8_SA(0, 1), a2 + hstep, voffA);
            PG8_WAIT_V(8); PG8_WAIT_L(0); PG8_BAR; PG8_MMA(0, 0, At, B0); PG8_MMA(0, 1, At, B1); PG8_BAR; PG8_SCHED;
            PG8_LDA(At, 1, 1); PG8_STAGE(PG8_SB(1, 0), b3, voffB); PG8_STAGE(PG8_SB(1, 1), b3 + hstep, voffB); PG8_STAGE(PG8_SA(1, 0), a3, voffA);
            PG8_WAIT_V(8); PG8_WAIT_L(0); PG8_BAR; PG8_MMA(1, 0, At, B0); PG8_MMA(1, 1, At, B1); PG8_BAR; PG8_SCHED;
            } else {
            PG8_LDB(B0, 0, 0); PG8_SCHED; PG8_LDA(At, 0, 0); PG8_STAGE(PG8_SA(1, 1), a1 + hstep, voffA);
            PG8_WAIT_L(8); PG8_BAR; PG8_WAIT_L(0); PG8_MMA(0, 0, At, B0); PG8_BAR; PG8_SCHED;
            PG8_LDB(B1, 0, 1); PG8_STAGE(PG8_SB(0, 0), b2, voffB);
            PG8_BAR; PG8_WAIT_L(0); PG8_MMA(0, 1, At, B1); PG8_BAR;
            PG8_LDA(At, 0, 1); PG8_STAGE(PG8_SA(0, 0), a2, voffA);
            PG8_BAR; PG8_WAIT_L(0); PG8_MMA(1, 0, At, B0); PG8_BAR; PG8_SCHED;
            PG8_STAGE(PG8_SB(0, 1), b2 + hstep, voffB);
            PG8_WAIT_V(6); PG8_BAR; PG8_MMA(1, 1, At, B1); PG8_BAR;
            PG8_LDB(B0, 1, 0); PG8_SCHED; PG8_LDA(At, 1, 0); PG8_STAGE(PG8_SA(0, 1), a2 + hstep, voffA);
            PG8_WAIT_L(8); PG8_BAR; PG8_WAIT_L(0); PG8_MMA(0, 0, At, B0); PG8_BAR; PG8_SCHED;
            PG8_LDB(B1, 1, 1); PG8_STAGE(PG8_SB(1, 0), b3, voffB);
            PG8_BAR; PG8_WAIT_L(0); PG8_MMA(0, 1, At, B1); PG8_BAR;
            PG8_LDA(At, 1, 1); PG8_STAGE(PG8_SA(1, 0), a3, voffA);
            PG8_BAR; PG8_WAIT_L(0); PG8_MMA(1, 0, At, B0); PG8_BAR; PG8_SCHED;
            PG8_STAGE(PG8_SB(1, 1), b3 + hstep, voffB);
            PG8_WAIT_V(6); PG8_BAR; PG8_MMA(1, 1, At, B1); PG8_BAR;
            }
        }
        if constexpr (ALIGN_EPI) { if (wr == 0) PG8_BAR; }
        if constexpr (!Epi::AFTER_DRAIN) { E(acc, cur, wr, wc, fr, fq); S.done(cur); }
        if (!has_next) break;
        if (!(Epi::KEEP_ACC && nxt.sub != 0)) {
#pragma unroll
        for (int a = 0; a < 2; ++a)
#pragma unroll
            for (int b = 0; b < 2; ++b)
#pragma unroll
                for (int m = 0; m < 4; ++m)
#pragma unroll
                    for (int n = 0; n < 2; ++n) acc[a][b][m][n] = (f32x4){0.f, 0.f, 0.f, 0.f};
        }
        cur = nxt; cA = nA; cB = nB; ++ui;
        if constexpr (ALIGN_EPI) { if (wr == 1) PG8_BAR; }
    }
    PG8_WAIT_V(0);
    if constexpr (!ALIGN_EPI) { if (wr == 0) PG8_BAR; }
    PG8_BAR;
    if constexpr (Epi::AFTER_DRAIN) { E.fused(acc, cur, wr, wc, fr, fq, lds, wid, lane); S.done(cur); }
#undef PG8_SA
#undef PG8_SB
#undef PG8_STAGE
#undef PG8_LDA
#undef PG8_LDB
#undef PG8_MMA
#undef PG8_WAIT_V
#undef PG8_WAIT_L
#undef PG8_BAR
#undef PG8_SCHED
}
}

constexpr int NWAVES = 8, NTHR = 512;
constexpr int D = 2048, MROWS = 8192, MPROMPT = 4096, DFF = 5632, NGU = 11264, NMOD = 18432;
constexpr int NIN = 11008, LDF = 1280, NSW = 1280, MKV = 8704;
constexpr int C_CQ = 0, C_GQ = 1280, C_GK = 1792, C_GOUT = 2304, C_SQ = 3328, C_GATE = 4864;
constexpr int F_CKV = 0, F_KPE = 512, F_GG = 576, F_SK = 768, F_SV = 1024;
constexpr float EPS = 1e-6f, LOG2E = 1.4426950408889634f;
constexpr float MLA_QSCALE = 0.07216878364870322f * LOG2E;
constexpr float SWA_QSCALE = 0.125f * LOG2E;
constexpr float GLA_QSCALE = 0.08838834764831845f;
constexpr size_t O_X = 0, O_CKV = 16777216, O_KPE = 20971520, O_SK = 21495808, O_SV = 23592960, O_SG = 25690112, O_END = 34078720;
constexpr size_t al4k(size_t x) { return (x + 4095) & ~(size_t)4095; }
constexpr size_t WS_CTL = 0, SZ_CTL = 1u << 20;
constexpr size_t WS_MOD = WS_CTL + SZ_CTL;                 constexpr size_t SZ_MOD = al4k((size_t)2 * 3 * NMOD * 4);
constexpr size_t WS_ROPE = WS_MOD + SZ_MOD;                constexpr size_t SZ_ROPE = al4k(2 * 1024 * 4);
constexpr size_t WS_DEC = WS_ROPE + SZ_ROPE;               constexpr size_t SZ_DEC = al4k((size_t)128 * 2 * 512 * 4);
constexpr size_t WS_WGU1 = WS_DEC + SZ_DEC;                constexpr size_t SZ_WGU = (size_t)NGU * D * 2;
constexpr size_t WS_WD1 = WS_WGU1 + SZ_WGU;                constexpr size_t SZ_WD = (size_t)D * DFF * 2;
constexpr size_t WS_WGU2 = WS_WD1 + SZ_WD;
constexpr size_t WS_WD2 = WS_WGU2 + SZ_WGU;
constexpr size_t WS_WIN = WS_WD2 + SZ_WD;                  constexpr size_t SZ_WIN = (size_t)NIN * D * 2;
constexpr size_t WS_WINS = WS_WIN + SZ_WIN;                constexpr size_t SZ_WINS = (size_t)NSW * D * 2;
constexpr size_t WS_WUQ = WS_WINS + SZ_WINS;               constexpr size_t SZ_WUQ = (size_t)1536 * 512 * 2;
constexpr size_t WS_WUK = WS_WUQ + SZ_WUQ;                 constexpr size_t SZ_WUK = (size_t)1024 * 512 * 2;
constexpr size_t WS_WUV = WS_WUK + SZ_WUK;
constexpr size_t WS_WBR = WS_WUV + SZ_WUK;                 constexpr size_t SZ_WBR = (size_t)2048 * 1024 * 2;
constexpr size_t WS_WOUT = WS_WBR + 3 * SZ_WBR;            constexpr size_t SZ_WOUT = (size_t)2048 * 2048 * 2;
constexpr size_t SZ_WLAYER = WS_WOUT + SZ_WOUT - WS_WGU1;
constexpr size_t WS_H = WS_WGU1 + 2 * SZ_WLAYER;                 constexpr size_t SZ_H = (size_t)MROWS * D * 2;
constexpr size_t WS_ACT = WS_H + SZ_H;                     constexpr size_t SZ_ACT = (size_t)MROWS * DFF * 2;
constexpr size_t WS_MF = WS_ACT;                           constexpr size_t SZ_MF = (size_t)MROWS * 2048 * 4;
constexpr size_t WS_QRAW = WS_MF + SZ_MF;                  constexpr size_t SZ_QRAW = (size_t)MROWS * 1536 * 2;
static_assert(SZ_MF + SZ_QRAW <= SZ_ACT, "alias");
constexpr size_t WS_IN = WS_ACT + SZ_ACT;                  constexpr size_t SZ_IN = (size_t)MROWS * NIN * 2;
constexpr size_t WS_INF = WS_IN + SZ_IN;                   constexpr size_t SZ_INF = (size_t)MROWS * LDF * 4;
constexpr size_t WS_VT = WS_INF + SZ_INF;                  constexpr size_t SZ_VT = (size_t)NSW * MROWS * 2;
constexpr size_t WS_CQN = WS_VT + SZ_VT;                   constexpr size_t SZ_CQN = (size_t)MROWS * 512 * 2;
constexpr size_t WS_CKVN = WS_CQN + SZ_CQN;                constexpr size_t SZ_CKVN = (size_t)MKV * 512 * 2;
constexpr size_t WS_KNRAW = WS_CKVN + SZ_CKVN;             constexpr size_t SZ_KNRAW = (size_t)MKV * 1024 * 2;
constexpr size_t WS_QM = WS_KNRAW + SZ_KNRAW;              constexpr size_t SZ_QM = (size_t)MROWS * 1536 * 2;
constexpr size_t WS_KM = WS_QM + SZ_QM;                    constexpr size_t SZ_KM = (size_t)MKV * 1536 * 2;
constexpr size_t WS_VMT = WS_KM + SZ_KM;                   constexpr size_t SZ_VMT = (size_t)1024 * MKV * 2;
constexpr size_t WS_QS = WS_VMT + SZ_VMT;                  constexpr size_t SZ_QS = (size_t)MROWS * 1024 * 2;
constexpr size_t WS_KS = WS_QS + SZ_QS;                    constexpr size_t SZ_KS = (size_t)MKV * 256 * 2;
constexpr size_t WS_VSCT = WS_KS + SZ_KS;                  constexpr size_t SZ_VSCT = (size_t)2 * 256 * 256 * 2;
constexpr size_t WS_QG = WS_VSCT + SZ_VSCT;                constexpr size_t SZ_G1 = (size_t)MROWS * 512 * 2;
constexpr size_t WS_KG = WS_QG + 2 * SZ_G1;
constexpr size_t WS_KHT = WS_KG + 2 * SZ_G1;
constexpr size_t WS_OG = WS_KHT + 2 * SZ_G1;               constexpr size_t SZ_OG1 = (size_t)MROWS * 1024 * 4;
constexpr size_t WS_OMLA = WS_OG + 2 * SZ_OG1;             constexpr size_t SZ_O = (size_t)MROWS * 1024 * 2;
constexpr size_t WS_OGN = WS_OMLA + SZ_O;
constexpr size_t WS_OSWA = WS_OGN + SZ_O;
constexpr size_t WS_END = WS_OSWA + SZ_O;
static_assert(WS_END < (size_t)1150 * 1024 * 1024, "workspace budget");
constexpr int CW_BAR = 4096, CW_QUEUE = 16384, CW_PANEL = 32768;
constexpr int LDS_MISC = 131072, LDS_BYTES = 147456;

#define XB_TMO      128
#define XB_XCNT(j)  (256  + 64 * (j))
#define XB_XSUB(j)  (1280 + 64 * (j))
#define XB_XGEN(j)  (2304 + 64 * (j))
#define XB_TOP      3328
#define XB_TOPGEN   3392
#define XCD_BAR_WORDS 3456
#define XB_SPIN_CAP (1u << 18)
__device__ __forceinline__ unsigned xb_ld(unsigned* p)              { return __hip_atomic_load(p, __ATOMIC_RELAXED, __HIP_MEMORY_SCOPE_AGENT); }
__device__ __forceinline__ unsigned xb_add(unsigned* p, unsigned v) { return __hip_atomic_fetch_add(p, v, __ATOMIC_RELAXED, __HIP_MEMORY_SCOPE_AGENT); }
__device__ __forceinline__ unsigned xb_xcc_id() { return (unsigned)__builtin_amdgcn_s_getreg((3 << 11) | 20) & 0xFu; }
#define XB_SPIN(cond, bar) do { unsigned _sp = 0; while (cond) { __builtin_amdgcn_s_sleep(1); \
    if ((++_sp & 255u) == 0u) { if (xb_ld(&(bar)[XB_TMO])) break; if (_sp > XB_SPIN_CAP) { atomicAdd(&(bar)[XB_TMO], 1u); break; } } } } while (0)
struct XcdBarrier { unsigned* bar; unsigned x; volatile LAS unsigned* st; };
__device__ __forceinline__ XcdBarrier xcd_barrier_post(unsigned* bar, volatile LAS unsigned* st) {
    XcdBarrier b; b.bar = bar; b.x = xb_xcc_id(); b.st = st;
    if (threadIdx.x == 0) (void)xb_add(&bar[XB_XCNT(b.x)], 1u);
    return b;
}
__device__ __forceinline__ void xcd_barrier_complete(unsigned* bar, unsigned x, unsigned& nloc, unsigned& nx) {
    const unsigned G = gridDim.x * gridDim.y * gridDim.z;
    unsigned sum, cnt, mine, sp = 0u;
    for (;;) {
        sum = 0u; cnt = 0u; mine = 0u;
#pragma unroll
        for (unsigned j = 0; j < 16; ++j) { const unsigned c = xb_ld(&bar[XB_XCNT(j)]); sum += c; cnt += (c > 0u) ? 1u : 0u; mine = (j == x) ? c : mine; }
        if (sum == G) break;
        __builtin_amdgcn_s_sleep(1);
        if ((++sp & 255u) == 0u) { if (xb_ld(&bar[XB_TMO])) break; if (sp > XB_SPIN_CAP) { atomicAdd(&bar[XB_TMO], 1u); break; } }
    }
    nloc = mine > 0u ? mine : 1u; nx = cnt > 0u ? cnt : 1u;
}
__device__ __forceinline__ void xcd_barrier(const XcdBarrier& b) {
    asm volatile("s_waitcnt vmcnt(0)" ::: "memory");
    __syncthreads();
    if (threadIdx.x == 0) {
        unsigned* bar = b.bar;
        __builtin_amdgcn_s_waitcnt(0);
        unsigned nloc = b.st[0], nx = b.st[1];
        if (nloc == 0u) { xcd_barrier_complete(bar, b.x, nloc, nx); b.st[0] = nloc; b.st[1] = nx; }
        const unsigned old = xb_add(&bar[XB_XSUB(b.x)], 1u);
        const unsigned gen = old / nloc;
        if (old + 1u == (gen + 1u) * nloc) {
            __builtin_amdgcn_fence(__ATOMIC_RELEASE, "agent");
            asm volatile("s_waitcnt vmcnt(0)" ::: "memory");
            const unsigned og = xb_add(&bar[XB_TOP], 1u);
            const unsigned tg = og / nx;
            if (og + 1u == (tg + 1u) * nx) xb_add(&bar[XB_TOPGEN], 1u);
            else XB_SPIN(xb_ld(&bar[XB_TOPGEN]) == tg, bar);
            __builtin_amdgcn_fence(__ATOMIC_ACQUIRE, "agent");
            xb_add(&bar[XB_XGEN(b.x)], 1u);
            asm volatile("s_waitcnt vmcnt(0)" ::: "memory");
        } else {
            XB_SPIN(xb_ld(&bar[XB_XGEN(b.x)]) == gen, bar);
            __builtin_amdgcn_fence(__ATOMIC_ACQUIRE, "agent");
            asm volatile("s_waitcnt vmcnt(0)" ::: "memory");
        }
    }
    __syncthreads();
}

struct Ctx {
    const float* const* in; float* out; unsigned char* ws; ldsp lds;
    int tid, lane, wave, G, bid, l;
};
#define WSP(T, off) ((T*)(C.ws + (off)))
#define LIN(i, per) (C.in[i] + (size_t)C.l * (per))

template <int KIND> __device__ __forceinline__ int rowmap(int j) {
    if (KIND == 0) return j;
    if (KIND == 1) { const int p = j >> 8, q = j & 255; return q < 128 ? 128 * p + q : DFF + 128 * p + (q - 128); }
    if (KIND == 2) {
        if (j < 1024) return j;
        if (j < 1280) { const int m = j - 1024; return m < 64 ? 1024 + m : (m < 96 ? 4160 + (m - 64) : -1); }
        if (j < 1792) return 1088 + (j - 1280);
        if (j < 2304) return 1600 + (j - 1792);
        if (j < 3328) return 3136 + (j - 2304);
        if (j < 4352) return 4192 + (j - 3328);
        if (j < 4608) return 5216 + (j - 4352);
        if (j < 4864) return 5472 + (j - 4608);
        return 5728 + (j - 4864);
    }
    if (KIND == 3) return j < 1024 ? 2112 + j : 5472 + (j - 1024);
    if (KIND == 4) return (j >> 7) * 256 + (j & 127);
    return (j >> 7) * 256 + 128 + (j & 127);
}
template <int KIND> __device__ __forceinline__ void conv_item(const float* __restrict__ src, bf16_t* __restrict__ dst, int K, int N, int item, int tid) {
    const int nkb = K >> 7, jb = item / nkb, kb = item - jb * nkb, lane = tid & 63, w = tid >> 6;
    const int j = jb * 256 + lane * 4, sc = rowmap<KIND>(j), k0 = kb * 128 + w * 16;
    f32x4 v[16];
    if (sc >= 0) { const float* p = src + (size_t)k0 * N + sc;
#pragma unroll
        for (int i = 0; i < 16; ++i) v[i] = __builtin_nontemporal_load((const f32x4*)(p + (size_t)i * N)); }
    else {
#pragma unroll
        for (int i = 0; i < 16; ++i) v[i] = (f32x4){0.f, 0.f, 0.f, 0.f}; }
#pragma unroll
    for (int jj = 0; jj < 4; ++jj) { bf16_t* o = dst + (size_t)(j + jj) * K + k0;
#pragma unroll
        for (int g = 0; g < 2; ++g) { u32x4 wv; wv.x = cvt_pk_bf16(v[g * 8 + 0][jj], v[g * 8 + 1][jj]); wv.y = cvt_pk_bf16(v[g * 8 + 2][jj], v[g * 8 + 3][jj]); wv.z = cvt_pk_bf16(v[g * 8 + 4][jj], v[g * 8 + 5][jj]); wv.w = cvt_pk_bf16(v[g * 8 + 6][jj], v[g * 8 + 7][jj]);
            *(u32x4*)(o + g * 8) = wv; } }
}
constexpr int I_GU = (NGU / 256) * 16, I_DN = (2048 / 256) * 44, I_IN = (NIN / 256) * 16, I_INS = (NSW / 256) * 16, I_UQ = 6 * 4, I_UK = 4 * 4, I_BR = 8 * 8, I_OUT = 8 * 16;
constexpr int NCONV_A = 2 * I_GU + I_DN, NCONV_B = I_DN + I_IN + I_INS + I_UQ + 2 * I_UK + 3 * I_BR + I_OUT;
#define LINW(i, per) (C.in[i] + (size_t)lw * (per))
#define WSW(off) ((bf16_t*)(C.ws + (off) + (size_t)lw * SZ_WLAYER))
__device__ __forceinline__ void conv_dispatch(const Ctx& C, const int lw, const int win, int r, const int tid) {
    if (win == 0) {
        if (r < I_GU) { conv_item<1>(LINW(14, (size_t)2048 * NGU), WSW(WS_WGU1), 2048, NGU, r, tid); return; } r -= I_GU;
        if (r < I_GU) { conv_item<1>(LINW(16, (size_t)2048 * NGU), WSW(WS_WGU2), 2048, NGU, r, tid); return; } r -= I_GU;
        conv_item<0>(LINW(17, (size_t)DFF * 2048), WSW(WS_WD2), DFF, 2048, r, tid); return;
    }
    if (r < I_DN) { conv_item<0>(LINW(15, (size_t)DFF * 2048), WSW(WS_WD1), DFF, 2048, r, tid); return; } r -= I_DN;
    if (r < I_IN) { conv_item<2>(LINW(18, (size_t)2048 * 11872), WSW(WS_WIN), 2048, 11872, r, tid); return; } r -= I_IN;
    if (r < I_INS) { conv_item<3>(LINW(18, (size_t)2048 * 11872), WSW(WS_WINS), 2048, 11872, r, tid); return; } r -= I_INS;
    if (r < I_UQ) { conv_item<0>(LINW(20, (size_t)512 * 1536), WSW(WS_WUQ), 512, 1536, r, tid); return; } r -= I_UQ;
    if (r < I_UK) { conv_item<4>(LINW(22, (size_t)512 * 2048), WSW(WS_WUK), 512, 2048, r, tid); return; } r -= I_UK;
    if (r < I_UK) { conv_item<5>(LINW(22, (size_t)512 * 2048), WSW(WS_WUV), 512, 2048, r, tid); return; } r -= I_UK;
    if (r < I_BR) { conv_item<0>(LINW(33, (size_t)1024 * 2048), WSW(WS_WBR), 1024, 2048, r, tid); return; } r -= I_BR;
    if (r < I_BR) { conv_item<0>(LINW(34, (size_t)1024 * 2048), WSW(WS_WBR + SZ_WBR), 1024, 2048, r, tid); return; } r -= I_BR;
    if (r < I_BR) { conv_item<0>(LINW(35, (size_t)1024 * 2048), WSW(WS_WBR + 2 * SZ_WBR), 1024, 2048, r, tid); return; } r -= I_BR;
    conv_item<0>(LINW(36, (size_t)2048 * 2048), WSW(WS_WOUT), 2048, 2048, r, tid);
}
__device__ __forceinline__ void conv_queue(const Ctx& C, const int lw, const int win, const int q, const int maxitems) {
    unsigned* head = WSP(unsigned, WS_CTL) + CW_QUEUE + 64 * q; volatile LAS int* slot = (volatile LAS int*)(C.lds + LDS_MISC + 16);
    const int n = win == 0 ? NCONV_A : NCONV_B;
    for (int cnt = 0; cnt < maxitems; ++cnt) {
        __syncthreads();
        if (C.tid == 0) *slot = (int)__hip_atomic_fetch_add(head, 1u, __ATOMIC_RELAXED, __HIP_MEMORY_SCOPE_AGENT);
        __syncthreads();
        const int it = *slot;
        if (it >= n) break;
        int tid = C.tid; asm volatile("" : "+v"(tid));
        conv_dispatch(C, lw, win, it, tid);
    }
}
__device__ __forceinline__ void phase_prep(const Ctx& C) {
    const int tid = C.tid, lane = C.lane, w = C.wave;
    LAS float* sc = (LAS float*)C.lds; LAS float* red = (LAS float*)(C.lds + 24576);
    for (int i = tid; i < 3 * 2048; i += NTHR) { const int c = i >> 11, k = i & 2047; const float v = (c == 0) ? C.in[8][k] : C.in[7][(c - 1) * 2048 + k]; sc[i] = siluf_(v); }
    __syncthreads();
    constexpr int I_ADA = 2 * (NMOD / 64);
    for (int it = C.bid; it < I_ADA + NCONV_A; it += C.G) {
        if (it < I_ADA) {
            const int la = it / (NMOD / 64), r = it - la * (NMOD / 64);
            const float* Wada = C.in[9] + (size_t)la * 2048 * NMOD; const float* bada = C.in[10] + (size_t)la * NMOD; float* modl = WSP(float, WS_MOD) + (size_t)la * 3 * NMOD;
            const int col = r * 64 + lane; float a0 = 0.f, a1 = 0.f, a2 = 0.f; const float* p = Wada + (size_t)(w * 256) * NMOD + col;
            for (int k = 0; k < 256; k += 32) { float wv[32];
#pragma unroll
                for (int i = 0; i < 32; ++i) wv[i] = __builtin_nontemporal_load(p + (size_t)(k + i) * NMOD);
#pragma unroll
                for (int i = 0; i < 32; ++i) { const int kk = w * 256 + k + i; a0 += sc[kk] * wv[i]; a1 += sc[2048 + kk] * wv[i]; a2 += sc[4096 + kk] * wv[i]; } }
            red[(w * 3 + 0) * 64 + lane] = a0; red[(w * 3 + 1) * 64 + lane] = a1; red[(w * 3 + 2) * 64 + lane] = a2;
            __syncthreads();
            if (w < 3) { float s = bada[col]; for (int ww = 0; ww < 8; ++ww) s += red[(ww * 3 + w) * 64 + lane]; modl[w * NMOD + col] = s; }
            __syncthreads();
            continue; }
        conv_dispatch(C, 0, 0, it - I_ADA, tid);
    }
    if (C.bid == 0) { float* rp = WSP(float, WS_ROPE);
        for (int i = tid; i < 1024; i += NTHR) { const int pos = i >> 4, f = i & 15; const float inv = fast_exp2(-(float)f * (13.287712379549449f / 16.0f));
            float rev = (float)pos * inv * 0.15915494309189535f; rev -= floorf(rev);
            rp[i] = __builtin_amdgcn_cosf(rev); rp[1024 + i] = __builtin_amdgcn_sinf(rev); } }
}

__device__ __forceinline__ void phase_norm(const Ctx& C, int gin, int mi, bool from_input) {
    const float* g = LIN(gin, D); const float* modl = WSP(float, WS_MOD) + (size_t)C.l * 3 * NMOD; bf16_t* H = WSP(bf16_t, WS_H);
    const int lane = C.lane; const float* x0 = from_input ? C.in[0] : C.out; const float* x1 = from_input ? C.in[1] - (size_t)MPROMPT * D : C.out;
    constexpr int U = 4;
    for (int q = C.bid * NWAVES + C.wave; q < MROWS / U; q += C.G * NWAVES) {
        const int r = U * q; const int c = r < MPROMPT ? 0 : 1 + ((r - MPROMPT) >> 11);
        const float* sh = modl + c * NMOD + (3 * mi) * 2048; const float* scl = sh + 2048;
        const f32x4* xr = (const f32x4*)((r < MPROMPT ? x0 : x1) + (size_t)r * D) + lane;
        f32x4 v[U][8]; float ss[U];
#pragma unroll
        for (int u = 0; u < U; ++u)
#pragma unroll
            for (int j = 0; j < 8; ++j) v[u][j] = __builtin_nontemporal_load(xr + u * 512 + 64 * j);
#pragma unroll
        for (int u = 0; u < U; ++u) { ss[u] = 0.f;
#pragma unroll
            for (int j = 0; j < 8; ++j) ss[u] += (v[u][j][0] * v[u][j][0] + v[u][j][1] * v[u][j][1]) + (v[u][j][2] * v[u][j][2] + v[u][j][3] * v[u][j][3]); }
#pragma unroll
        for (int o = 1; o < 64; o <<= 1) {
#pragma unroll
            for (int u = 0; u < U; ++u) ss[u] += __shfl_xor(ss[u], o); }
        float rs[U];
#pragma unroll
        for (int u = 0; u < U; ++u) rs[u] = rsqrtf(ss[u] * (1.0f / D) + EPS);
        u32x2* o = (u32x2*)(H + (size_t)r * D) + lane;
#pragma unroll
        for (int j = 0; j < 8; ++j) { const int col = 4 * lane + 256 * j; const f32x4 gg = *(const f32x4*)(g + col), s1 = *(const f32x4*)(scl + col), s0 = *(const f32x4*)(sh + col);
            f32x4 gm;
#pragma unroll
            for (int e = 0; e < 4; ++e) gm[e] = gg[e] * (1.0f + s1[e]);
#pragma unroll
            for (int u = 0; u < U; ++u) { const f32x4 y = v[u][j] * rs[u] * gm + s0; u32x2 w; w.x = cvt_pk_bf16(y[0], y[1]); w.y = cvt_pk_bf16(y[2], y[3]); o[u * 512 + 64 * j] = w; } }
    }
}

__device__ __forceinline__ float logsig16(float z) { return (fminf(z, 0.f) - __logf(1.0f + __expf(-fabsf(z)))) * (1.0f / 16.0f); }
__device__ __forceinline__ void prepa_gla_item(const Ctx& C, int chunk, int h) {
    const int tid = C.tid, l = C.l, k = tid & 127, tq = tid >> 7, r0 = chunk * 64;
    LAS float* gg = (LAS float*)C.lds; LAS float* tot = (LAS float*)(C.lds + 8192);
    const float* INF = WSP(float, WS_INF); const bf16_t* IN = WSP(bf16_t, WS_IN);
    { const int idx = tid * 4, t = idx >> 5, j = idx & 31; *(LAS f32x4*)(gg + idx) = *(const f32x4*)(INF + (size_t)(r0 + t) * LDF + F_GG + j); }
    __syncthreads();
    const float* wgf = LIN(25, 16 * 512) + h * 128 + k; const float* wgb = LIN(27, 16 * 512) + h * 128 + k;
    float wf[16], wb[16];
#pragma unroll
    for (int j = 0; j < 16; ++j) { wf[j] = wgf[j * 512]; wb[j] = wgb[j * 512]; }
    const float bfv = LIN(26, 512)[h * 128 + k], bbv = LIN(28, 512)[h * 128 + k];
    float cf[16], cb[16];
#pragma unroll
    for (int i = 0; i < 16; ++i) { const LAS float* gr = gg + (tq * 16 + i) * 32; float zf = bfv, zb = bbv;
#pragma unroll
        for (int j = 0; j < 16; ++j) { zf += gr[j] * wf[j]; zb += gr[16 + j] * wb[j]; }
        cf[i] = logsig16(zf); cb[i] = logsig16(zb); }
#pragma unroll
    for (int i = 1; i < 16; ++i) cf[i] += cf[i - 1];
#pragma unroll
    for (int i = 14; i >= 0; --i) cb[i] += cb[i + 1];
    tot[(0 * 4 + tq) * 128 + k] = cf[15]; tot[(1 * 4 + tq) * 128 + k] = cb[0];
    __syncthreads();
    float off_f = 0.f, off_b = 0.f, bl_f = 0.f, bl_b = 0.f;
#pragma unroll
    for (int q = 0; q < 4; ++q) { const float tf = tot[q * 128 + k], tb = tot[(4 + q) * 128 + k]; bl_f += tf; bl_b += tb; if (q < tq) off_f += tf; if (q > tq) off_b += tb; }
    bf16_t* QG0 = WSP(bf16_t, WS_QG); bf16_t* QG1 = WSP(bf16_t, WS_QG + SZ_G1); bf16_t* KG0 = WSP(bf16_t, WS_KG); bf16_t* KG1 = WSP(bf16_t, WS_KG + SZ_G1);
    bf16_t* KHT0 = WSP(bf16_t, WS_KHT); bf16_t* KHT1 = WSP(bf16_t, WS_KHT + SZ_G1);
    float khf[16], khb[16];
#pragma unroll
    for (int i = 0; i < 16; ++i) { const size_t r = (size_t)(r0 + tq * 16 + i);
        const float q = bf1(IN[r * NIN + C_GQ + h * 128 + k]) * GLA_QSCALE, kk = bf1(IN[r * NIN + C_GK + h * 128 + k]);
        const float bf_ = off_f + cf[i], bb_ = off_b + cb[i];
        const size_t o = r * 512 + h * 128 + k;
        QG0[o] = f2bf(q * __expf(bf_)); KG0[o] = f2bf(kk * __expf(-bf_)); khf[i] = kk * __expf(bl_f - bf_);
        QG1[o] = f2bf(q * __expf(bb_)); KG1[o] = f2bf(kk * __expf(-bb_)); khb[i] = kk * __expf(bl_b - bb_); }
    { u32x4 a, b; a.x = cvt_pk_bf16(khf[0], khf[1]); a.y = cvt_pk_bf16(khf[2], khf[3]); a.z = cvt_pk_bf16(khf[4], khf[5]); a.w = cvt_pk_bf16(khf[6], khf[7]);
      b.x = cvt_pk_bf16(khf[8], khf[9]); b.y = cvt_pk_bf16(khf[10], khf[11]); b.z = cvt_pk_bf16(khf[12], khf[13]); b.w = cvt_pk_bf16(khf[14], khf[15]);
      u32x4* p = (u32x4*)(KHT0 + (size_t)(h * 128 + k) * MROWS + r0 + tq * 16); p[0] = a; p[1] = b; }
    { u32x4 a, b; a.x = cvt_pk_bf16(khb[0], khb[1]); a.y = cvt_pk_bf16(khb[2], khb[3]); a.z = cvt_pk_bf16(khb[4], khb[5]); a.w = cvt_pk_bf16(khb[6], khb[7]);
      b.x = cvt_pk_bf16(khb[8], khb[9]); b.y = cvt_pk_bf16(khb[10], khb[11]); b.z = cvt_pk_bf16(khb[12], khb[13]); b.w = cvt_pk_bf16(khb[14], khb[15]);
      u32x4* p = (u32x4*)(KHT1 + (size_t)(h * 128 + k) * MROWS + r0 + tq * 16); p[0] = a; p[1] = b; }
    if (tq == 0) { float* DEC = WSP(float, WS_DEC); DEC[(size_t)(chunk * 2 + 0) * 512 + h * 128 + k] = __expf(bl_f); DEC[(size_t)(chunk * 2 + 1) * 512 + h * 128 + k] = __expf(bl_b); }
    __syncthreads();
}
template <int U> __device__ __forceinline__ void prepa_tokens(const Ctx& C, int r0) {
    const int lane = C.lane, l = C.l; const bool prompt = r0 < MPROMPT;
    const float* ROPE = WSP(float, WS_ROPE);
    u32x4 wq[U], ws0[U], ws1[U]; f32x4 a[U], bb[U], kv[U], sv[U]; float kp[U];
#pragma unroll
    for (int u = 0; u < U; ++u) { const int r = r0 + u; const float* INF = WSP(float, WS_INF) + (size_t)r * LDF; const bf16_t* IN = WSP(bf16_t, WS_IN) + (size_t)r * NIN;
        wq[u] = __builtin_nontemporal_load((const u32x4*)(IN + C_CQ + lane * 8)); a[u] = __builtin_nontemporal_load((const f32x4*)(INF + F_CKV + lane * 8)); bb[u] = __builtin_nontemporal_load((const f32x4*)(INF + F_CKV + lane * 8 + 4));
        ws0[u] = __builtin_nontemporal_load((const u32x4*)(IN + C_SQ + lane * 16)); ws1[u] = __builtin_nontemporal_load((const u32x4*)(IN + C_SQ + lane * 16 + 8)); kv[u] = *(const f32x4*)(INF + F_SK + lane * 4);
        if (prompt) { kp[u] = INF[F_KPE + lane]; sv[u] = __builtin_nontemporal_load((const f32x4*)(INF + F_SV + lane * 4)); } }
    float vq[U][8], vs[U][16], s1[U], s2[U], s3[U], s4[U];
#pragma unroll
    for (int u = 0; u < U; ++u) {
        vq[u][0] = bf_lo(wq[u].x); vq[u][1] = bf_hi(wq[u].x); vq[u][2] = bf_lo(wq[u].y); vq[u][3] = bf_hi(wq[u].y); vq[u][4] = bf_lo(wq[u].z); vq[u][5] = bf_hi(wq[u].z); vq[u][6] = bf_lo(wq[u].w); vq[u][7] = bf_hi(wq[u].w);
        vs[u][0] = bf_lo(ws0[u].x); vs[u][1] = bf_hi(ws0[u].x); vs[u][2] = bf_lo(ws0[u].y); vs[u][3] = bf_hi(ws0[u].y); vs[u][4] = bf_lo(ws0[u].z); vs[u][5] = bf_hi(ws0[u].z); vs[u][6] = bf_lo(ws0[u].w); vs[u][7] = bf_hi(ws0[u].w);
        vs[u][8] = bf_lo(ws1[u].x); vs[u][9] = bf_hi(ws1[u].x); vs[u][10] = bf_lo(ws1[u].y); vs[u][11] = bf_hi(ws1[u].y); vs[u][12] = bf_lo(ws1[u].z); vs[u][13] = bf_hi(ws1[u].z); vs[u][14] = bf_lo(ws1[u].w); vs[u][15] = bf_hi(ws1[u].w);
        s1[u] = 0.f; s3[u] = 0.f;
#pragma unroll
        for (int i = 0; i < 8; ++i) s1[u] += vq[u][i] * vq[u][i];
#pragma unroll
        for (int i = 0; i < 16; ++i) s3[u] += vs[u][i] * vs[u][i];
        s2[u] = (a[u][0] * a[u][0] + a[u][1] * a[u][1]) + (a[u][2] * a[u][2] + a[u][3] * a[u][3]) + (bb[u][0] * bb[u][0] + bb[u][1] * bb[u][1]) + (bb[u][2] * bb[u][2] + bb[u][3] * bb[u][3]);
        s4[u] = (kv[u][0] * kv[u][0] + kv[u][1] * kv[u][1]) + (kv[u][2] * kv[u][2] + kv[u][3] * kv[u][3]); }
#pragma unroll
    for (int o = 1; o < 64; o <<= 1) {
#pragma unroll
        for (int u = 0; u < U; ++u) { s1[u] += __shfl_xor(s1[u], o); s2[u] += __shfl_xor(s2[u], o); if (o < 4) s3[u] += __shfl_xor(s3[u], o); if (o < 16) s4[u] += __shfl_xor(s4[u], o); } }
    const float* gq = LIN(19, 512) + lane * 8; const float* gk = LIN(21, 512) + lane * 8;
    const int sub = lane & 3, s16 = lane & 15; const float* g = LIN(30, 64) + sub * 16; const f32x4 gkn = *(const f32x4*)(LIN(31, 64) + s16 * 4);
#pragma unroll
    for (int u = 0; u < U; ++u) { const int r = r0 + u; const size_t orow = (size_t)(((r >> 8) * 2 + l) * 256 + (r & 255)); const int t = (r - MPROMPT) & 2047, trow = t >> 6, tcol = t & 63;
        const float rs1 = rsqrtf(s1[u] * (1.0f / 512.0f) + EPS), rs2 = rsqrtf(s2[u] * (1.0f / 512.0f) + EPS), rs3 = rsqrtf(s3[u] * (1.0f / 64.0f) + EPS), rs4 = rsqrtf(s4[u] * (1.0f / 64.0f) + EPS);
        {
            u32x4 o; o.x = cvt_pk_bf16(vq[u][0] * rs1 * gq[0], vq[u][1] * rs1 * gq[1]); o.y = cvt_pk_bf16(vq[u][2] * rs1 * gq[2], vq[u][3] * rs1 * gq[3]); o.z = cvt_pk_bf16(vq[u][4] * rs1 * gq[4], vq[u][5] * rs1 * gq[5]); o.w = cvt_pk_bf16(vq[u][6] * rs1 * gq[6], vq[u][7] * rs1 * gq[7]);
            *(u32x4*)(WSP(bf16_t, WS_CQN) + (size_t)r * 512 + lane * 8) = o; }
        {
            const f32x4 ya = a[u] * rs2 * *(const f32x4*)gk, yb = bb[u] * rs2 * *(const f32x4*)(gk + 4);
            if (prompt) { float* op = C.out + O_CKV + orow * 512 + lane * 8; *(f32x4*)op = ya; *(f32x4*)(op + 4) = yb; }
            u32x4 o2; o2.x = cvt_pk_bf16(ya[0], ya[1]); o2.y = cvt_pk_bf16(ya[2], ya[3]); o2.z = cvt_pk_bf16(yb[0], yb[1]); o2.w = cvt_pk_bf16(yb[2], yb[3]);
            *(u32x4*)(WSP(bf16_t, WS_CKVN) + (size_t)r * 512 + lane * 8) = o2; }
        if (prompt) { C.out[O_KPE + orow * 64 + lane] = kp[u]; *(f32x4*)(C.out + O_SV + orow * 256 + lane * 4) = sv[u]; }
        {
#pragma unroll
            for (int i = 0; i < 16; ++i) vs[u][i] = vs[u][i] * rs3 * g[i];
            if (!prompt) { const int pos = sub < 2 ? trow : tcol; const float* cp = ROPE + pos * 16; const float* sp = cp + 1024;
#pragma unroll
                for (int i = 0; i < 16; ++i) { const float oth = __shfl_xor(vs[u][i], 1), c = cp[i], sn = sp[i]; vs[u][i] = (sub & 1) ? (oth * sn + vs[u][i] * c) : (vs[u][i] * c - oth * sn); } }
            u32x4 o0, o1;
            o0.x = cvt_pk_bf16(vs[u][0] * SWA_QSCALE, vs[u][1] * SWA_QSCALE); o0.y = cvt_pk_bf16(vs[u][2] * SWA_QSCALE, vs[u][3] * SWA_QSCALE); o0.z = cvt_pk_bf16(vs[u][4] * SWA_QSCALE, vs[u][5] * SWA_QSCALE); o0.w = cvt_pk_bf16(vs[u][6] * SWA_QSCALE, vs[u][7] * SWA_QSCALE);
            o1.x = cvt_pk_bf16(vs[u][8] * SWA_QSCALE, vs[u][9] * SWA_QSCALE); o1.y = cvt_pk_bf16(vs[u][10] * SWA_QSCALE, vs[u][11] * SWA_QSCALE); o1.z = cvt_pk_bf16(vs[u][12] * SWA_QSCALE, vs[u][13] * SWA_QSCALE); o1.w = cvt_pk_bf16(vs[u][14] * SWA_QSCALE, vs[u][15] * SWA_QSCALE);
            u32x4* op = (u32x4*)(WSP(bf16_t, WS_QS) + (size_t)r * 1024 + lane * 16); op[0] = o0; op[1] = o1; }
        {
            f32x4 kk = kv[u] * rs4 * gkn;
            if (prompt) *(f32x4*)(C.out + O_SK + orow * 256 + lane * 4) = kk;
            else { const int pos = s16 < 8 ? trow : tcol; const f32x4 c = *(const f32x4*)(ROPE + pos * 16 + (lane & 3) * 4), sn = *(const f32x4*)(ROPE + 1024 + pos * 16 + (lane & 3) * 4);
#pragma unroll
                for (int j = 0; j < 4; ++j) { const float oth = __shfl_xor(kk[j], 4); kk[j] = (s16 & 4) ? (oth * sn[j] + kk[j] * c[j]) : (kk[j] * c[j] - oth * sn[j]); } }
            u32x2 o; o.x = cvt_pk_bf16(kk[0], kk[1]); o.y = cvt_pk_bf16(kk[2], kk[3]);
            *(u32x2*)(WSP(bf16_t, WS_KS) + (size_t)r * 256 + lane * 4) = o; } }
}
__device__ __forceinline__ void prepa_ctx_item(const Ctx& C, int j) {
    const int tid = C.tid, l = C.l;
    {   bf16_t* CKVN = WSP(bf16_t, WS_CKVN) + (size_t)(MROWS + j * 64) * 512;
        const int b = (j * 64) >> 8, key0 = (j * 64) & 255; const float* src = C.in[2] + ((size_t)(b * 2 + l) * 256 + key0) * 512;
#pragma unroll
        for (int i = 0; i < 8; ++i) { const int idx = (i * NTHR + tid) * 8; const f32x4 a = *(const f32x4*)(src + idx), bb = *(const f32x4*)(src + idx + 4);
            u32x4 o; o.x = cvt_pk_bf16(a[0], a[1]); o.y = cvt_pk_bf16(a[2], a[3]); o.z = cvt_pk_bf16(bb[0], bb[1]); o.w = cvt_pk_bf16(bb[2], bb[3]); *(u32x4*)(CKVN + idx) = o; }
        bf16_t* KS = WSP(bf16_t, WS_KS) + (size_t)(MROWS + j * 64) * 256; const float* sk = C.in[4] + ((size_t)(b * 2 + l) * 256 + key0) * 256;
#pragma unroll
        for (int i = 0; i < 4; ++i) { const int idx = (i * NTHR + tid) * 8; const f32x4 a = *(const f32x4*)(sk + idx), bb = *(const f32x4*)(sk + idx + 4);
            u32x4 o; o.x = cvt_pk_bf16(a[0], a[1]); o.y = cvt_pk_bf16(a[2], a[3]); o.z = cvt_pk_bf16(bb[0], bb[1]); o.w = cvt_pk_bf16(bb[2], bb[3]); *(u32x4*)(KS + idx) = o; }
        const int c = tid & 255, kh = tid >> 8; const float* sv = C.in[5] + ((size_t)(b * 2 + l) * 256 + key0 + kh * 32) * 256 + c;
        float v[32];
#pragma unroll
        for (int i = 0; i < 32; ++i) v[i] = sv[(size_t)i * 256];
        u32x4* op = (u32x4*)(WSP(bf16_t, WS_VSCT) + ((size_t)b * 256 + c) * 256 + key0 + kh * 32);
#pragma unroll
        for (int g = 0; g < 4; ++g) { u32x4 o; o.x = cvt_pk_bf16(v[g * 8], v[g * 8 + 1]); o.y = cvt_pk_bf16(v[g * 8 + 2], v[g * 8 + 3]); o.z = cvt_pk_bf16(v[g * 8 + 4], v[g * 8 + 5]); o.w = cvt_pk_bf16(v[g * 8 + 6], v[g * 8 + 7]); op[g] = o; }
    }
}
__device__ __forceinline__ void phase_prepa(const Ctx& C, const int mask) {
    constexpr int I_GLA = 512, I_TOK = 256, I_CTX = 8;
    for (int it = C.bid; it < I_GLA + I_TOK + I_CTX; it += C.G) {
        if (it < I_GLA) { if (mask & 1) prepa_gla_item(C, it >> 2, it & 3); continue; }
        if (it < I_GLA + I_TOK) { const int r0 = (it - I_GLA) * 32 + C.wave * 4;
            if (mask & 2) { prepa_tokens<2>(C, r0); prepa_tokens<2>(C, r0 + 2); }
            continue; }
        if (mask & 4) prepa_ctx_item(C, it - I_GLA - I_TOK);
    }
}

__device__ __forceinline__ void prepb_unpack(const u32x4 w, float (&v)[8]) { v[0] = bf_lo(w.x); v[1] = bf_hi(w.x); v[2] = bf_lo(w.y); v[3] = bf_hi(w.y); v[4] = bf_lo(w.z); v[5] = bf_hi(w.z); v[6] = bf_lo(w.w); v[7] = bf_hi(w.w); }
__device__ __forceinline__ u32x4 prepb_pack(const float (&v)[8], float s) { u32x4 o; o.x = cvt_pk_bf16(v[0] * s, v[1] * s); o.y = cvt_pk_bf16(v[2] * s, v[3] * s); o.z = cvt_pk_bf16(v[4] * s, v[5] * s); o.w = cvt_pk_bf16(v[6] * s, v[7] * s); return o; }
__device__ __forceinline__ void phase_prepb(const Ctx& C) {
    const int lane = C.lane, l = C.l, h = lane >> 3, sub = lane & 7; const float* ROPE = WSP(float, WS_ROPE);
    constexpr int NT = MROWS + MKV, U = 2; const int nw = C.G * NWAVES;
    float gq[3][8], gk[3][8];
#pragma unroll
    for (int c = 0; c < 3; ++c)
#pragma unroll
        for (int j = 0; j < 8; ++j) { gq[c][j] = LIN(23, 192)[64 * c + 8 * sub + j]; gk[c][j] = LIN(24, 192)[64 * c + 8 * sub + j]; }
    const bf16_t* QRAW = WSP(bf16_t, WS_QRAW); const bf16_t* KNRAW = WSP(bf16_t, WS_KNRAW); const float* INF = WSP(float, WS_INF);
    for (int t0 = C.bid * NWAVES + C.wave; t0 < NT; t0 += U * nw) {
        float v[U][3][8];
#pragma unroll
        for (int u = 0; u < U; ++u) { const int task = (t0 + u * nw < NT) ? t0 + u * nw : t0; const bool isq = task < MROWS; const int r = isq ? task : task - MROWS;
            if (isq) {
#pragma unroll
                for (int c = 0; c < 3; ++c) prepb_unpack(__builtin_nontemporal_load((const u32x4*)(QRAW + (size_t)r * 1536 + h * 192 + 64 * c + 8 * sub)), v[u][c]); }
            else {
#pragma unroll
                for (int c = 0; c < 2; ++c) prepb_unpack(__builtin_nontemporal_load((const u32x4*)(KNRAW + (size_t)r * 1024 + h * 128 + 64 * c + 8 * sub)), v[u][c]);
                const float* kp = (r < MROWS) ? INF + (size_t)r * LDF + F_KPE + 8 * sub : C.in[3] + ((size_t)(((r - MROWS) >> 8) * 2 + l) * 256 + ((r - MROWS) & 255)) * 64 + 8 * sub;
                const f32x4 a = *(const f32x4*)kp, b = *(const f32x4*)(kp + 4);
                v[u][2][0] = a[0]; v[u][2][1] = a[1]; v[u][2][2] = a[2]; v[u][2][3] = a[3]; v[u][2][4] = b[0]; v[u][2][5] = b[1]; v[u][2][6] = b[2]; v[u][2][7] = b[3]; } }
        float ss[U];
#pragma unroll
        for (int u = 0; u < U; ++u) { ss[u] = 0.f;
#pragma unroll
            for (int c = 0; c < 3; ++c)
#pragma unroll
                for (int j = 0; j < 8; ++j) ss[u] += v[u][c][j] * v[u][c][j]; }
#pragma unroll
        for (int o = 1; o < 8; o <<= 1) {
#pragma unroll
            for (int u = 0; u < U; ++u) ss[u] += __shfl_xor(ss[u], o); }
#pragma unroll
        for (int u = 0; u < U; ++u) { const int task = t0 + u * nw; const bool isq = task < MROWS; const int r = isq ? task : task - MROWS;
            const float rs = rsqrtf(ss[u] * (1.0f / 192.0f) + EPS);
#pragma unroll
            for (int c = 0; c < 3; ++c)
#pragma unroll
                for (int j = 0; j < 8; ++j) v[u][c][j] *= rs * (isq ? gq[c][j] : gk[c][j]);
            const bool rope = (r >= MPROMPT) && (r < MROWS);
            const int t = (r - MPROMPT) & 2047, pos = (sub & 4) ? (t & 63) : (t >> 6);
            const float* cp = ROPE + pos * 16 + 8 * (sub & 1); const f32x4 c0 = *(const f32x4*)cp, c1 = *(const f32x4*)(cp + 4), s0 = *(const f32x4*)(cp + 1024), s1 = *(const f32x4*)(cp + 1028);
            float y[8];
#pragma unroll
            for (int j = 0; j < 8; ++j) { const float x = v[u][2][j], oth = __shfl_xor(x, 2), cc = j < 4 ? c0[j & 3] : c1[j & 3], sn = j < 4 ? s0[j & 3] : s1[j & 3];
                const float rot = (sub & 2) ? (oth * sn + x * cc) : (x * cc - oth * sn); y[j] = rope ? rot : x; }
            if (task < NT) {
                bf16_t* o = (isq ? WSP(bf16_t, WS_QM) : WSP(bf16_t, WS_KM)) + (size_t)r * 1536 + h * 192 + 8 * sub; const float sc = isq ? MLA_QSCALE : 1.0f;
                *(u32x4*)o = prepb_pack(v[u][0], sc); *(u32x4*)(o + 64) = prepb_pack(v[u][1], sc); *(u32x4*)(o + 128) = prepb_pack(y, sc); } }
    }
}

__device__ __forceinline__ void phase_post(const Ctx& C) {
    const int lane = C.lane; const float* g = LIN(29, 256) + lane * 4;
    const float* OF = WSP(float, WS_OG); const float* OB = WSP(float, WS_OG + SZ_OG1); const bf16_t* IN = WSP(bf16_t, WS_IN); bf16_t* OGN = WSP(bf16_t, WS_OGN);
    const f32x4 gv = *(const f32x4*)g; constexpr int U = 4, NT = MROWS * 4; const int nw = C.G * NWAVES;
    for (int t0 = C.bid * NWAVES + C.wave; t0 < NT; t0 += U * nw) {
        f32x4 v[U]; u32x2 gw[U]; float ss[U];
#pragma unroll
        for (int u = 0; u < U; ++u) { const int task = t0 + u * nw < NT ? t0 + u * nw : t0; const int r = task >> 2, h = task & 3; const size_t o = (size_t)r * 1024 + h * 256 + lane * 4;
            v[u] = __builtin_nontemporal_load((const f32x4*)(OF + o)) + __builtin_nontemporal_load((const f32x4*)(OB + o)); gw[u] = __builtin_nontemporal_load((const u32x2*)(IN + (size_t)r * NIN + C_GOUT + h * 256 + lane * 4));
            ss[u] = (v[u][0] * v[u][0] + v[u][1] * v[u][1]) + (v[u][2] * v[u][2] + v[u][3] * v[u][3]); }
#pragma unroll
        for (int o = 1; o < 64; o <<= 1) {
#pragma unroll
            for (int u = 0; u < U; ++u) ss[u] += __shfl_xor(ss[u], o); }
#pragma unroll
        for (int u = 0; u < U; ++u) { const int task = t0 + u * nw; if (task < NT) { const int r = task >> 2, h = task & 3; const size_t o = (size_t)r * 1024 + h * 256 + lane * 4;
            const float rs = rsqrtf(ss[u] * (1.0f / 256.0f) + EPS);
            const f32x4 y = v[u] * rs * gv * (f32x4){siluf_(bf_lo(gw[u].x)), siluf_(bf_hi(gw[u].x)), siluf_(bf_lo(gw[u].y)), siluf_(bf_hi(gw[u].y))};
            u32x2 ow; ow.x = cvt_pk_bf16(y[0], y[1]); ow.y = cvt_pk_bf16(y[2], y[3]); *(u32x2*)(OGN + o) = ow; } }
    }
}

struct AttnSeg { const bf16_t* K; const bf16_t* VT; int kstride, vtstride, nk, kpos0; };
template <int DQK, int DV>
__device__ __forceinline__ void attn_item(ldsp lds, int tid, const bf16_t* Qw, int qstride, int qpos0, const AttnSeg s0, const AttnSeg s1, bool window,
                                          float m_init, float l_init, bf16_t* Ow, int ostride, const int variant = 0  ) {
    constexpr int KST = DQK * 2 + 32  , VST = 160, KT_BYTES = 64 * KST, VT_BYTES = DV * VST, BUF = KT_BYTES + VT_BYTES;
    constexpr int NKK = DQK / 32, NDVB = DV / 16, KPR = DQK / 8, KP = (64 * KPR) / NTHR, VP = (DV * 8) / NTHR;
    static_assert((64 * KPR) % NTHR == 0 && (DV * 8) % NTHR == 0 && 2 * BUF <= 131072, "attn tile geometry");
    const int lane = tid & 63, fr = lane & 15, fq = lane >> 4;
    bf16x8 qf[2][NKK];
#pragma unroll
    for (int rb = 0; rb < 2; ++rb)
#pragma unroll
        for (int kk = 0; kk < NKK; ++kk) qf[rb][kk] = *(const bf16x8*)(Qw + (size_t)(rb * 16 + fr) * qstride + kk * 32 + fq * 8);
    f32x4 o[NDVB][2];
#pragma unroll
    for (int d = 0; d < NDVB; ++d) { o[d][0] = (f32x4){0.f, 0.f, 0.f, 0.f}; o[d][1] = (f32x4){0.f, 0.f, 0.f, 0.f}; }
    float mrun[2] = {m_init, m_init}, lrun[2] = {fq == 0 ? l_init : 0.f, fq == 0 ? l_init : 0.f};
    const int nt0 = s0.nk >> 6, nt = nt0 + (s1.nk >> 6);
    u32x4 kreg[KP], vreg[VP];
#define ATT_LOAD(t) do { const bool _a = (t) < nt0; const bf16_t* _K = _a ? s0.K : s1.K; const bf16_t* _V = _a ? s0.VT : s1.VT; const int _ks = _a ? s0.kstride : s1.kstride, _vs = _a ? s0.vtstride : s1.vtstride; \
        const int _k0 = (_a ? (t) : (t) - nt0) * 64; \
        _Pragma("unroll") for (int _j = 0; _j < KP; ++_j) { const int _pi = tid + NTHR * _j, _row = _pi / KPR, _cp = _pi - _row * KPR; kreg[_j] = *(const u32x4*)(_K + (size_t)(_k0 + _row) * _ks + _cp * 8); } \
        _Pragma("unroll") for (int _j = 0; _j < VP; ++_j) { const int _pi = tid + NTHR * _j, _row = _pi >> 3, _cp = _pi & 7; vreg[_j] = *(const u32x4*)(_V + (size_t)_row * _vs + _k0 + _cp * 8); } } while (0)
#define ATT_STORE(buf) do { ldsp _b = lds + (buf) * BUF; \
        _Pragma("unroll") for (int _j = 0; _j < KP; ++_j) { const int _pi = tid + NTHR * _j, _row = _pi / KPR, _cp = _pi - _row * KPR; *(LAS u32x4*)(_b + ATT_KROW(_row) * KST + _cp * 16) = kreg[_j]; } \
        _Pragma("unroll") for (int _j = 0; _j < VP; ++_j) { const int _pi = tid + NTHR * _j, _row = _pi >> 3, _cp = _pi & 7; *(LAS u32x4*)(_b + KT_BYTES + _row * VST + _cp * 16) = vreg[_j]; } } while (0)
#define ATT_KROW(key) (((((key) >> 5) * 2 + (((key) >> 2) & 1)) << 4) + ((((key) >> 3) & 3) << 2) + ((key) & 3))
    ATT_LOAD(0); ATT_STORE(0);
    __syncthreads();
    for (int t = 0; t < nt; ++t) {
        if (t + 1 < nt && !(variant & 4)) ATT_LOAD(t + 1);
        ldsp kb_ = lds + (t & 1) * BUF; ldsp vb_ = kb_ + KT_BYTES;
        f32x4 s[4][2];
#pragma unroll
        for (int kb = 0; kb < 4; ++kb) { s[kb][0] = (f32x4){0.f, 0.f, 0.f, 0.f}; s[kb][1] = (f32x4){0.f, 0.f, 0.f, 0.f}; }
        __builtin_amdgcn_s_setprio(1);
        {
            constexpr int NG = 4 * NKK, KD = 4; bf16x8 af[KD + 1];
#define ATT_KOFF(g) ((((g) / (2 * NKK)) * 2 + ((g) & 1)) * 16 * KST + (((g) >> 1) % NKK) * 64)
#pragma unroll
            for (int j = 0; j < KD; ++j) af[j] = *(const LAS bf16x8*)(kb_ + ATT_KOFF(j) + fr * KST + fq * 16);
#pragma unroll
            for (int g = 0; g < NG; ++g) {
                if (g + KD < NG) af[(g + KD) % (KD + 1)] = *(const LAS bf16x8*)(kb_ + ATT_KOFF(g + KD) + fr * KST + fq * 16);
                __builtin_amdgcn_sched_barrier(0);
                { const int kb = (g / (2 * NKK)) * 2 + (g & 1), kk = (g >> 1) % NKK;
                  if (variant & 2) { s[kb][0][0] += (float)af[g % (KD + 1)][0]; }
                  else { s[kb][0] = __builtin_amdgcn_mfma_f32_16x16x32_bf16(af[g % (KD + 1)], qf[0][kk], s[kb][0], 0, 0, 0);
                         s[kb][1] = __builtin_amdgcn_mfma_f32_16x16x32_bf16(af[g % (KD + 1)], qf[1][kk], s[kb][1], 0, 0, 0); } }
                __builtin_amdgcn_sched_barrier(0);
            }
#undef ATT_KOFF
        }
        __builtin_amdgcn_s_setprio(0);
#pragma unroll
        for (int hf = 0; hf < 2; ++hf) {
            if (window && t < nt0) {
                const int kp0 = s0.kpos0 + t * 64 + fq * 8;
#pragma unroll
                for (int rb = 0; rb < 2; ++rb) { const int qp = qpos0 + rb * 16 + fr;
#pragma unroll
                    for (int kb = 2 * hf; kb < 2 * hf + 2; ++kb)
#pragma unroll
                        for (int i = 0; i < 4; ++i) { const int dlt = qp - (kp0 + (kb >> 1) * 32 + (kb & 1) * 4 + i); if (dlt > 128 || dlt < -128) s[kb][rb][i] = -1e30f; } }
            }
            bf16x8 pb[2];
#pragma unroll
            for (int rb = 0; rb < 2; ++rb) {
                if (variant & 1) { union { u32x4 u; bf16x8 b; } cv; cv.u.x = cvt_pk_bf16(s[2 * hf][rb][0], s[2 * hf][rb][1]); cv.u.y = cvt_pk_bf16(s[2 * hf][rb][2], s[2 * hf][rb][3]);
                    cv.u.z = cvt_pk_bf16(s[2 * hf + 1][rb][0], s[2 * hf + 1][rb][1]); cv.u.w = cvt_pk_bf16(s[2 * hf + 1][rb][2], s[2 * hf + 1][rb][3]); pb[rb] = cv.b; continue; }
                float mx = fmaxf(fmaxf(fmaxf(s[2 * hf][rb][0], s[2 * hf][rb][1]), fmaxf(s[2 * hf][rb][2], s[2 * hf][rb][3])), fmaxf(fmaxf(s[2 * hf + 1][rb][0], s[2 * hf + 1][rb][1]), fmaxf(s[2 * hf + 1][rb][2], s[2 * hf + 1][rb][3])));
                mx = fmaxf(mx, __shfl_xor(mx, 16)); mx = fmaxf(mx, __shfl_xor(mx, 32));
                const float mn = fmaxf(mrun[rb], mx);
                if (__builtin_amdgcn_ballot_w64(mn > mrun[rb]) != 0ull) {
                    const float alpha = fast_exp2(mrun[rb] - mn); lrun[rb] *= alpha;
#pragma unroll
                    for (int d = 0; d < NDVB; ++d) o[d][rb] = o[d][rb] * alpha; }
                mrun[rb] = mn;
                float ps = 0.f;
#pragma unroll
                for (int kb = 2 * hf; kb < 2 * hf + 2; ++kb)
#pragma unroll
                    for (int i = 0; i < 4; ++i) { const float p = fast_exp2(s[kb][rb][i] - mn); s[kb][rb][i] = p; ps += p; }
                lrun[rb] += ps;
                union { u32x4 u; bf16x8 b; } cv;
                cv.u.x = cvt_pk_bf16(s[2 * hf][rb][0], s[2 * hf][rb][1]); cv.u.y = cvt_pk_bf16(s[2 * hf][rb][2], s[2 * hf][rb][3]);
                cv.u.z = cvt_pk_bf16(s[2 * hf + 1][rb][0], s[2 * hf + 1][rb][1]); cv.u.w = cvt_pk_bf16(s[2 * hf + 1][rb][2], s[2 * hf + 1][rb][3]);
                pb[rb] = cv.b;
            }
            __builtin_amdgcn_sched_barrier(0);
            __builtin_amdgcn_s_setprio(1);
            {
                constexpr int VD = NDVB < 4 ? NDVB : 4; bf16x8 vf[VD + 1];
#define ATT_VREAD(d) (*(const LAS bf16x8*)(vb_ + ((d) * 16 + fr) * VST + (hf * 32 + fq * 8) * 2))
#pragma unroll
                for (int j = 0; j < VD; ++j) vf[j] = ATT_VREAD(j);
#pragma unroll
                for (int d = 0; d < NDVB; ++d) {
                    if (d + VD < NDVB) vf[(d + VD) % (VD + 1)] = ATT_VREAD(d + VD);
                    __builtin_amdgcn_sched_barrier(0);
                    if (variant & 2) { o[d][0][0] += (float)vf[d % (VD + 1)][0]; }
                    else { o[d][0] = __builtin_amdgcn_mfma_f32_16x16x32_bf16(vf[d % (VD + 1)], pb[0], o[d][0], 0, 0, 0);
                           o[d][1] = __builtin_amdgcn_mfma_f32_16x16x32_bf16(vf[d % (VD + 1)], pb[1], o[d][1], 0, 0, 0); }
                    __builtin_amdgcn_sched_barrier(0);
                }
#undef ATT_VREAD
            }
            __builtin_amdgcn_s_setprio(0);
        }
        if (t + 1 < nt && !(variant & 4)) ATT_STORE((t + 1) & 1);
        __syncthreads();
    }
#undef ATT_LOAD
#undef ATT_STORE
#undef ATT_KROW
#pragma unroll
    for (int rb = 0; rb < 2; ++rb) { float lt = lrun[rb]; lt += __shfl_xor(lt, 16); lt += __shfl_xor(lt, 32); const float inv = 1.0f / lt;
        bf16_t* orow = Ow + (size_t)(rb * 16 + fr) * ostride + fq * 4;
#pragma unroll
        for (int d = 0; d < NDVB; ++d) { const f32x4 v = o[d][rb] * inv; u32x2 w; w.x = cvt_pk_bf16(v[0], v[1]); w.y = cvt_pk_bf16(v[2], v[3]); *(u32x2*)(orow + d * 16) = w; } }
}

namespace gla {
constexpr int QST = 288, HST = 160, VST = 144, SST = 288;
constexpr int OFF_Q = 0, OFF_K = 64 * QST, OFF_KH = OFF_K + 64 * QST, OFF_V = OFF_KH + 128 * HST, OFF_S = OFF_V + 64 * VST, SBYTES = 64 * SST;
static_assert(OFF_S + 2 * SBYTES <= 131072, "gla lds");
struct Regs { u32x4 q[2], k[2], h[2], v; float dec; };
__device__ __forceinline__ void load(Regs& R, const bf16_t* QG, const bf16_t* KG, const bf16_t* KHT, const bf16_t* VT, const float* DEC, size_t r0, int h, int tid) {
    R.dec = DEC[(r0 >> 6) * 1024];
#pragma unroll
    for (int j = 0; j < 2; ++j) { const int pi = tid + NTHR * j, row = pi >> 4, cp = pi & 15;
        R.q[j] = *(const u32x4*)(QG + (r0 + row) * 512 + h * 128 + cp * 8); R.k[j] = *(const u32x4*)(KG + (r0 + row) * 512 + h * 128 + cp * 8);
        const int hr = pi >> 3, hc = pi & 7; R.h[j] = *(const u32x4*)(KHT + (size_t)(h * 128 + hr) * MROWS + r0 + hc * 8); }
    { const int row = tid >> 3, cp = tid & 7; R.v = *(const u32x4*)(VT + (size_t)row * MROWS + r0 + cp * 8); }
}
__device__ __forceinline__ void store(const Regs& R, ldsp lds, int tid) {
#pragma unroll
    for (int j = 0; j < 2; ++j) { const int pi = tid + NTHR * j, row = pi >> 4, cp = pi & 15;
        *(LAS u32x4*)(lds + OFF_Q + row * QST + cp * 16) = R.q[j]; *(LAS u32x4*)(lds + OFF_K + row * QST + cp * 16) = R.k[j];
        const int hr = pi >> 3, hc = pi & 7; *(LAS u32x4*)(lds + OFF_KH + hr * HST + hc * 16) = R.h[j]; }
    { const int row = tid >> 3, cp = tid & 7; *(LAS u32x4*)(lds + OFF_V + row * VST + cp * 16) = R.v; }
}
__device__ __forceinline__ void puts(const f32x4 (&st)[4], ldsp lds, int buf, int w, int fr, int fq) {
    ldsp s = lds + OFF_S + buf * SBYTES;
#pragma unroll
    for (int d = 0; d < 4; ++d)
#pragma unroll
        for (int i = 0; i < 4; ++i) *(LAS bf16_t*)(s + (d * 16 + fq * 4 + i) * SST + (w * 16 + fr) * 2) = f2bf(st[d][i]);
}
__device__ __forceinline__ void chunk(f32x4 (&st)[4], ldsp lds, int cur, float dec, int dir, float* og  , int w, int fr, int fq) {
    const int pbk = w >> 1, dh = w & 1;
    bf16x8 qf[4];
#pragma unroll
    for (int kk = 0; kk < 4; ++kk) qf[kk] = *(const LAS bf16x8*)(lds + OFF_Q + (pbk * 16 + fr) * QST + kk * 64 + fq * 16);
    f32x4 at[4];
#pragma unroll
    for (int sb = 0; sb < 4; ++sb) { at[sb] = (f32x4){0.f, 0.f, 0.f, 0.f};
#pragma unroll
        for (int kk = 0; kk < 4; ++kk) { const bf16x8 a = *(const LAS bf16x8*)(lds + OFF_K + (sb * 16 + fr) * QST + kk * 64 + fq * 16); at[sb] = __builtin_amdgcn_mfma_f32_16x16x32_bf16(a, qf[kk], at[sb], 0, 0, 0); }
        const int pt = pbk * 16 + fr;
#pragma unroll
        for (int i = 0; i < 4; ++i) { const int stok = sb * 16 + fq * 4 + i; const bool keep = dir ? (stok >= pt) : (stok <= pt); if (!keep) at[sb][i] = 0.f; } }
    bf16x8 pT[2];
#pragma unroll
    for (int ks = 0; ks < 2; ++ks) { union { u32x4 u; bf16x8 b; } cv;
        cv.u.x = cvt_pk_bf16(at[2 * ks][0], at[2 * ks][1]); cv.u.y = cvt_pk_bf16(at[2 * ks][2], at[2 * ks][3]); cv.u.z = cvt_pk_bf16(at[2 * ks + 1][0], at[2 * ks + 1][1]); cv.u.w = cvt_pk_bf16(at[2 * ks + 1][2], at[2 * ks + 1][3]); pT[ks] = cv.b; }
    const ldsp sb_ = lds + OFF_S + cur * SBYTES;
#pragma unroll
    for (int dd = 0; dd < 2; ++dd) { const int dvb = dh * 2 + dd; f32x4 oacc = (f32x4){0.f, 0.f, 0.f, 0.f};
#pragma unroll
        for (int ks = 0; ks < 2; ++ks) { union { u32x4 u; bf16x8 b; } av;
            const u32x2 lo = *(const LAS u32x2*)(lds + OFF_V + (dvb * 16 + fr) * VST + ((2 * ks) * 16 + fq * 4) * 2), hi = *(const LAS u32x2*)(lds + OFF_V + (dvb * 16 + fr) * VST + ((2 * ks + 1) * 16 + fq * 4) * 2);
            av.u.x = lo.x; av.u.y = lo.y; av.u.z = hi.x; av.u.w = hi.y;
            oacc = __builtin_amdgcn_mfma_f32_16x16x32_bf16(av.b, pT[ks], oacc, 0, 0, 0); }
#pragma unroll
        for (int kk = 0; kk < 4; ++kk) { const bf16x8 a = *(const LAS bf16x8*)(sb_ + (dvb * 16 + fr) * SST + kk * 64 + fq * 16); oacc = __builtin_amdgcn_mfma_f32_16x16x32_bf16(a, qf[kk], oacc, 0, 0, 0); }
        *(f32x4*)(og + (size_t)(pbk * 16 + fr) * 1024 + dvb * 16 + fq * 4) = oacc; }
    bf16x8 hb[2];
#pragma unroll
    for (int ks = 0; ks < 2; ++ks) hb[ks] = *(const LAS bf16x8*)(lds + OFF_KH + (w * 16 + fr) * HST + ks * 64 + fq * 16);
#pragma unroll
    for (int d = 0; d < 4; ++d) { st[d] = st[d] * dec;
#pragma unroll
        for (int ks = 0; ks < 2; ++ks) { const bf16x8 a = *(const LAS bf16x8*)(lds + OFF_V + (d * 16 + fr) * VST + ks * 64 + fq * 16); st[d] = __builtin_amdgcn_mfma_f32_16x16x32_bf16(a, hb[ks], st[d], 0, 0, 0); } }
    puts(st, lds, cur ^ 1, w, fr, fq);
}
}
__device__ __forceinline__ void gla_item(const Ctx& C, const int tid, int row0, int nchunk  , int h, int dir, int dvs, const float* s0, float* sout) {
    ldsp lds = C.lds; const int lane = tid & 63, w = C.wave, fr = lane & 15, fq = lane >> 4;
    const bf16_t* QG = WSP(bf16_t, WS_QG + (size_t)dir * SZ_G1); const bf16_t* KG = WSP(bf16_t, WS_KG + (size_t)dir * SZ_G1); const bf16_t* KHT = WSP(bf16_t, WS_KHT + (size_t)dir * SZ_G1);
    const bf16_t* VT = WSP(bf16_t, WS_VT) + (size_t)(h * 256 + dvs * 64) * MROWS; const float* DEC = WSP(float, WS_DEC) + (size_t)dir * 512 + h * 128 + w * 16 + fr;
    float* OG = WSP(float, WS_OG + (size_t)dir * SZ_OG1) + h * 256 + dvs * 64;
    f32x4 st[4];
#pragma unroll
    for (int d = 0; d < 4; ++d) st[d] = s0 ? *(const f32x4*)(s0 + (size_t)(w * 16 + fr) * 256 + dvs * 64 + d * 16 + fq * 4) : (f32x4){0.f, 0.f, 0.f, 0.f};
    const int c_first = dir ? nchunk - 1 : 0, c_step = dir ? -1 : 1;
#define GLA_ROW(n) ((size_t)row0 + (size_t)(c_first + (n) * c_step) * 64)
    gla::Regs RA, RB;
    gla::load(RA, QG, KG, KHT, VT, DEC, GLA_ROW(0), h, tid); gla::store(RA, lds, tid); float dec_cur = RA.dec;
    gla::load(RA, QG, KG, KHT, VT, DEC, GLA_ROW(1), h, tid);
    if (nchunk > 2) gla::load(RB, QG, KG, KHT, VT, DEC, GLA_ROW(2), h, tid);
    gla::puts(st, lds, 0, w, fr, fq);
    __syncthreads();
    for (int n = 0; n < nchunk; n += 2) {
        gla::chunk(st, lds, 0, dec_cur, dir, OG + GLA_ROW(n) * 1024, w, fr, fq);
        __syncthreads();
        gla::store(RA, lds, tid); dec_cur = RA.dec;
        if (n + 3 < nchunk) gla::load(RA, QG, KG, KHT, VT, DEC, GLA_ROW(n + 3), h, tid);
        __syncthreads();
        gla::chunk(st, lds, 1, dec_cur, dir, OG + GLA_ROW(n + 1) * 1024, w, fr, fq);
        __syncthreads();
        if (n + 2 < nchunk) { gla::store(RB, lds, tid); dec_cur = RB.dec;
            if (n + 4 < nchunk) gla::load(RB, QG, KG, KHT, VT, DEC, GLA_ROW(n + 4), h, tid); }
        __syncthreads();
    }
#undef GLA_ROW
    if (sout) {
#pragma unroll
        for (int d = 0; d < 4; ++d) *(f32x4*)(sout + (size_t)(w * 16 + fr) * 256 + dvs * 64 + d * 16 + fq * 4) = st[d]; }
}

#ifdef MIX_ONLY
#define MIXEN(k) ((k) == MIX_ONLY)
#else
#define MIXEN(k) true
#endif
__device__ __forceinline__ void phase_mixer(const Ctx& C, const int rep, const int mask, const int variant) {
    const int w = C.wave, l = C.l;
    unsigned* head = WSP(unsigned, WS_CTL) + CW_QUEUE + 64 * (l + 2 * rep);
    volatile LAS int* slot = (volatile LAS int*)(C.lds + LDS_MISC + 16);
    constexpr int N_GS = 64, N_MS = 128, N_SS = 256, N_GP = 512, N_MP = 128, N_SP = 256, NTOT = N_GS + N_MS + N_SS + N_GP + N_MP + N_SP;
    const bf16_t* QM = WSP(bf16_t, WS_QM); const bf16_t* KM = WSP(bf16_t, WS_KM); const bf16_t* VMT = WSP(bf16_t, WS_VMT); bf16_t* OMLA = WSP(bf16_t, WS_OMLA);
    const bf16_t* QS = WSP(bf16_t, WS_QS); const bf16_t* KS = WSP(bf16_t, WS_KS); const bf16_t* VT = WSP(bf16_t, WS_VT); const bf16_t* VSCT = WSP(bf16_t, WS_VSCT); bf16_t* OSWA = WSP(bf16_t, WS_OSWA);
    for (;;) {
        __syncthreads();
        if (C.tid == 0) *slot = (int)__hip_atomic_fetch_add(head, 1u, __ATOMIC_RELAXED, __HIP_MEMORY_SCOPE_AGENT);
        __syncthreads();
        int it = *slot;
        if (it >= NTOT) break;
        int tid = C.tid; asm volatile("" : "+v"(tid));
        if (it < N_MS + N_GS) it = (it < N_MS) ? it + N_GS : it - N_MS;
        if (it < N_GS) {
            const int b = it >> 5, h = (it >> 3) & 3, dir = (it >> 2) & 1, dvs = it & 3;
            if (MIXEN(0) && (mask & 1)) gla_item(C, tid, MPROMPT + b * 2048, 32, h, dir, dvs, C.in[6] + ((((size_t)(b * 2 + l) * 2 + dir) * 4 + h) * 128) * 256, nullptr);
            continue; }
        it -= N_GS;
        if (it < N_MS) {
            const int b = it >> 6, h = (it >> 3) & 7, qt = it & 7; const int rq = MPROMPT + b * 2048 + qt * 256 + w * 32;
            AttnSeg a0{KM + (size_t)(MPROMPT + b * 2048) * 1536 + h * 192, VMT + (size_t)(h * 128) * MKV + MPROMPT + b * 2048, 1536, MKV, 2048, 0};
            AttnSeg a1{KM + (size_t)(MROWS + b * 256) * 1536 + h * 192, VMT + (size_t)(h * 128) * MKV + MROWS + b * 256, 1536, MKV, 256, 0};
            if (MIXEN(1) && (mask & 2)) attn_item<192, 128>(C.lds, tid, QM + (size_t)rq * 1536 + h * 192, 1536, 0, a0, a1, false, -1e30f, 0.f, (rep ? WSP(bf16_t, WS_ACT) : OMLA) + (size_t)rq * 1024 + h * 128, 1024, rep ? variant : 0);
            continue; }
        it -= N_MS;
        if (it < N_SS) {
            const int b = it >> 7, kvh = (it >> 5) & 3, qt = it & 31; const int g = w >> 1, t0 = qt * 64, tq0 = t0 + (w & 1) * 32; const int rq = MPROMPT + b * 2048 + tq0, hd = kvh * 4 + g;
            const int tlo = (qt - 2 < 0 ? 0 : qt - 2), thi = (qt + 2 > 31 ? 31 : qt + 2);
            AttnSeg a0{KS + (size_t)(MPROMPT + b * 2048 + tlo * 64) * 256 + kvh * 64, VT + (size_t)(1024 + kvh * 64) * MROWS + MPROMPT + b * 2048 + tlo * 64, 256, MROWS, (thi - tlo + 1) * 64, tlo * 64};
            AttnSeg a1{KS + (size_t)(MROWS + b * 256) * 256 + kvh * 64, VSCT + ((size_t)b * 256 + kvh * 64) * 256, 256, 256, 256, 0};
            if (MIXEN(2) && (mask & 4)) attn_item<64, 64>(C.lds, tid, QS + (size_t)rq * 1024 + hd * 64, 1024, tq0, a0, a1, true, LIN(32, 16)[hd] * LOG2E, 1.0f, OSWA + (size_t)rq * 1024 + hd * 64, 1024);
            continue; }
        it -= N_SS;
        if (it < N_GP) {
            const int b = it >> 5, h = (it >> 3) & 3, dir = (it >> 2) & 1, dvs = it & 3;
            if (MIXEN(0) && (mask & 1)) gla_item(C, tid, b * 256, 4, h, dir, dvs, nullptr, C.out + O_SG + ((((size_t)(b * 2 + l) * 2 + dir) * 4 + h) * 128) * 256);
            continue; }
        it -= N_GP;
        if (it < N_MP) {
            const int b = it >> 3, h = it & 7; const int rq = b * 256 + w * 32;
            AttnSeg a0{KM + (size_t)(b * 256) * 1536 + h * 192, VMT + (size_t)(h * 128) * MKV + b * 256, 1536, MKV, 256, 0};
            AttnSeg a1{KM, VMT, 1536, MKV, 0, 0};
            if (MIXEN(1) && (mask & 2)) attn_item<192, 128>(C.lds, tid, QM + (size_t)rq * 1536 + h * 192, 1536, 0, a0, a1, false, -1e30f, 0.f, OMLA + (size_t)rq * 1024 + h * 128, 1024);
            continue; }
        it -= N_MP;
        {
            const int b = it >> 4, kvh = (it >> 2) & 3, qt = it & 3; const int g = w >> 1, tq0 = qt * 64 + (w & 1) * 32; const int rq = b * 256 + tq0, hd = kvh * 4 + g;
            AttnSeg a0{KS + (size_t)(b * 256) * 256 + kvh * 64, VT + (size_t)(1024 + kvh * 64) * MROWS + b * 256, 256, MROWS, 256, 0};
            AttnSeg a1{KS, VT, 256, MROWS, 0, 0};
            if (MIXEN(2) && (mask & 4)) attn_item<64, 64>(C.lds, tid, QS + (size_t)rq * 1024 + hd * 64, 1024, tq0, a0, a1, false, LIN(32, 16)[hd] * LOG2E, 1.0f, OSWA + (size_t)rq * 1024 + hd * 64, 1024);
        }
    }
}
#define MK_PER_PHASE 0

#ifndef PREP_REP_MODE
#define PREP_REP_MODE 0
#endif
#ifndef MK_PER_PHASE
#define MK_PER_PHASE 0
#endif
constexpr int NPH = 16;
struct Args { const float* in[37]; float* out; unsigned char* ws; int ph_lo, ph_hi; };

__global__ void __launch_bounds__(NTHR, 2) fwd_kernel(Args a) {
    extern __shared__ __attribute__((aligned(16))) unsigned char lds_raw[];
    Ctx C{a.in, a.out, a.ws, (ldsp)lds_raw, 0, 0, 0, 0, 0, 0};
    C.tid = threadIdx.x; C.lane = C.tid & 63; C.wave = __builtin_amdgcn_readfirstlane(C.tid >> 6); C.G = gridDim.x; C.bid = blockIdx.x; C.l = 0;
    if (C.tid < 16) ((LAS unsigned*)(C.lds + LDS_MISC))[C.tid] = 0u;
    __syncthreads();
    unsigned* ctl = (unsigned*)(a.ws + WS_CTL);
    XcdBarrier bar = xcd_barrier_post(ctl + CW_BAR, (volatile LAS unsigned*)(C.lds + LDS_MISC));
    const int lo = a.ph_lo, hi = a.ph_hi;
#define SITE(L) Ctx L = C; { int t_ = C.tid; asm volatile("" : "+v"(t_)); L.tid = t_; L.lane = t_ & 63; L.wave = __builtin_amdgcn_readfirstlane(t_ >> 6); }
    bf16_t* H = WSP(bf16_t, WS_H); bf16_t* ACT = WSP(bf16_t, WS_ACT); bf16_t* IN = WSP(bf16_t, WS_IN);
    for (int l = 0; l < 2; ++l) {
        C.l = l;
        const float* modl = WSP(float, WS_MOD) + (size_t)l * 3 * NMOD; const size_t wl = (size_t)l * SZ_WLAYER;
#ifdef ONLY_SITE
#define EN(s) ((s) == ONLY_SITE)
#else
#define EN(s) true
#endif
#define PH(k) (lo <= l * NPH + (k) && l * NPH + (k) < hi)
#define SEAM(k) do { if (PH(k) && (l * NPH + (k) + 1 < hi)) xcd_barrier(bar); } while (0)
#ifdef REPEAT_SITE
#define REPBEGIN(s) for (int rep = 0; rep < ((s) == REPEAT_SITE ? 2 : 1); ++rep) { if (rep) xcd_barrier(bar);
#define REPEND }
#else
#define REPBEGIN(s) { const int rep = 0; (void)rep;
#define REPEND }
#endif
        REPBEGIN(0) if (EN(0) && PH(0) && l == 0) { SITE(L); phase_prep(L); };
        REPEND if (l == 0) SEAM(0);
        for (int f = 0; f < 2; ++f) {
            const int kb = f ? 13 : 1;
            REPBEGIN(1) if (EN(1) && PH(kb)) { SITE(L); phase_norm(L, f ? 13 : 11, f ? 2 : 0, l == 0 && f == 0); }
            REPEND SEAM(kb);
            REPBEGIN(2) if (EN(2) && PH(kb + 1)) { pg8::MultiOrder<false> S{H, H, H, WSP(bf16_t, (f ? WS_WGU2 : WS_WGU1) + wl), nullptr, nullptr, MROWS / 256, NGU / 256, 0, 0, 0, 0, 1, C.G, C.bid}; pg8::EpiSwiglu E{ACT, DFF, rep};
                pg8::gemm_phase<pg8::EpiSwiglu, pg8::MultiOrder<false>, true, true>(C.lds, 2048, S, E);
                { const int ci = 2 * l + f; if (rep == 0 && ci < 3) { SITE(L); conv_queue(L, (ci + 1) >> 1, ci == 1 ? 0 : 1, 8 + ci, 1 << 30); } } }
            REPEND SEAM(kb + 1);
            REPBEGIN(3) if (EN(3) && PH(kb + 2)) { pg8::MultiOrder<false> S{ACT, ACT, ACT, WSP(bf16_t, (f ? WS_WD2 : WS_WD1) + wl), nullptr, nullptr, MROWS / 256, 2048 / 256, 0, 0, 0, 0, 1, C.G, C.bid}; const bool first = (l == 0 && f == 0 && rep == 0); pg8::EpiResid E{C.out, first ? a.in[0] : C.out, first ? a.in[1] - (size_t)MPROMPT * D : C.out, modl, f ? 8 : 2, rep ? 0.f : 0.5f};
                pg8::gemm_phase<pg8::EpiResid, pg8::MultiOrder<false>, false, true>(C.lds, DFF, S, E); }
            REPEND SEAM(kb + 2);
            if (f == 1) break;
#if defined(REPEAT_SITE) && REPEAT_SITE == 20
            for (int xb = 0; xb < 10; ++xb) xcd_barrier(bar);
#endif
            REPBEGIN(4) if (EN(4) && PH(4)) { SITE(L); phase_norm(L, 12, 1, false); }
            REPEND SEAM(4);
            REPBEGIN(5) if (EN(5) && PH(5)) {
                pg8::MultiOrder<false> S{H, WSP(bf16_t, WS_WINS + wl), nullptr, WSP(bf16_t, WS_WIN + wl), H, nullptr, MROWS / 256, NIN / 256, NSW / 256, MROWS / 256, 0, 0, 2, C.G, C.bid};
                pg8::EpiIn E{IN, WSP(float, WS_INF), WSP(bf16_t, WS_VT), rep};
                pg8::gemm_phase<pg8::EpiIn, pg8::MultiOrder<false>, true, true>(C.lds, 2048, S, E); }
            REPEND SEAM(5);
            REPBEGIN(6) if (EN(6) && PH(6)) { SITE(L); phase_prepa(L, rep ? PREP_REP_MODE : 7); };
            REPEND SEAM(6);
            REPBEGIN(7) if (EN(7) && PH(7)) {
                pg8::MultiOrder<false> S{WSP(bf16_t, WS_CQN), WSP(bf16_t, WS_CKVN), WSP(bf16_t, WS_WUV + wl), WSP(bf16_t, WS_WUQ + wl), WSP(bf16_t, WS_WUK + wl), WSP(bf16_t, WS_CKVN),
                                         MROWS / 256, 1536 / 256, MKV / 256, 1024 / 256, 1024 / 256, MKV / 256, 3, C.G, C.bid};
                pg8::EpiBf E{WSP(bf16_t, WS_QRAW), WSP(bf16_t, WS_KNRAW), WSP(bf16_t, WS_VMT), 1536, 1024, MKV};
                pg8::gemm_phase<pg8::EpiBf, pg8::MultiOrder<false>, true, true>(C.lds, 512, S, E); }
            REPEND SEAM(7);
            REPBEGIN(8) if (EN(8) && PH(8)) { SITE(L); phase_prepb(L); };
            REPEND SEAM(8);
            REPBEGIN(9) if (EN(9) && PH(9)) { SITE(L); phase_mixer(L, rep, rep ? (PREP_REP_MODE & 7) : 7, PREP_REP_MODE >> 4); };
            REPEND SEAM(9);
            REPBEGIN(10) if (EN(10) && PH(10)) { SITE(L); phase_post(L); };
            REPEND SEAM(10);
            REPBEGIN(11) if (EN(11) && PH(11)) {
                pg8::MultiOrder<true> S{WSP(bf16_t, WS_OMLA), WSP(bf16_t, WS_OGN), WSP(bf16_t, WS_OSWA), WSP(bf16_t, WS_WBR + wl), WSP(bf16_t, WS_WBR + SZ_WBR + wl), WSP(bf16_t, WS_WBR + 2 * SZ_WBR + wl),
                                        MROWS / 256, 2048 / 256, MROWS / 256, 2048 / 256, MROWS / 256, 2048 / 256, 3, C.G, C.bid};
                pg8::EpiBranch E{IN + C_GATE, NIN, H};
                pg8::gemm_phase<pg8::EpiBranch, pg8::MultiOrder<true>, true, true>(C.lds, 1024, S, E); }
            REPEND SEAM(11);
            REPBEGIN(12) if (EN(12) && PH(12)) { pg8::MultiOrder<false> S{H, H, H, WSP(bf16_t, WS_WOUT + wl), nullptr, nullptr, MROWS / 256, 2048 / 256, 0, 0, 0, 0, 1, C.G, C.bid}; pg8::EpiResid E{C.out, C.out, C.out, modl, 5, rep ? 0.f : 1.0f};
                pg8::gemm_phase<pg8::EpiResid, pg8::MultiOrder<false>, false, true>(C.lds, 2048, S, E); }
            REPEND SEAM(12);
        }
#undef PH
#undef EN
#undef SEAM
    }
}

extern "C" void kernel_launch(void* const* d_in, const int* in_sizes, int n_in, void* d_out, int out_size, void* d_ws, size_t ws_size, hipStream_t stream) {
    static int grid = 0;
    if (grid == 0) {
        if (n_in != 37 || out_size != (int)O_END || ws_size < WS_END) { fprintf(stderr, "kernel_launch: unexpected sizes n_in %d out %d ws %zu (need %zu)\n", n_in, out_size, ws_size, (size_t)WS_END); grid = -1; return; }
        int dev = 0, cus = 0, per_cu = 0;
        if (hipGetDevice(&dev) != hipSuccess || hipDeviceGetAttribute(&cus, hipDeviceAttributeMultiprocessorCount, dev) != hipSuccess) { grid = -1; return; }
        if (hipFuncSetAttribute((const void*)fwd_kernel, hipFuncAttributeMaxDynamicSharedMemorySize, LDS_BYTES) != hipSuccess) { fprintf(stderr, "kernel_launch: hipFuncSetAttribute failed\n"); grid = -1; return; }
        if (hipOccupancyMaxActiveBlocksPerMultiprocessor(&per_cu, (const void*)fwd_kernel, NTHR, LDS_BYTES) != hipSuccess || per_cu < 1) { fprintf(stderr, "kernel_launch: occupancy query says %d blocks per CU\n", per_cu); }
        (void)hipGetLastError();
        grid = cus;
    }
    if (grid < 0) return;
    if (hipMemsetAsync((char*)d_ws + WS_CTL, 0, SZ_CTL, stream) != hipSuccess) return;
    Args a{};
    for (int i = 0; i < 37; ++i) a.in[i] = (const float*)d_in[i];
    a.out = (float*)d_out; a.ws = (unsigned char*)d_ws;
#if MK_PER_PHASE
    for (int p = 0; p < 2 * NPH; ++p) { a.ph_lo = p; a.ph_hi = p + 1; hipLaunchKernelGGL(fwd_kernel, dim3(grid), dim3(NTHR), LDS_BYTES, stream, a); }
#else
    a.ph_lo = 0; a.ph_hi = 2 * NPH;
    hipLaunchKernelGGL(fwd_kernel, dim3(grid), dim3(NTHR), LDS_BYTES, stream, a);
#endif
    (void)in_sizes;
}
```

```cpp
#include <hip/hip_runtime.h>
#include <cstdio>
#include <cstdint>

#define LAS __attribute__((address_space(3)))
typedef unsigned short bf16_t;
typedef short bf16x8 __attribute__((ext_vector_type(8)));
typedef float f32x4 __attribute__((ext_vector_type(4)));
typedef float f32x2 __attribute__((ext_vector_type(2)));
typedef unsigned u32x4 __attribute__((ext_vector_type(4)));
typedef unsigned u32x2 __attribute__((ext_vector_type(2)));
typedef LAS unsigned char* ldsp;

__device__ __forceinline__ unsigned cvt_pk_bf16(float lo, float hi) { unsigned r; asm volatile("v_cvt_pk_bf16_f32 %0, %1, %2" : "=v"(r) : "v"(lo), "v"(hi)); return r; }
__device__ __forceinline__ float bf_lo(unsigned w) { return __uint_as_float(w << 16); }
__device__ __forceinline__ float bf_hi(unsigned w) { return __uint_as_float(w & 0xffff0000u); }
__device__ __forceinline__ float bf1(bf16_t b) { return __uint_as_float(((unsigned)b) << 16); }
__device__ __forceinline__ bf16_t f2bf(float f) { return (bf16_t)(cvt_pk_bf16(f, 0.f) & 0xffffu); }
__device__ __forceinline__ float fast_rcp(float x) { return __builtin_amdgcn_rcpf(x); }
__device__ __forceinline__ float fast_exp2(float x) { return __builtin_amdgcn_exp2f(x); }
__device__ __forceinline__ float sigmoidf_(float a) { return fast_rcp(1.0f + fast_exp2(-1.44269504f * a)); }
__device__ __forceinline__ float siluf_(float a) { return a * sigmoidf_(a); }
__device__ __forceinline__ float wave_sum(float v) {
#pragma unroll
    for (int o = 1; o < 64; o <<= 1) v += __shfl_xor(v, o);
    return v;
}
namespace pg8 {
#define PG8_LAS __attribute__((address_space(3)))
constexpr int BM = 256, BK = 64, HALF = 128, HTB = HALF * BK * 2  , STAGE_BYTES = 8 * HTB, NXCD = 8, WGM = 8;

__host__ __device__ __forceinline__ int lds_byte(int r, int c) { const int st = (r >> 4) * 2 + (c >> 5), rr = r & 15, cc = c & 31, ob = rr * 64 + cc * 2; return st * 1024 + (ob ^ (((ob >> 9) & 1) << 5)); }
__host__ __device__ __forceinline__ void stage_rc(int b, int& R, int& C) { const int st = b / 1024, sb = b % 1024, swz = sb ^ (((sb >> 9) & 1) << 5); R = (st >> 1) * 16 + swz / 64; C = (st & 1) * 32 + (swz % 64) / 2; }
__host__ __device__ __forceinline__ int perm32(int rho) { const int n = rho >> 4, i = rho & 15; return 8 * (i >> 2) + 4 * n + (i & 3); }

template <class T> __device__ __forceinline__ T sel3(int s, T a, T b, T c) { T r = a; if (s == 1) r = b; if (s == 2) r = c; return r; }
struct Unit { int pm, pn, sub; };
__device__ __forceinline__ void tile_of(int wgid, int nwg, int nM, int nN, int& pm, int& pn) {
    { const int q = nwg / NXCD, r = nwg % NXCD, xcd = wgid % NXCD, off = wgid / NXCD; wgid = (xcd < r ? xcd * (q + 1) : r * (q + 1) + (xcd - r) * q) + off; }
    const int nig = WGM * nN, gid = wgid / nig, fm = gid * WGM, gsz = (nM - fm) < WGM ? (nM - fm) : WGM;
    pm = fm + ((wgid % nig) % gsz); pn = (wgid % nig) / gsz;
}
template <bool TILEMAJOR> struct MultiOrder {
    const bf16_t* A0; const bf16_t* A1; const bf16_t* A2; const bf16_t* B0; const bf16_t* B1; const bf16_t* B2;
    int nM0, nN0, nM1, nN1, nM2, nN2, nsub, G, c;
    __device__ __forceinline__ bool next(int i, Unit& u) const {
        if (TILEMAJOR) { const int j = i / nsub, s = i - j * nsub; const long L = (long)j * G + c; const int nwg = nM0 * nN0; if (L >= nwg) return false;
            u.sub = s; tile_of((int)L, nwg, nM0, nN0, u.pm, u.pn); return true; }
        long L = (long)i * G + c; const int w0 = nM0 * nN0, w1 = nM1 * nN1, w2 = nM2 * nN2;
        if (L < w0) { u.sub = 0; tile_of((int)L, w0, nM0, nN0, u.pm, u.pn); return true; } L -= w0;
        if (L < w1) { u.sub = 1; tile_of((int)L, w1, nM1, nN1, u.pm, u.pn); return true; } L -= w1;
        if (L < w2) { u.sub = 2; tile_of((int)L, w2, nM2, nN2, u.pm, u.pn); return true; }
        return false;
    }
    __device__ __forceinline__ const char* a_tile(const Unit& u, size_t tstep) const { const bf16_t* p = sel3<const bf16_t*>(u.sub, A0, A1, A2); return (const char*)p + (size_t)u.pm * tstep; }
    __device__ __forceinline__ const char* b_tile(const Unit& u, size_t tstep) const { const bf16_t* p = sel3<const bf16_t*>(u.sub, B0, B1, B2); return (const char*)p + (size_t)u.pn * tstep; }
    __device__ __forceinline__ void a_ready(const Unit&) const {}
    __device__ __forceinline__ void done(const Unit&) const {}
};

__device__ __forceinline__ int cond_of_tile(int pm) { return pm < 16 ? 0 : 1 + ((pm - 16) >> 3); }

struct EpiSwiglu {
    static constexpr bool PERM = true, AFTER_DRAIN = false, KEEP_ACC = false;
    bf16_t* O; int ldc; int skip;
    __device__ __forceinline__ void operator()(const f32x4 (&acc)[2][2][4][2], const Unit& u, int wr, int wc, int fr, int fq) const {
        if (skip) { asm volatile("" :: "v"(acc[0][0][0][0]), "v"(acc[1][1][3][1])); return; }
        const int row0 = u.pm * BM + wr * 64 + fr, col0 = u.pn * HALF + wc * 32 + 8 * fq;
#pragma unroll
        for (int ai = 0; ai < 2; ++ai)
#pragma unroll
            for (int m = 0; m < 4; ++m) {
                bf16_t* rowp = O + (size_t)(row0 + ai * HALF + m * 16) * ldc + col0;
                f32x4 r0, r1;
#pragma unroll
                for (int j = 0; j < 4; ++j) { r0[j] = siluf_(acc[ai][0][m][0][j]) * acc[ai][1][m][0][j]; r1[j] = siluf_(acc[ai][0][m][1][j]) * acc[ai][1][m][1][j]; }
                u32x4 w; w.x = cvt_pk_bf16(r0[0], r0[1]); w.y = cvt_pk_bf16(r0[2], r0[3]); w.z = cvt_pk_bf16(r1[0], r1[1]); w.w = cvt_pk_bf16(r1[2], r1[3]);
                *(u32x4*)rowp = w;
            }
    }
};
struct EpiResid {
    static constexpr bool PERM = false, AFTER_DRAIN = false, KEEP_ACC = false;
    float* X; const float* Xin0; const float* Xin1; const float* modl; int gidx; float coef;
    __device__ __forceinline__ void operator()(const f32x4 (&acc)[2][2][4][2], const Unit& u, int wr, int wc, int fr, int fq) const {
        const int row0 = u.pm * BM + wr * 64 + fr, col0 = u.pn * BM + wc * 32 + 4 * fq;
        const float* g = modl + cond_of_tile(u.pm) * 18432 + gidx * 2048 + col0;
        f32x4 gv[2][2];
#pragma unroll
        for (int bj = 0; bj < 2; ++bj)
#pragma unroll
            for (int n = 0; n < 2; ++n) gv[bj][n] = *(const f32x4*)(g + bj * HALF + n * 16) * coef;
        const float* src = (u.pm < 16 ? Xin0 : Xin1);
#pragma unroll
        for (int ai = 0; ai < 2; ++ai)
#pragma unroll
            for (int mp = 0; mp < 2; ++mp) {
                f32x4 xv[2][2][2];
#pragma unroll
                for (int m = 0; m < 2; ++m) { const float* srcp = src + (size_t)(row0 + ai * HALF + (mp * 2 + m) * 16) * 2048 + col0;
#pragma unroll
                    for (int bj = 0; bj < 2; ++bj)
#pragma unroll
                        for (int n = 0; n < 2; ++n) xv[m][bj][n] = *(const f32x4*)(srcp + bj * HALF + n * 16); }
#pragma unroll
                for (int m = 0; m < 2; ++m) { float* rowp = X + (size_t)(row0 + ai * HALF + (mp * 2 + m) * 16) * 2048 + col0;
#pragma unroll
                    for (int bj = 0; bj < 2; ++bj)
#pragma unroll
                        for (int n = 0; n < 2; ++n) *(f32x4*)(rowp + bj * HALF + n * 16) = xv[m][bj][n] + gv[bj][n] * acc[ai][bj][mp * 2 + m][n]; }
            }
    }
};
struct EpiIn {
    static constexpr bool PERM = true, AFTER_DRAIN = false, KEEP_ACC = false;
    bf16_t* IN; float* INF; bf16_t* VT; int skip;
    __device__ __forceinline__ void operator()(const f32x4 (&acc)[2][2][4][2], const Unit& u, int wr, int wc, int fr, int fq) const {
        if (skip) { asm volatile("" :: "v"(acc[0][0][0][0]), "v"(acc[1][1][3][1])); return; }
        const int row0 = u.pm * BM + wr * 64 + fr, cin = wc * 32 + 8 * fq, pn = u.pn;
        if (u.sub == 1) {
#pragma unroll
            for (int ai = 0; ai < 2; ++ai)
#pragma unroll
                for (int m = 0; m < 4; ++m) { bf16_t* rowp = VT + (size_t)(row0 + ai * HALF + m * 16) * 8192 + pn * BM + cin;
#pragma unroll
                    for (int bj = 0; bj < 2; ++bj) { const f32x4 v0 = acc[ai][bj][m][0], v1 = acc[ai][bj][m][1];
                        u32x4 w; w.x = cvt_pk_bf16(v0[0], v0[1]); w.y = cvt_pk_bf16(v0[2], v0[3]); w.z = cvt_pk_bf16(v1[0], v1[1]); w.w = cvt_pk_bf16(v1[2], v1[3]);
                        *(u32x4*)(rowp + bj * HALF) = w; } }
            return; }
        int fbase = -1;
        if (pn == 2) fbase = 0; else if (pn == 3) fbase = 256; else if (pn == 4) fbase = 512; else if (pn == 17) fbase = 768; else if (pn == 18) fbase = 1024;
        if (fbase >= 0) {
#pragma unroll
            for (int ai = 0; ai < 2; ++ai)
#pragma unroll
                for (int m = 0; m < 4; ++m) { float* rowp = INF + (size_t)(row0 + ai * HALF + m * 16) * 1280 + fbase + cin;
#pragma unroll
                    for (int bj = 0; bj < 2; ++bj) { *(f32x4*)(rowp + bj * HALF) = acc[ai][bj][m][0]; *(f32x4*)(rowp + bj * HALF + 4) = acc[ai][bj][m][1]; } }
        } else {
#pragma unroll
            for (int ai = 0; ai < 2; ++ai)
#pragma unroll
                for (int m = 0; m < 4; ++m) { bf16_t* rowp = IN + (size_t)(row0 + ai * HALF + m * 16) * 11008 + pn * BM + cin;
#pragma unroll
                    for (int bj = 0; bj < 2; ++bj) { const f32x4 v0 = acc[ai][bj][m][0], v1 = acc[ai][bj][m][1];
                        u32x4 w; w.x = cvt_pk_bf16(v0[0], v0[1]); w.y = cvt_pk_bf16(v0[2], v0[3]); w.z = cvt_pk_bf16(v1[0], v1[1]); w.w = cvt_pk_bf16(v1[2], v1[3]);
                        *(u32x4*)(rowp + bj * HALF) = w; } }
        }
    }
};
struct EpiBf {
    static constexpr bool PERM = true, AFTER_DRAIN = false, KEEP_ACC = false;
    bf16_t* O0; bf16_t* O1; bf16_t* O2; int ld0, ld1, ld2;
    __device__ __forceinline__ void operator()(const f32x4 (&acc)[2][2][4][2], const Unit& u, int wr, int wc, int fr, int fq) const {
        const int row0 = u.pm * BM + wr * 64 + fr, col0 = u.pn * BM + wc * 32 + 8 * fq;
        bf16_t* O = sel3<bf16_t*>(u.sub, O0, O1, O2); const int ldc = sel3<int>(u.sub, ld0, ld1, ld2);
#pragma unroll
        for (int ai = 0; ai < 2; ++ai)
#pragma unroll
            for (int m = 0; m < 4; ++m) { bf16_t* rowp = O + (size_t)(row0 + ai * HALF + m * 16) * ldc + col0;
#pragma unroll
                for (int bj = 0; bj < 2; ++bj) { const f32x4 v0 = acc[ai][bj][m][0], v1 = acc[ai][bj][m][1];
                    u32x4 w; w.x = cvt_pk_bf16(v0[0], v0[1]); w.y = cvt_pk_bf16(v0[2], v0[3]); w.z = cvt_pk_bf16(v1[0], v1[1]); w.w = cvt_pk_bf16(v1[2], v1[3]);
                    *(u32x4*)(rowp + bj * HALF) = w; } }
    }
};
struct EpiGate {
    static constexpr bool PERM = true, AFTER_DRAIN = false, KEEP_ACC = false;
    bf16_t* G; int ldg;
    __device__ __forceinline__ void operator()(const f32x4 (&acc)[2][2][4][2], const Unit& u, int wr, int wc, int fr, int fq) const {
        const int row0 = u.pm * BM + wr * 64 + fr, col0 = u.sub * 2048 + u.pn * BM + wc * 32 + 8 * fq;
#pragma unroll
        for (int ai = 0; ai < 2; ++ai)
#pragma unroll
            for (int m = 0; m < 4; ++m) { bf16_t* rowp = G + (size_t)(row0 + ai * HALF + m * 16) * ldg + col0;
#pragma unroll
                for (int bj = 0; bj < 2; ++bj) { const f32x4 v0 = acc[ai][bj][m][0], v1 = acc[ai][bj][m][1];
                    u32x4 w; w.x = cvt_pk_bf16(v0[0], v0[1]); w.y = cvt_pk_bf16(v0[2], v0[3]); w.z = cvt_pk_bf16(v1[0], v1[1]); w.w = cvt_pk_bf16(v1[2], v1[3]);
                    *(u32x4*)(rowp + bj * HALF) = w; } }
    }
};
struct EpiBranch {
    static constexpr bool PERM = true, AFTER_DRAIN = false, KEEP_ACC = true;
    const bf16_t* gate0; int ldg; bf16_t* OUT;
    __device__ __forceinline__ float ratio(float a, float b, bool last) const {
        a = fminf(fmaxf(a, -30.f), 30.f); b = fminf(fmaxf(b, -30.f), 30.f);
        const float ia = fast_rcp(1.0f + fast_exp2(-1.44269504f * a)); return last ? ia : ia * (1.0f + fast_exp2(-1.44269504f * b)); }
    __device__ __forceinline__ void operator()(f32x4 (&acc)[2][2][4][2], const Unit& u, int wr, int wc, int fr, int fq) const {
        const int row0 = u.pm * BM + wr * 64 + fr, col0 = u.pn * BM + wc * 32 + 8 * fq; const int s = u.sub; const bool last = s == 2;
        const bf16_t* ga = gate0 + s * 2048; const bf16_t* gb = gate0 + (last ? s : s + 1) * 2048;
#pragma unroll
        for (int ai = 0; ai < 2; ++ai)
#pragma unroll
            for (int m = 0; m < 4; ++m) { const size_t row = (size_t)(row0 + ai * HALF + m * 16);
#pragma unroll
                for (int bj = 0; bj < 2; ++bj) {
                    const u32x4 wa = *(const u32x4*)(ga + row * ldg + col0 + bj * HALF), wb = *(const u32x4*)(gb + row * ldg + col0 + bj * HALF);
                    f32x4 r0, r1;
                    r0[0] = ratio(bf_lo(wa.x), bf_lo(wb.x), last); r0[1] = ratio(bf_hi(wa.x), bf_hi(wb.x), last); r0[2] = ratio(bf_lo(wa.y), bf_lo(wb.y), last); r0[3] = ratio(bf_hi(wa.y), bf_hi(wb.y), last);
                    r1[0] = ratio(bf_lo(wa.z), bf_lo(wb.z), last); r1[1] = ratio(bf_hi(wa.z), bf_hi(wb.z), last); r1[2] = ratio(bf_lo(wa.w), bf_lo(wb.w), last); r1[3] = ratio(bf_hi(wa.w), bf_hi(wb.w), last);
                    const f32x4 v0 = acc[ai][bj][m][0] * r0, v1 = acc[ai][bj][m][1] * r1;
                    acc[ai][bj][m][0] = v0; acc[ai][bj][m][1] = v1;
                    if (last) { u32x4 w; w.x = cvt_pk_bf16(v0[0], v0[1]); w.y = cvt_pk_bf16(v0[2], v0[3]); w.z = cvt_pk_bf16(v1[0], v1[1]); w.w = cvt_pk_bf16(v1[2], v1[3]);
                        *(u32x4*)(OUT + row * 2048 + col0 + bj * HALF) = w; }
                } }
    }
};
template <class Epi, class Sched, bool ALIGN_EPI = false, bool SP2 = false>
__device__ __forceinline__ void gemm_phase(PG8_LAS unsigned char* lds, const int K, const Sched& S, const Epi& E) {
    int tid_ = threadIdx.x; asm volatile("" : "+v"(tid_));
    const int tid = tid_, wid = __builtin_amdgcn_readfirstlane(tid >> 6), lane = tid & 63, wr = wid >> 2, wc = wid & 3, fr = lane & 15, fq = lane >> 4;
    const int nt = K / BK;
    unsigned voffA[2], voffB[2];
#pragma unroll
    for (int i = 0; i < 2; ++i) { int R, C; stage_rc(tid * 16 + i * 8192, R, C); const int Rb = Epi::PERM ? ((R & ~31) + perm32(R & 31)) : R;
        voffA[i] = (unsigned)(R * K + C) * 2u; voffB[i] = (unsigned)(Rb * K + C) * 2u; }
    const size_t kstep = (size_t)(BK * 2);
    const size_t hstep = (size_t)HALF * K * 2;
    const size_t tstep = 2 * hstep;
    const unsigned ldsw = (unsigned)wid * 1024u;
    const int aoff = lds_byte(wr * 64 + fr, fq * 8), boff = lds_byte(wc * 32 + fr, fq * 8);
#define PG8_SA(b, h) (((b) * 2 + (h)) * HTB)
#define PG8_SB(b, h) ((4 + (b) * 2 + (h)) * HTB)
#define PG8_STAGE(bufoff, gbase, voff) do { _Pragma("unroll") for (int _i = 0; _i < 2; ++_i) \
        __builtin_amdgcn_global_load_lds((const unsigned*)((const char*)(gbase) + (voff)[_i]), (PG8_LAS unsigned*)(lds + (bufoff) + ldsw + _i * 8192), 16, 0, 0); } while (0)
#define PG8_LDA(dst, b, h) do { _Pragma("unroll") for (int m = 0; m < 4; ++m) _Pragma("unroll") for (int k = 0; k < 2; ++k) dst[m][k] = *(const PG8_LAS bf16x8*)(lds + PG8_SA(b, h) + aoff + m * 2048 + k * 1024); } while (0)
#define PG8_LDB(dst, b, h) do { _Pragma("unroll") for (int n = 0; n < 2; ++n) _Pragma("unroll") for (int k = 0; k < 2; ++k) dst[n][k] = *(const PG8_LAS bf16x8*)(lds + PG8_SB(b, h) + boff + n * 2048 + k * 1024); } while (0)
#define PG8_MMA(ai, bj, At, Bt) do { __builtin_amdgcn_s_setprio(1); _Pragma("unroll") for (int m = 0; m < 4; ++m) _Pragma("unroll") for (int n = 0; n < 2; ++n) _Pragma("unroll") for (int k = 0; k < 2; ++k) \
        acc[ai][bj][m][n] = __builtin_amdgcn_mfma_f32_16x16x32_bf16(Bt[n][k], At[m][k], acc[ai][bj][m][n], 0, 0, 0); __builtin_amdgcn_s_setprio(0); } while (0)
#define PG8_WAIT_V(n) asm volatile("s_waitcnt vmcnt(" #n ")" ::: "memory")
#define PG8_WAIT_L(n) asm volatile("s_waitcnt lgkmcnt(" #n ")" ::: "memory")
#define PG8_BAR __builtin_amdgcn_s_barrier()
#define PG8_SCHED __builtin_amdgcn_sched_barrier(0)
    Unit cur, nxt; int ui = 0;
    if (!S.next(0, cur)) return;
    f32x4 acc[2][2][4][2];
#pragma unroll
    for (int a = 0; a < 2; ++a)
#pragma unroll
        for (int b = 0; b < 2; ++b)
#pragma unroll
            for (int m = 0; m < 4; ++m)
#pragma unroll
                for (int n = 0; n < 2; ++n) acc[a][b][m][n] = (f32x4){0.f, 0.f, 0.f, 0.f};
    bf16x8 At[4][2], B0[2][2], B1[2][2];
    const char* cA = S.a_tile(cur, tstep); const char* cB = S.b_tile(cur, tstep);
    S.a_ready(cur);
    if constexpr (SP2) {
        PG8_STAGE(PG8_SB(0, 0), cB, voffB); PG8_STAGE(PG8_SB(0, 1), cB + hstep, voffB); PG8_STAGE(PG8_SA(0, 0), cA, voffA); PG8_STAGE(PG8_SA(0, 1), cA + hstep, voffA);
        if (wr == 1) PG8_BAR;
        PG8_WAIT_V(2); PG8_BAR;
        PG8_STAGE(PG8_SB(1, 0), cB + kstep, voffB); PG8_STAGE(PG8_SA(1, 0), cA + kstep, voffA); PG8_STAGE(PG8_SB(1, 1), cB + hstep + kstep, voffB);
        PG8_WAIT_V(6); PG8_BAR;
    } else {
        PG8_STAGE(PG8_SB(0, 0), cB, voffB); PG8_STAGE(PG8_SA(0, 0), cA, voffA); PG8_STAGE(PG8_SB(0, 1), cB + hstep, voffB); PG8_STAGE(PG8_SA(0, 1), cA + hstep, voffA);
        if (wr == 1) PG8_BAR;
        PG8_WAIT_V(4); PG8_BAR;
        PG8_STAGE(PG8_SB(1, 0), cB + kstep, voffB); PG8_STAGE(PG8_SA(1, 0), cA + kstep, voffA); PG8_STAGE(PG8_SB(1, 1), cB + hstep + kstep, voffB);
        PG8_WAIT_V(6); PG8_BAR;
    }
    for (;;) {
        const bool has_next = S.next(ui + 1, nxt);
        const char* nA = has_next ? S.a_tile(nxt, tstep) : cA; const char* nB = has_next ? S.b_tile(nxt, tstep) : cB;
        asm volatile(".p2align 8" ::: );
        for (int t = 0; t < nt; t += 2) {
            const bool last = (t == nt - 2);
            const char* a1 = cA + (size_t)(t + 1) * kstep;
            const char* a2 = last ? nA : cA + (size_t)(t + 2) * kstep; const char* b2 = last ? nB : cB + (size_t)(t + 2) * kstep;
            const char* a3 = a2 + kstep; const char* b3 = b2 + kstep;
            if (last && has_next) S.a_ready(nxt);
            if constexpr (SP2) {
            PG8_LDB(B0, 0, 0); PG8_LDB(B1, 0, 1); PG8_SCHED; PG8_LDA(At, 0, 0); PG8_STAGE(PG8_SA(1, 1), a1 + hstep, voffA);
            PG8_WAIT_V(8); PG8_WAIT_L(0); PG8_BAR; PG8_MMA(0, 0, At, B0); PG8_MMA(0, 1, At, B1); PG8_BAR; PG8_SCHED;
            PG8_LDA(At, 0, 1); PG8_STAGE(PG8_SB(0, 0), b2, voffB); PG8_STAGE(PG8_SB(0, 1), b2 + hstep, voffB); PG8_STAGE(PG8_SA(0, 0), a2, voffA);
            PG8_WAIT_V(8); PG8_WAIT_L(0); PG8_BAR; PG8_MMA(1, 0, At, B0); PG8_MMA(1, 1, At, B1); PG8_BAR; PG8_SCHED;
            PG8_LDB(B0, 1, 0); PG8_LDB(B1, 1, 1); PG8_SCHED; PG8_LDA(At, 1, 0); PG8_STAGE(PG8_SA(0, 1), a2 + hstep, voffA);
            PG8_WAIT_V(8); PG8_WAIT_L(0); PG8_BAR; PG8_MMA(0, 0, At, B0); PG8_MMA(0, 1, At, B1); PG8_BAR; PG8_SCHED;
            PG8_LDA(At, 1, 1); PG8_STAGE(PG8_SB(1, 0), b3, voffB); PG8_STAGE(PG8_SB(1, 1), b3 + hstep, voffB); PG8_STAGE(PG8_SA(1, 0), a3, voffA);
            PG8_WAIT_V(8); PG8_WAIT_L(0); PG8_BAR; PG8_MMA(1, 0, At, B0); PG8_MMA(1, 1, At, B1); PG8_BAR; PG8_SCHED;
            } else {
            PG8_LDB(B0, 0, 0); PG8_SCHED; PG8_LDA(At, 0, 0); PG8_STAGE(PG8_SA(1, 1), a1 + hstep, voffA);
            PG8_WAIT_L(8); PG8_BAR; PG8_WAIT_L(0); PG8_MMA(0, 0, At, B0); PG8_BAR; PG8_SCHED;
            PG8_LDB(B1, 0, 1); PG8_STAGE(PG8_SB(0, 0), b2, voffB);
            PG8_BAR; PG8_WAIT_L(0); PG8_MMA(0, 1, At, B1); PG8_BAR;
            PG8_LDA(At, 0, 1); PG8_STAGE(PG8_SA(0, 0), a2, voffA);
            PG8_BAR; PG8_WAIT_L(0); PG8_MMA(1, 0, At, B0); PG8_BAR; PG8_SCHED;
            PG8_STAGE(PG8_SB(0, 1), b2 + hstep, voffB);
            PG8_WAIT_V(6); PG8_BAR; PG8_MMA(1, 1, At, B1); PG8_BAR;
            PG8_LDB(B0, 1, 0); PG8_SCHED; PG8_LDA(At, 1, 0); PG8_STAGE(PG8_SA(0, 1), a2 + hstep, voffA);
            PG8_WAIT_L(8); PG8_BAR; PG8_WAIT_L(0); PG8_MMA(0, 0, At, B0); PG8_BAR; PG8_SCHED;
            PG8_LDB(B1, 1, 1); PG8_STAGE(PG8_SB(1, 0), b3, voffB);
            PG8_BAR; PG8_WAIT_L(0); PG8_MMA(0, 1, At, B1); PG8_BAR;
            PG8_LDA(At, 1, 1); PG8_STAGE(PG8_SA(1, 0), a3, voffA);
            PG8_BAR; PG8_WAIT_L(0); PG8_MMA(1, 0, At, B0); PG8_BAR; PG8_SCHED;
            PG8_STAGE(PG8_SB(1, 1), b3 + hstep, voffB);
            PG8_WAIT_V(6); PG8_BAR; PG8_MMA(1, 1, At, B1); PG8_BAR;
            }
        }
        if constexpr (ALIGN_EPI) { if (wr == 0) PG8_BAR; }
        if constexpr (!Epi::AFTER_DRAIN) { E(acc, cur, wr, wc, fr, fq); S.done(cur); }
        if (!has_next) break;
        if (!(Epi::KEEP_ACC && nxt.sub != 0)) {
#pragma unroll
        for (int a = 0; a < 2; ++a)
#pragma unroll
            for (int b = 0; b < 2; ++b)
#pragma unroll
                for (int m = 0; m < 4; ++m)
#pragma unroll
                    for (int n = 0; n < 2; ++n) acc[a][b][m][n] = (f32x4){0.f, 0.f, 0.f, 0.f};
        }
        cur = nxt; cA = nA; cB = nB; ++ui;
        if constexpr (ALIGN_EPI) { if (wr == 1) PG8_BAR; }
    }
    PG8_WAIT_V(0);
    if constexpr (!ALIGN_EPI) { if (wr == 0) PG8_BAR; }
    PG8_BAR;
    if constexpr (Epi::AFTER_DRAIN) { E.fused(acc, cur, wr, wc, fr, fq, lds, wid, lane); S.done(cur); }
#undef PG8_SA
#undef PG8_SB
#undef PG8_STAGE
#undef PG8_LDA
#undef PG8_LDB
#undef PG8_MMA
#undef PG8_WAIT_V
#undef PG8_WAIT_L
#undef PG8_BAR
#undef PG8_SCHED
}
}

constexpr int NWAVES = 8, NTHR = 512;
constexpr int D = 2048, MROWS = 8192, MPROMPT = 4096, DFF = 5632, NGU = 11264, NMOD = 18432;
constexpr int NIN = 11008, LDF = 1280, NSW = 1280, MKV = 8704;
constexpr int C_CQ = 0, C_GQ = 1280, C_GK = 1792, C_GOUT = 2304, C_SQ = 3328, C_GATE = 4864;
constexpr int F_CKV = 0, F_KPE = 512, F_GG = 576, F_SK = 768, F_SV = 1024;
constexpr float EPS = 1e-6f, LOG2E = 1.4426950408889634f;
constexpr float MLA_QSCALE = 0.07216878364870322f * LOG2E;
constexpr float SWA_QSCALE = 0.125f * LOG2E;
constexpr float GLA_QSCALE = 0.08838834764831845f;
constexpr size_t O_X = 0, O_CKV = 16777216, O_KPE = 20971520, O_SK = 21495808, O_SV = 23592960, O_SG = 25690112, O_END = 34078720;
constexpr size_t al4k(size_t x) { return (x + 4095) & ~(size_t)4095; }
constexpr size_t WS_CTL = 0, SZ_CTL = 1u << 20;
constexpr size_t WS_MOD = WS_CTL + SZ_CTL;                 constexpr size_t SZ_MOD = al4k((size_t)2 * 3 * NMOD * 4);
constexpr size_t WS_ROPE = WS_MOD + SZ_MOD;                constexpr size_t SZ_ROPE = al4k(2 * 1024 * 4);
constexpr size_t WS_DEC = WS_ROPE + SZ_ROPE;               constexpr size_t SZ_DEC = al4k((size_t)128 * 2 * 512 * 4);
constexpr size_t WS_WGU1 = WS_DEC + SZ_DEC;                constexpr size_t SZ_WGU = (size_t)NGU * D * 2;
constexpr size_t WS_WD1 = WS_WGU1 + SZ_WGU;                constexpr size_t SZ_WD = (size_t)D * DFF * 2;
constexpr size_t WS_WGU2 = WS_WD1 + SZ_WD;
constexpr size_t WS_WD2 = WS_WGU2 + SZ_WGU;
constexpr size_t WS_WIN = WS_WD2 + SZ_WD;                  constexpr size_t SZ_WIN = (size_t)NIN * D * 2;
constexpr size_t WS_WINS = WS_WIN + SZ_WIN;                constexpr size_t SZ_WINS = (size_t)NSW * D * 2;
constexpr size_t WS_WUQ = WS_WINS + SZ_WINS;               constexpr size_t SZ_WUQ = (size_t)1536 * 512 * 2;
constexpr size_t WS_WUK = WS_WUQ + SZ_WUQ;                 constexpr size_t SZ_WUK = (size_t)1024 * 512 * 2;
constexpr size_t WS_WUV = WS_WUK + SZ_WUK;
constexpr size_t WS_WBR = WS_WUV + SZ_WUK;                 constexpr size_t SZ_WBR = (size_t)2048 * 1024 * 2;
constexpr size_t WS_WOUT = WS_WBR + 3 * SZ_WBR;            constexpr size_t SZ_WOUT = (size_t)2048 * 2048 * 2;
constexpr size_t SZ_WLAYER = WS_WOUT + SZ_WOUT - WS_WGU1;
constexpr size_t WS_H = WS_WGU1 + 2 * SZ_WLAYER;                 constexpr size_t SZ_H = (size_t)MROWS * D * 2;
constexpr size_t WS_ACT = WS_H + SZ_H;                     constexpr size_t SZ_ACT = (size_t)MROWS * DFF * 2;
constexpr size_t WS_MF = WS_ACT;                           constexpr size_t SZ_MF = (size_t)MROWS * 2048 * 4;
constexpr size_t WS_QRAW = WS_MF + SZ_MF;                  constexpr size_t SZ_QRAW = (size_t)MROWS * 1536 * 2;
static_assert(SZ_MF + SZ_QRAW <= SZ_ACT, "alias");
constexpr size_t WS_IN = WS_ACT + SZ_ACT;                  constexpr size_t SZ_IN = (size_t)MROWS * NIN * 2;
constexpr size_t WS_INF = WS_IN + SZ_IN;                   constexpr size_t SZ_INF = (size_t)MROWS * LDF * 4;
constexpr size_t WS_VT = WS_INF + SZ_INF;                  constexpr size_t SZ_VT = (size_t)NSW * MROWS * 2;
constexpr size_t WS_CQN = WS_VT + SZ_VT;                   constexpr size_t SZ_CQN = (size_t)MROWS * 512 * 2;
constexpr size_t WS_CKVN = WS_CQN + SZ_CQN;                constexpr size_t SZ_CKVN = (size_t)MKV * 512 * 2;
constexpr size_t WS_KNRAW = WS_CKVN + SZ_CKVN;             constexpr size_t SZ_KNRAW = (size_t)MKV * 1024 * 2;
constexpr size_t WS_QM = WS_KNRAW + SZ_KNRAW;              constexpr size_t SZ_QM = (size_t)MROWS * 1536 * 2;
constexpr size_t WS_KM = WS_QM + SZ_QM;                    constexpr size_t SZ_KM = (size_t)MKV * 1536 * 2;
constexpr size_t WS_VMT = WS_KM + SZ_KM;                   constexpr size_t SZ_VMT = (size_t)1024 * MKV * 2;
constexpr size_t WS_QS = WS_VMT + SZ_VMT;                  constexpr size_t SZ_QS = (size_t)MROWS * 1024 * 2;
constexpr size_t WS_KS = WS_QS + SZ_QS;                    constexpr size_t SZ_KS = (size_t)MKV * 256 * 2;
constexpr size_t WS_VSCT = WS_KS + SZ_KS;                  constexpr size_t SZ_VSCT = (size_t)2 * 256 * 256 * 2;
constexpr size_t WS_QG = WS_VSCT + SZ_VSCT;                constexpr size_t SZ_G1 = (size_t)MROWS * 512 * 2;
constexpr size_t WS_KG = WS_QG + 2 * SZ_G1;
constexpr size_t WS_KHT = WS_KG + 2 * SZ_G1;
constexpr size_t WS_OG = WS_KHT + 2 * SZ_G1;               constexpr size_t SZ_OG1 = (size_t)MROWS * 1024 * 4;
constexpr size_t WS_OMLA = WS_OG + 2 * SZ_OG1;             constexpr size_t SZ_O = (size_t)MROWS * 1024 * 2;
constexpr size_t WS_OGN = WS_OMLA + SZ_O;
constexpr size_t WS_OSWA = WS_OGN + SZ_O;
constexpr size_t WS_END = WS_OSWA + SZ_O;
static_assert(WS_END < (size_t)1150 * 1024 * 1024, "workspace budget");
constexpr int CW_BAR = 4096, CW_QUEUE = 16384, CW_PANEL = 32768;
constexpr int LDS_MISC = 131072, LDS_BYTES = 147456;

#define XB_TMO      128
#define XB_XCNT(j)  (256  + 64 * (j))
#define XB_XSUB(j)  (1280 + 64 * (j))
#define XB_XGEN(j)  (2304 + 64 * (j))
#define XB_TOP      3328
#define XB_TOPGEN   3392
#define XCD_BAR_WORDS 3456
#define XB_SPIN_CAP (1u << 18)
__device__ __forceinline__ unsigned xb_ld(unsigned* p)              { return __hip_atomic_load(p, __ATOMIC_RELAXED, __HIP_MEMORY_SCOPE_AGENT); }
__device__ __forceinline__ unsigned xb_add(unsigned* p, unsigned v) { return __hip_atomic_fetch_add(p, v, __ATOMIC_RELAXED, __HIP_MEMORY_SCOPE_AGENT); }
__device__ __forceinline__ unsigned xb_xcc_id() { return (unsigned)__builtin_amdgcn_s_getreg((3 << 11) | 20) & 0xFu; }
#define XB_SPIN(cond, bar) do { unsigned _sp = 0; while (cond) { __builtin_amdgcn_s_sleep(1); \
    if ((++_sp & 255u) == 0u) { if (xb_ld(&(bar)[XB_TMO])) break; if (_sp > XB_SPIN_CAP) { atomicAdd(&(bar)[XB_TMO], 1u); break; } } } } while (0)
struct XcdBarrier { unsigned* bar; unsigned x; volatile LAS unsigned* st; };
__device__ __forceinline__ XcdBarrier xcd_barrier_post(unsigned* bar, volatile LAS unsigned* st) {
    XcdBarrier b; b.bar = bar; b.x = xb_xcc_id(); b.st = st;
    if (threadIdx.x == 0) (void)xb_add(&bar[XB_XCNT(b.x)], 1u);
    return b;
}
__device__ __forceinline__ void xcd_barrier_complete(unsigned* bar, unsigned x, unsigned& nloc, unsigned& nx) {
    const unsigned G = gridDim.x * gridDim.y * gridDim.z;
    unsigned sum, cnt, mine, sp = 0u;
    for (;;) {
        sum = 0u; cnt = 0u; mine = 0u;
#pragma unroll
        for (unsigned j = 0; j < 16; ++j) { const unsigned c = xb_ld(&bar[XB_XCNT(j)]); sum += c; cnt += (c > 0u) ? 1u : 0u; mine = (j == x) ? c : mine; }
        if (sum == G) break;
        __builtin_amdgcn_s_sleep(1);
        if ((++sp & 255u) == 0u) { if (xb_ld(&bar[XB_TMO])) break; if (sp > XB_SPIN_CAP) { atomicAdd(&bar[XB_TMO], 1u); break; } }
    }
    nloc = mine > 0u ? mine : 1u; nx = cnt > 0u ? cnt : 1u;
}
__device__ __forceinline__ void xcd_barrier(const XcdBarrier& b) {
    asm volatile("s_waitcnt vmcnt(0)" ::: "memory");
    __syncthreads();
    if (threadIdx.x == 0) {
        unsigned* bar = b.bar;
        __builtin_amdgcn_s_waitcnt(0);
        unsigned nloc = b.st[0], nx = b.st[1];
        if (nloc == 0u) { xcd_barrier_complete(bar, b.x, nloc, nx); b.st[0] = nloc; b.st[1] = nx; }
        const unsigned old = xb_add(&bar[XB_XSUB(b.x)], 1u);
        const unsigned gen = old / nloc;
        if (old + 1u == (gen + 1u) * nloc) {
            __builtin_amdgcn_fence(__ATOMIC_RELEASE, "agent");
            asm volatile("s_waitcnt vmcnt(0)" ::: "memory");
            const unsigned og = xb_add(&bar[XB_TOP], 1u);
            const unsigned tg = og / nx;
            if (og + 1u == (tg + 1u) * nx) xb_add(&bar[XB_TOPGEN], 1u);
            else XB_SPIN(xb_ld(&bar[XB_TOPGEN]) == tg, bar);
            __builtin_amdgcn_fence(__ATOMIC_ACQUIRE, "agent");
            xb_add(&bar[XB_XGEN(b.x)], 1u);
            asm volatile("s_waitcnt vmcnt(0)" ::: "memory");
        } else {
            XB_SPIN(xb_ld(&bar[XB_XGEN(b.x)]) == gen, bar);
            __builtin_amdgcn_fence(__ATOMIC_ACQUIRE, "agent");
            asm volatile("s_waitcnt vmcnt(0)" ::: "memory");
        }
    }
    __syncthreads();
}

struct Ctx {
    const float* const* in; float* out; unsigned char* ws; ldsp lds;
    int tid, lane, wave, G, bid, l;
};
#define WSP(T, off) ((T*)(C.ws + (off)))
#define LIN(i, per) (C.in[i] + (size_t)C.l * (per))

template <int KIND> __device__ __forceinline__ int rowmap(int j) {
    if (KIND == 0) return j;
    if (KIND == 1) { const int p = j >> 8, q = j & 255; return q < 128 ? 128 * p + q : DFF + 128 * p + (q - 128); }
    if (KIND == 2) {
        if (j < 1024) return j;
        if (j < 1280) { const int m = j - 1024; return m < 64 ? 1024 + m : (m < 96 ? 4160 + (m - 64) : -1); }
        if (j < 1792) return 1088 + (j - 1280);
        if (j < 2304) return 1600 + (j - 1792);
        if (j < 3328) return 3136 + (j - 2304);
        if (j < 4352) return 4192 + (j - 3328);
        if (j < 4608) return 5216 + (j - 4352);
        if (j < 4864) return 5472 + (j - 4608);
        return 5728 + (j - 4864);
    }
    if (KIND == 3) return j < 1024 ? 2112 + j : 5472 + (j - 1024);
    if (KIND == 4) return (j >> 7) * 256 + (j & 127);
    return (j >> 7) * 256 + 128 + (j & 127);
}
template <int KIND> __device__ __forceinline__ void conv_item(const float* __restrict__ src, bf16_t* __restrict__ dst, int K, int N, int item, int tid) {
    const int nkb = K >> 7, jb = item / nkb, kb = item - jb * nkb, lane = tid & 63, w = tid >> 6;
    const int j = jb * 256 + lane * 4, sc = rowmap<KIND>(j), k0 = kb * 128 + w * 16;
    f32x4 v[16];
    if (sc >= 0) { const float* p = src + (size_t)k0 * N + sc;
#pragma unroll
        for (int i = 0; i < 16; ++i) v[i] = __builtin_nontemporal_load((const f32x4*)(p + (size_t)i * N)); }
    else {
#pragma unroll
        for (int i = 0; i < 16; ++i) v[i] = (f32x4){0.f, 0.f, 0.f, 0.f}; }
#pragma unroll
    for (int jj = 0; jj < 4; ++jj) { bf16_t* o = dst + (size_t)(j + jj) * K + k0;
#pragma unroll
        for (int g = 0; g < 2; ++g) { u32x4 wv; wv.x = cvt_pk_bf16(v[g * 8 + 0][jj], v[g * 8 + 1][jj]); wv.y = cvt_pk_bf16(v[g * 8 + 2][jj], v[g * 8 + 3][jj]); wv.z = cvt_pk_bf16(v[g * 8 + 4][jj], v[g * 8 + 5][jj]); wv.w = cvt_pk_bf16(v[g * 8 + 6][jj], v[g * 8 + 7][jj]);
            *(u32x4*)(o + g * 8) = wv; } }
}
constexpr int I_GU = (NGU / 256) * 16, I_DN = (2048 / 256) * 44, I_IN = (NIN / 256) * 16, I_INS = (NSW / 256) * 16, I_UQ = 6 * 4, I_UK = 4 * 4, I_BR = 8 * 8, I_OUT = 8 * 16;
constexpr int NCONV_A = 2 * I_GU + I_DN, NCONV_B = I_DN + I_IN + I_INS + I_UQ + 2 * I_UK + 3 * I_BR + I_OUT;
#define LINW(i, per) (C.in[i] + (size_t)lw * (per))
#define WSW(off) ((bf16_t*)(C.ws + (off) + (size_t)lw * SZ_WLAYER))
__device__ __forceinline__ void conv_dispatch(const Ctx& C, const int lw, const int win, int r, const int tid) {
    if (win == 0) {
        if (r < I_GU) { conv_item<1>(LINW(14, (size_t)2048 * NGU), WSW(WS_WGU1), 2048, NGU, r, tid); return; } r -= I_GU;
        if (r < I_GU) { conv_item<1>(LINW(16, (size_t)2048 * NGU), WSW(WS_WGU2), 2048, NGU, r, tid); return; } r -= I_GU;
        conv_item<0>(LINW(17, (size_t)DFF * 2048), WSW(WS_WD2), DFF, 2048, r, tid); return;
    }
    if (r < I_DN) { conv_item<0>(LINW(15, (size_t)DFF * 2048), WSW(WS_WD1), DFF, 2048, r, tid); return; } r -= I_DN;
    if (r < I_IN) { conv_item<2>(LINW(18, (size_t)2048 * 11872), WSW(WS_WIN), 2048, 11872, r, tid); return; } r -= I_IN;
    if (r < I_INS) { conv_item<3>(LINW(18, (size_t)2048 * 11872), WSW(WS_WINS), 2048, 11872, r, tid); return; } r -= I_INS;
    if (r < I_UQ) { conv_item<0>(LINW(20, (size_t)512 * 1536), WSW(WS_WUQ), 512, 1536, r, tid); return; } r -= I_UQ;
    if (r < I_UK) { conv_item<4>(LINW(22, (size_t)512 * 2048), WSW(WS_WUK), 512, 2048, r, tid); return; } r -= I_UK;
    if (r < I_UK) { conv_item<5>(LINW(22, (size_t)512 * 2048), WSW(WS_WUV), 512, 2048, r, tid); return; } r -= I_UK;
    if (r < I_BR) { conv_item<0>(LINW(33, (size_t)1024 * 2048), WSW(WS_WBR), 1024, 2048, r, tid); return; } r -= I_BR;
    if (r < I_BR) { conv_item<0>(LINW(34, (size_t)1024 * 2048), WSW(WS_WBR + SZ_WBR), 1024, 2048, r, tid); return; } r -= I_BR;
    if (r < I_BR) { conv_item<0>(LINW(35, (size_t)1024 * 2048), WSW(WS_WBR + 2 * SZ_WBR), 1024, 2048, r, tid); return; } r -= I_BR;
    conv_item<0>(LINW(36, (size_t)2048 * 2048), WSW(WS_WOUT), 2048, 2048, r, tid);
}
__device__ __forceinline__ void conv_queue(const Ctx& C, const int lw, const int win, const int q, const int maxitems) {
    unsigned* head = WSP(unsigned, WS_CTL) + CW_QUEUE + 64 * q; volatile LAS int* slot = (volatile LAS int*)(C.lds + LDS_MISC + 16);
    const int n = win == 0 ? NCONV_A : NCONV_B;
    for (int cnt = 0; cnt < maxitems; ++cnt) {
        __syncthreads();
        if (C.tid == 0) *slot = (int)__hip_atomic_fetch_add(head, 1u, __ATOMIC_RELAXED, __HIP_MEMORY_SCOPE_AGENT);
        __syncthreads();
        const int it = *slot;
        if (it >= n) break;
        int tid = C.tid; asm volatile("" : "+v"(tid));
        conv_dispatch(C, lw, win, it, tid);
    }
}
__device__ __forceinline__ void conv_some(const Ctx& C, const int c0, const int k) {
    volatile LAS int* slot = (volatile LAS int*)(C.lds + LDS_MISC + 16);
    for (int j = 0; j < k; ++j) {
        __syncthreads();
        if (C.tid == 0) {
            int code = -1;
            for (int c = c0; c < 3; ++c) {
                const int n = (c == 1) ? NCONV_A : NCONV_B;
                unsigned* head = WSP(unsigned, WS_CTL) + CW_QUEUE + 64 * (8 + c);
                if (__hip_atomic_load(head, __ATOMIC_RELAXED, __HIP_MEMORY_SCOPE_AGENT) >= (unsigned)n) continue;
                const int it = (int)__hip_atomic_fetch_add(head, 1u, __ATOMIC_RELAXED, __HIP_MEMORY_SCOPE_AGENT);
                if (it < n) { code = c * 65536 + it; break; }
            }
            *slot = code;
        }
        __syncthreads();
        const int code = *slot;
        if (code < 0) break;
        const int c = code >> 16, it = code & 65535;
        int tid = C.tid; asm volatile("" : "+v"(tid));
        conv_dispatch(C, (c + 1) >> 1, c == 1 ? 0 : 1, it, tid);
    }
}
__device__ __forceinline__ void phase_prep(const Ctx& C) {
    const int tid = C.tid, lane = C.lane, w = C.wave;
    LAS float* sc = (LAS float*)C.lds; LAS float* red = (LAS float*)(C.lds + 24576);
    for (int i = tid; i < 3 * 2048; i += NTHR) { const int c = i >> 11, k = i & 2047; const float v = (c == 0) ? C.in[8][k] : C.in[7][(c - 1) * 2048 + k]; sc[i] = siluf_(v); }
    __syncthreads();
    constexpr int I_ADA = 2 * (NMOD / 64);
    for (int it = C.bid; it < I_ADA + NCONV_A; it += C.G) {
        if (it < I_ADA) {
            const int la = it / (NMOD / 64), r = it - la * (NMOD / 64);
            const float* Wada = C.in[9] + (size_t)la * 2048 * NMOD; const float* bada = C.in[10] + (size_t)la * NMOD; float* modl = WSP(float, WS_MOD) + (size_t)la * 3 * NMOD;
            const int col = r * 64 + lane; float a0 = 0.f, a1 = 0.f, a2 = 0.f; const float* p = Wada + (size_t)(w * 256) * NMOD + col;
            for (int k = 0; k < 256; k += 32) { float wv[32];
#pragma unroll
                for (int i = 0; i < 32; ++i) wv[i] = __builtin_nontemporal_load(p + (size_t)(k + i) * NMOD);
#pragma unroll
                for (int i = 0; i < 32; ++i) { const int kk = w * 256 + k + i; a0 += sc[kk] * wv[i]; a1 += sc[2048 + kk] * wv[i]; a2 += sc[4096 + kk] * wv[i]; } }
            red[(w * 3 + 0) * 64 + lane] = a0; red[(w * 3 + 1) * 64 + lane] = a1; red[(w * 3 + 2) * 64 + lane] = a2;
            __syncthreads();
            if (w < 3) { float s = bada[col]; for (int ww = 0; ww < 8; ++ww) s += red[(ww * 3 + w) * 64 + lane]; modl[w * NMOD + col] = s; }
            __syncthreads();
            continue; }
        conv_dispatch(C, 0, 0, it - I_ADA, tid);
    }
    if (C.bid == 0) { float* rp = WSP(float, WS_ROPE);
        for (int i = tid; i < 1024; i += NTHR) { const int pos = i >> 4, f = i & 15; const float inv = fast_exp2(-(float)f * (13.287712379549449f / 16.0f));
            float rev = (float)pos * inv * 0.15915494309189535f; rev -= floorf(rev);
            rp[i] = __builtin_amdgcn_cosf(rev); rp[1024 + i] = __builtin_amdgcn_sinf(rev); } }
}

__device__ __forceinline__ void phase_norm(const Ctx& C, int gin, int mi, bool from_input) {
    const float* g = LIN(gin, D); const float* modl = WSP(float, WS_MOD) + (size_t)C.l * 3 * NMOD; bf16_t* H = WSP(bf16_t, WS_H);
    const int lane = C.lane; const float* x0 = from_input ? C.in[0] : C.out; const float* x1 = from_input ? C.in[1] - (size_t)MPROMPT * D : C.out;
    constexpr int U = 4;
    for (int q = C.bid * NWAVES + C.wave; q < MROWS / U; q += C.G * NWAVES) {
        const int r = U * q; const int c = r < MPROMPT ? 0 : 1 + ((r - MPROMPT) >> 11);
        const float* sh = modl + c * NMOD + (3 * mi) * 2048; const float* scl = sh + 2048;
        const f32x4* xr = (const f32x4*)((r < MPROMPT ? x0 : x1) + (size_t)r * D) + lane;
        f32x4 v[U][8]; float ss[U];
#pragma unroll
        for (int u = 0; u < U; ++u)
#pragma unroll
            for (int j = 0; j < 8; ++j) v[u][j] = __builtin_nontemporal_load(xr + u * 512 + 64 * j);
#pragma unroll
        for (int u = 0; u < U; ++u) { ss[u] = 0.f;
#pragma unroll
            for (int j = 0; j < 8; ++j) ss[u] += (v[u][j][0] * v[u][j][0] + v[u][j][1] * v[u][j][1]) + (v[u][j][2] * v[u][j][2] + v[u][j][3] * v[u][j][3]); }
#pragma unroll
        for (int o = 1; o < 64; o <<= 1) {
#pragma unroll
            for (int u = 0; u < U; ++u) ss[u] += __shfl_xor(ss[u], o); }
        float rs[U];
#pragma unroll
        for (int u = 0; u < U; ++u) rs[u] = rsqrtf(ss[u] * (1.0f / D) + EPS);
        u32x2* o = (u32x2*)(H + (size_t)r * D) + lane;
#pragma unroll
        for (int j = 0; j < 8; ++j) { const int col = 4 * lane + 256 * j; const f32x4 gg = *(const f32x4*)(g + col), s1 = *(const f32x4*)(scl + col), s0 = *(const f32x4*)(sh + col);
            f32x4 gm;
#pragma unroll
            for (int e = 0; e < 4; ++e) gm[e] = gg[e] * (1.0f + s1[e]);
#pragma unroll
            for (int u = 0; u < U; ++u) { const f32x4 y = v[u][j] * rs[u] * gm + s0; u32x2 w; w.x = cvt_pk_bf16(y[0], y[1]); w.y = cvt_pk_bf16(y[2], y[3]); o[u * 512 + 64 * j] = w; } }
    }
}

__device__ __forceinline__ float logsig16(float z) { return (fminf(z, 0.f) - __logf(1.0f + __expf(-fabsf(z)))) * (1.0f / 16.0f); }
__device__ __forceinline__ void prepa_gla_item(const Ctx& C, int chunk, int h) {
    const int tid = C.tid, l = C.l, k = tid & 127, tq = tid >> 7, r0 = chunk * 64;
    LAS float* gg = (LAS float*)C.lds; LAS float* tot = (LAS float*)(C.lds + 8192);
    const float* INF = WSP(float, WS_INF); const bf16_t* IN = WSP(bf16_t, WS_IN);
    { const int idx = tid * 4, t = idx >> 5, j = idx & 31; *(LAS f32x4*)(gg + idx) = *(const f32x4*)(INF + (size_t)(r0 + t) * LDF + F_GG + j); }
    __syncthreads();
    const float* wgf = LIN(25, 16 * 512) + h * 128 + k; const float* wgb = LIN(27, 16 * 512) + h * 128 + k;
    float wf[16], wb[16];
#pragma unroll
    for (int j = 0; j < 16; ++j) { wf[j] = wgf[j * 512]; wb[j] = wgb[j * 512]; }
    const float bfv = LIN(26, 512)[h * 128 + k], bbv = LIN(28, 512)[h * 128 + k];
    float cf[16], cb[16];
#pragma unroll
    for (int i = 0; i < 16; ++i) { const LAS float* gr = gg + (tq * 16 + i) * 32; float zf = bfv, zb = bbv;
#pragma unroll
        for (int j = 0; j < 16; ++j) { zf += gr[j] * wf[j]; zb += gr[16 + j] * wb[j]; }
        cf[i] = logsig16(zf); cb[i] = logsig16(zb); }
#pragma unroll
    for (int i = 1; i < 16; ++i) cf[i] += cf[i - 1];
#pragma unroll
    for (int i = 14; i >= 0; --i) cb[i] += cb[i + 1];
    tot[(0 * 4 + tq) * 128 + k] = cf[15]; tot[(1 * 4 + tq) * 128 + k] = cb[0];
    __syncthreads();
    float off_f = 0.f, off_b = 0.f, bl_f = 0.f, bl_b = 0.f;
#pragma unroll
    for (int q = 0; q < 4; ++q) { const float tf = tot[q * 128 + k], tb = tot[(4 + q) * 128 + k]; bl_f += tf; bl_b += tb; if (q < tq) off_f += tf; if (q > tq) off_b += tb; }
    bf16_t* QG0 = WSP(bf16_t, WS_QG); bf16_t* QG1 = WSP(bf16_t, WS_QG + SZ_G1); bf16_t* KG0 = WSP(bf16_t, WS_KG); bf16_t* KG1 = WSP(bf16_t, WS_KG + SZ_G1);
    bf16_t* KHT0 = WSP(bf16_t, WS_KHT); bf16_t* KHT1 = WSP(bf16_t, WS_KHT + SZ_G1);
    float khf[16], khb[16];
#pragma unroll
    for (int i = 0; i < 16; ++i) { const size_t r = (size_t)(r0 + tq * 16 + i);
        const float q = bf1(IN[r * NIN + C_GQ + h * 128 + k]) * GLA_QSCALE, kk = bf1(IN[r * NIN + C_GK + h * 128 + k]);
        const float bf_ = off_f + cf[i], bb_ = off_b + cb[i];
        const size_t o = r * 512 + h * 128 + k;
        QG0[o] = f2bf(q * __expf(bf_)); KG0[o] = f2bf(kk * __expf(-bf_)); khf[i] = kk * __expf(bl_f - bf_);
        QG1[o] = f2bf(q * __expf(bb_)); KG1[o] = f2bf(kk * __expf(-bb_)); khb[i] = kk * __expf(bl_b - bb_); }
    { u32x4 a, b; a.x = cvt_pk_bf16(khf[0], khf[1]); a.y = cvt_pk_bf16(khf[2], khf[3]); a.z = cvt_pk_bf16(khf[4], khf[5]); a.w = cvt_pk_bf16(khf[6], khf[7]);
      b.x = cvt_pk_bf16(khf[8], khf[9]); b.y = cvt_pk_bf16(khf[10], khf[11]); b.z = cvt_pk_bf16(khf[12], khf[13]); b.w = cvt_pk_bf16(khf[14], khf[15]);
      u32x4* p = (u32x4*)(KHT0 + (size_t)(h * 128 + k) * MROWS + r0 + tq * 16); p[0] = a; p[1] = b; }
    { u32x4 a, b; a.x = cvt_pk_bf16(khb[0], khb[1]); a.y = cvt_pk_bf16(khb[2], khb[3]); a.z = cvt_pk_bf16(khb[4], khb[5]); a.w = cvt_pk_bf16(khb[6], khb[7]);
      b.x = cvt_pk_bf16(khb[8], khb[9]); b.y = cvt_pk_bf16(khb[10], khb[11]); b.z = cvt_pk_bf16(khb[12], khb[13]); b.w = cvt_pk_bf16(khb[14], khb[15]);
      u32x4* p = (u32x4*)(KHT1 + (size_t)(h * 128 + k) * MROWS + r0 + tq * 16); p[0] = a; p[1] = b; }
    if (tq == 0) { float* DEC = WSP(float, WS_DEC); DEC[(size_t)(chunk * 2 + 0) * 512 + h * 128 + k] = __expf(bl_f); DEC[(size_t)(chunk * 2 + 1) * 512 + h * 128 + k] = __expf(bl_b); }
    __syncthreads();
}
template <int U> __device__ __forceinline__ void prepa_tokens(const Ctx& C, int r0) {
    const int lane = C.lane, l = C.l; const bool prompt = r0 < MPROMPT;
    const float* ROPE = WSP(float, WS_ROPE);
    u32x4 wq[U], ws0[U], ws1[U]; f32x4 a[U], bb[U], kv[U], sv[U]; float kp[U];
#pragma unroll
    for (int u = 0; u < U; ++u) { const int r = r0 + u; const float* INF = WSP(float, WS_INF) + (size_t)r * LDF; const bf16_t* IN = WSP(bf16_t, WS_IN) + (size_t)r * NIN;
        wq[u] = __builtin_nontemporal_load((const u32x4*)(IN + C_CQ + lane * 8)); a[u] = __builtin_nontemporal_load((const f32x4*)(INF + F_CKV + lane * 8)); bb[u] = __builtin_nontemporal_load((const f32x4*)(INF + F_CKV + lane * 8 + 4));
        ws0[u] = __builtin_nontemporal_load((const u32x4*)(IN + C_SQ + lane * 16)); ws1[u] = __builtin_nontemporal_load((const u32x4*)(IN + C_SQ + lane * 16 + 8)); kv[u] = *(const f32x4*)(INF + F_SK + lane * 4);
        if (prompt) { kp[u] = INF[F_KPE + lane]; sv[u] = __builtin_nontemporal_load((const f32x4*)(INF + F_SV + lane * 4)); } }
    float vq[U][8], vs[U][16], s1[U], s2[U], s3[U], s4[U];
#pragma unroll
    for (int u = 0; u < U; ++u) {
        vq[u][0] = bf_lo(wq[u].x); vq[u][1] = bf_hi(wq[u].x); vq[u][2] = bf_lo(wq[u].y); vq[u][3] = bf_hi(wq[u].y); vq[u][4] = bf_lo(wq[u].z); vq[u][5] = bf_hi(wq[u].z); vq[u][6] = bf_lo(wq[u].w); vq[u][7] = bf_hi(wq[u].w);
        vs[u][0] = bf_lo(ws0[u].x); vs[u][1] = bf_hi(ws0[u].x); vs[u][2] = bf_lo(ws0[u].y); vs[u][3] = bf_hi(ws0[u].y); vs[u][4] = bf_lo(ws0[u].z); vs[u][5] = bf_hi(ws0[u].z); vs[u][6] = bf_lo(ws0[u].w); vs[u][7] = bf_hi(ws0[u].w);
        vs[u][8] = bf_lo(ws1[u].x); vs[u][9] = bf_hi(ws1[u].x); vs[u][10] = bf_lo(ws1[u].y); vs[u][11] = bf_hi(ws1[u].y); vs[u][12] = bf_lo(ws1[u].z); vs[u][13] = bf_hi(ws1[u].z); vs[u][14] = bf_lo(ws1[u].w); vs[u][15] = bf_hi(ws1[u].w);
        s1[u] = 0.f; s3[u] = 0.f;
#pragma unroll
        for (int i = 0; i < 8; ++i) s1[u] += vq[u][i] * vq[u][i];
#pragma unroll
        for (int i = 0; i < 16; ++i) s3[u] += vs[u][i] * vs[u][i];
        s2[u] = (a[u][0] * a[u][0] + a[u][1] * a[u][1]) + (a[u][2] * a[u][2] + a[u][3] * a[u][3]) + (bb[u][0] * bb[u][0] + bb[u][1] * bb[u][1]) + (bb[u][2] * bb[u][2] + bb[u][3] * bb[u][3]);
        s4[u] = (kv[u][0] * kv[u][0] + kv[u][1] * kv[u][1]) + (kv[u][2] * kv[u][2] + kv[u][3] * kv[u][3]); }
#pragma unroll
    for (int o = 1; o < 64; o <<= 1) {
#pragma unroll
        for (int u = 0; u < U; ++u) { s1[u] += __shfl_xor(s1[u], o); s2[u] += __shfl_xor(s2[u], o); if (o < 4) s3[u] += __shfl_xor(s3[u], o); if (o < 16) s4[u] += __shfl_xor(s4[u], o); } }
    const float* gq = LIN(19, 512) + lane * 8; const float* gk = LIN(21, 512) + lane * 8;
    const int sub = lane & 3, s16 = lane & 15; const float* g = LIN(30, 64) + sub * 16; const f32x4 gkn = *(const f32x4*)(LIN(31, 64) + s16 * 4);
#pragma unroll
    for (int u = 0; u < U; ++u) { const int r = r0 + u; const size_t orow = (size_t)(((r >> 8) * 2 + l) * 256 + (r & 255)); const int t = (r - MPROMPT) & 2047, trow = t >> 6, tcol = t & 63;
        const float rs1 = rsqrtf(s1[u] * (1.0f / 512.0f) + EPS), rs2 = rsqrtf(s2[u] * (1.0f / 512.0f) + EPS), rs3 = rsqrtf(s3[u] * (1.0f / 64.0f) + EPS), rs4 = rsqrtf(s4[u] * (1.0f / 64.0f) + EPS);
        {
            u32x4 o; o.x = cvt_pk_bf16(vq[u][0] * rs1 * gq[0], vq[u][1] * rs1 * gq[1]); o.y = cvt_pk_bf16(vq[u][2] * rs1 * gq[2], vq[u][3] * rs1 * gq[3]); o.z = cvt_pk_bf16(vq[u][4] * rs1 * gq[4], vq[u][5] * rs1 * gq[5]); o.w = cvt_pk_bf16(vq[u][6] * rs1 * gq[6], vq[u][7] * rs1 * gq[7]);
            *(u32x4*)(WSP(bf16_t, WS_CQN) + (size_t)r * 512 + lane * 8) = o; }
        {
            const f32x4 ya = a[u] * rs2 * *(const f32x4*)gk, yb = bb[u] * rs2 * *(const f32x4*)(gk + 4);
            if (prompt) { float* op = C.out + O_CKV + orow * 512 + lane * 8; *(f32x4*)op = ya; *(f32x4*)(op + 4) = yb; }
            u32x4 o2; o2.x = cvt_pk_bf16(ya[0], ya[1]); o2.y = cvt_pk_bf16(ya[2], ya[3]); o2.z = cvt_pk_bf16(yb[0], yb[1]); o2.w = cvt_pk_bf16(yb[2], yb[3]);
            *(u32x4*)(WSP(bf16_t, WS_CKVN) + (size_t)r * 512 + lane * 8) = o2; }
        if (prompt) { C.out[O_KPE + orow * 64 + lane] = kp[u]; *(f32x4*)(C.out + O_SV + orow * 256 + lane * 4) = sv[u]; }
        {
#pragma unroll
            for (int i = 0; i < 16; ++i) vs[u][i] = vs[u][i] * rs3 * g[i];
            if (!prompt) { const int pos = sub < 2 ? trow : tcol; const float* cp = ROPE + pos * 16; const float* sp = cp + 1024;
#pragma unroll
                for (int i = 0; i < 16; ++i) { const float oth = __shfl_xor(vs[u][i], 1), c = cp[i], sn = sp[i]; vs[u][i] = (sub & 1) ? (oth * sn + vs[u][i] * c) : (vs[u][i] * c - oth * sn); } }
            u32x4 o0, o1;
            o0.x = cvt_pk_bf16(vs[u][0] * SWA_QSCALE, vs[u][1] * SWA_QSCALE); o0.y = cvt_pk_bf16(vs[u][2] * SWA_QSCALE, vs[u][3] * SWA_QSCALE); o0.z = cvt_pk_bf16(vs[u][4] * SWA_QSCALE, vs[u][5] * SWA_QSCALE); o0.w = cvt_pk_bf16(vs[u][6] * SWA_QSCALE, vs[u][7] * SWA_QSCALE);
            o1.x = cvt_pk_bf16(vs[u][8] * SWA_QSCALE, vs[u][9] * SWA_QSCALE); o1.y = cvt_pk_bf16(vs[u][10] * SWA_QSCALE, vs[u][11] * SWA_QSCALE); o1.z = cvt_pk_bf16(vs[u][12] * SWA_QSCALE, vs[u][13] * SWA_QSCALE); o1.w = cvt_pk_bf16(vs[u][14] * SWA_QSCALE, vs[u][15] * SWA_QSCALE);
            u32x4* op = (u32x4*)(WSP(bf16_t, WS_QS) + (size_t)r * 1024 + lane * 16); op[0] = o0; op[1] = o1; }
        {
            f32x4 kk = kv[u] * rs4 * gkn;
            if (prompt) *(f32x4*)(C.out + O_SK + orow * 256 + lane * 4) = kk;
            else { const int pos = s16 < 8 ? trow : tcol; const f32x4 c = *(const f32x4*)(ROPE + pos * 16 + (lane & 3) * 4), sn = *(const f32x4*)(ROPE + 1024 + pos * 16 + (lane & 3) * 4);
#pragma unroll
                for (int j = 0; j < 4; ++j) { const float oth = __shfl_xor(kk[j], 4); kk[j] = (s16 & 4) ? (oth * sn[j] + kk[j] * c[j]) : (kk[j] * c[j] - oth * sn[j]); } }
            u32x2 o; o.x = cvt_pk_bf16(kk[0], kk[1]); o.y = cvt_pk_bf16(kk[2], kk[3]);
            *(u32x2*)(WSP(bf16_t, WS_KS) + (size_t)r * 256 + lane * 4) = o; } }
}
__device__ __forceinline__ void prepa_ctx_item(const Ctx& C, int j) {
    const int tid = C.tid, l = C.l;
    {   bf16_t* CKVN = WSP(bf16_t, WS_CKVN) + (size_t)(MROWS + j * 64) * 512;
        const int b = (j * 64) >> 8, key0 = (j * 64) & 255; const float* src = C.in[2] + ((size_t)(b * 2 + l) * 256 + key0) * 512;
#pragma unroll
        for (int i = 0; i < 8; ++i) { const int idx = (i * NTHR + tid) * 8; const f32x4 a = *(const f32x4*)(src + idx), bb = *(const f32x4*)(src + idx + 4);
            u32x4 o; o.x = cvt_pk_bf16(a[0], a[1]); o.y = cvt_pk_bf16(a[2], a[3]); o.z = cvt_pk_bf16(bb[0], bb[1]); o.w = cvt_pk_bf16(bb[2], bb[3]); *(u32x4*)(CKVN + idx) = o; }
        bf16_t* KS = WSP(bf16_t, WS_KS) + (size_t)(MROWS + j * 64) * 256; const float* sk = C.in[4] + ((size_t)(b * 2 + l) * 256 + key0) * 256;
#pragma unroll
        for (int i = 0; i < 4; ++i) { const int idx = (i * NTHR + tid) * 8; const f32x4 a = *(const f32x4*)(sk + idx), bb = *(const f32x4*)(sk + idx + 4);
            u32x4 o; o.x = cvt_pk_bf16(a[0], a[1]); o.y = cvt_pk_bf16(a[2], a[3]); o.z = cvt_pk_bf16(bb[0], bb[1]); o.w = cvt_pk_bf16(bb[2], bb[3]); *(u32x4*)(KS + idx) = o; }
        const int c = tid & 255, kh = tid >> 8; const float* sv = C.in[5] + ((size_t)(b * 2 + l) * 256 + key0 + kh * 32) * 256 + c;
        float v[32];
#pragma unroll
        for (int i = 0; i < 32; ++i) v[i] = sv[(size_t)i * 256];
        u32x4* op = (u32x4*)(WSP(bf16_t, WS_VSCT) + ((size_t)b * 256 + c) * 256 + key0 + kh * 32);
#pragma unroll
        for (int g = 0; g < 4; ++g) { u32x4 o; o.x = cvt_pk_bf16(v[g * 8], v[g * 8 + 1]); o.y = cvt_pk_bf16(v[g * 8 + 2], v[g * 8 + 3]); o.z = cvt_pk_bf16(v[g * 8 + 4], v[g * 8 + 5]); o.w = cvt_pk_bf16(v[g * 8 + 6], v[g * 8 + 7]); op[g] = o; }
    }
}
__device__ __forceinline__ void phase_prepa(const Ctx& C, const int mask) {
    constexpr int I_GLA = 512, I_TOK = 256, I_CTX = 8;
    for (int it = C.bid; it < I_GLA + I_TOK + I_CTX; it += C.G) {
        if (it < I_GLA) { if (mask & 1) prepa_gla_item(C, it >> 2, it & 3); continue; }
        if (it < I_GLA + I_TOK) { const int r0 = (it - I_GLA) * 32 + C.wave * 4;
            if (mask & 2) { prepa_tokens<2>(C, r0); prepa_tokens<2>(C, r0 + 2); }
            continue; }
        if (mask & 4) prepa_ctx_item(C, it - I_GLA - I_TOK);
    }
}

__device__ __forceinline__ void prepb_unpack(const u32x4 w, float (&v)[8]) { v[0] = bf_lo(w.x); v[1] = bf_hi(w.x); v[2] = bf_lo(w.y); v[3] = bf_hi(w.y); v[4] = bf_lo(w.z); v[5] = bf_hi(w.z); v[6] = bf_lo(w.w); v[7] = bf_hi(w.w); }
__device__ __forceinline__ u32x4 prepb_pack(const float (&v)[8], float s) { u32x4 o; o.x = cvt_pk_bf16(v[0] * s, v[1] * s); o.y = cvt_pk_bf16(v[2] * s, v[3] * s); o.z = cvt_pk_bf16(v[4] * s, v[5] * s); o.w = cvt_pk_bf16(v[6] * s, v[7] * s); return o; }
__device__ __forceinline__ void phase_prepb(const Ctx& C) {
    const int lane = C.lane, l = C.l, h = lane >> 3, sub = lane & 7; const float* ROPE = WSP(float, WS_ROPE);
    constexpr int NT = MROWS + MKV, U = 2; const int nw = C.G * NWAVES;
    float gq[3][8], gk[3][8];
#pragma unroll
    for (int c = 0; c < 3; ++c)
#pragma unroll
        for (int j = 0; j < 8; ++j) { gq[c][j] = LIN(23, 192)[64 * c + 8 * sub + j]; gk[c][j] = LIN(24, 192)[64 * c + 8 * sub + j]; }
    const bf16_t* QRAW = WSP(bf16_t, WS_QRAW); const bf16_t* KNRAW = WSP(bf16_t, WS_KNRAW); const float* INF = WSP(float, WS_INF);
    for (int t0 = C.bid * NWAVES + C.wave; t0 < NT; t0 += U * nw) {
        float v[U][3][8];
#pragma unroll
        for (int u = 0; u < U; ++u) { const int task = (t0 + u * nw < NT) ? t0 + u * nw : t0; const bool isq = task < MROWS; const int r = isq ? task : task - MROWS;
            if (isq) {
#pragma unroll
                for (int c = 0; c < 3; ++c) prepb_unpack(__builtin_nontemporal_load((const u32x4*)(QRAW + (size_t)r * 1536 + h * 192 + 64 * c + 8 * sub)), v[u][c]); }
            else {
#pragma unroll
                for (int c = 0; c < 2; ++c) prepb_unpack(__builtin_nontemporal_load((const u32x4*)(KNRAW + (size_t)r * 1024 + h * 128 + 64 * c + 8 * sub)), v[u][c]);
                const float* kp = (r < MROWS) ? INF + (size_t)r * LDF + F_KPE + 8 * sub : C.in[3] + ((size_t)(((r - MROWS) >> 8) * 2 + l) * 256 + ((r - MROWS) & 255)) * 64 + 8 * sub;
                const f32x4 a = *(const f32x4*)kp, b = *(const f32x4*)(kp + 4);
                v[u][2][0] = a[0]; v[u][2][1] = a[1]; v[u][2][2] = a[2]; v[u][2][3] = a[3]; v[u][2][4] = b[0]; v[u][2][5] = b[1]; v[u][2][6] = b[2]; v[u][2][7] = b[3]; } }
        float ss[U];
#pragma unroll
        for (int u = 0; u < U; ++u) { ss[u] = 0.f;
#pragma unroll
            for (int c = 0; c < 3; ++c)
#pragma unroll
                for (int j = 0; j < 8; ++j) ss[u] += v[u][c][j] * v[u][c][j]; }
#pragma unroll
        for (int o = 1; o < 8; o <<= 1) {
#pragma unroll
            for (int u = 0; u < U; ++u) ss[u] += __shfl_xor(ss[u], o); }
#pragma unroll
        for (int u = 0; u < U; ++u) { const int task = t0 + u * nw; const bool isq = task < MROWS; const int r = isq ? task : task - MROWS;
            const float rs = rsqrtf(ss[u] * (1.0f / 192.0f) + EPS);
#pragma unroll
            for (int c = 0; c < 3; ++c)
#pragma unroll
                for (int j = 0; j < 8; ++j) v[u][c][j] *= rs * (isq ? gq[c][j] : gk[c][j]);
            const bool rope = (r >= MPROMPT) && (r < MROWS);
            const int t = (r - MPROMPT) & 2047, pos = (sub & 4) ? (t & 63) : (t >> 6);
            const float* cp = ROPE + pos * 16 + 8 * (sub & 1); const f32x4 c0 = *(const f32x4*)cp, c1 = *(const f32x4*)(cp + 4), s0 = *(const f32x4*)(cp + 1024), s1 = *(const f32x4*)(cp + 1028);
            float y[8];
#pragma unroll
            for (int j = 0; j < 8; ++j) { const float x = v[u][2][j], oth = __shfl_xor(x, 2), cc = j < 4 ? c0[j & 3] : c1[j & 3], sn = j < 4 ? s0[j & 3] : s1[j & 3];
                const float rot = (sub & 2) ? (oth * sn + x * cc) : (x * cc - oth * sn); y[j] = rope ? rot : x; }
            if (task < NT) {
                bf16_t* o = (isq ? WSP(bf16_t, WS_QM) : WSP(bf16_t, WS_KM)) + (size_t)r * 1536 + h * 192 + 8 * sub; const float sc = isq ? MLA_QSCALE : 1.0f;
                *(u32x4*)o = prepb_pack(v[u][0], sc); *(u32x4*)(o + 64) = prepb_pack(v[u][1], sc); *(u32x4*)(o + 128) = prepb_pack(y, sc); } }
    }
}

__device__ __forceinline__ void phase_post(const Ctx& C) {
    const int lane = C.lane; const float* g = LIN(29, 256) + lane * 4;
    const float* OF = WSP(float, WS_OG); const float* OB = WSP(float, WS_OG + SZ_OG1); const bf16_t* IN = WSP(bf16_t, WS_IN); bf16_t* OGN = WSP(bf16_t, WS_OGN);
    const f32x4 gv = *(const f32x4*)g; constexpr int U = 4, NT = MROWS * 4; const int nw = C.G * NWAVES;
    for (int t0 = C.bid * NWAVES + C.wave; t0 < NT; t0 += U * nw) {
        f32x4 v[U]; u32x2 gw[U]; float ss[U];
#pragma unroll
        for (int u = 0; u < U; ++u) { const int task = t0 + u * nw < NT ? t0 + u * nw : t0; const int r = task >> 2, h = task & 3; const size_t o = (size_t)r * 1024 + h * 256 + lane * 4;
            v[u] = __builtin_nontemporal_load((const f32x4*)(OF + o)) + __builtin_nontemporal_load((const f32x4*)(OB + o)); gw[u] = __builtin_nontemporal_load((const u32x2*)(IN + (size_t)r * NIN + C_GOUT + h * 256 + lane * 4));
            ss[u] = (v[u][0] * v[u][0] + v[u][1] * v[u][1]) + (v[u][2] * v[u][2] + v[u][3] * v[u][3]); }
#pragma unroll
        for (int o = 1; o < 64; o <<= 1) {
#pragma unroll
            for (int u = 0; u < U; ++u) ss[u] += __shfl_xor(ss[u], o); }
#pragma unroll
        for (int u = 0; u < U; ++u) { const int task = t0 + u * nw; if (task < NT) { const int r = task >> 2, h = task & 3; const size_t o = (size_t)r * 1024 + h * 256 + lane * 4;
            const float rs = rsqrtf(ss[u] * (1.0f / 256.0f) + EPS);
            const f32x4 y = v[u] * rs * gv * (f32x4){siluf_(bf_lo(gw[u].x)), siluf_(bf_hi(gw[u].x)), siluf_(bf_lo(gw[u].y)), siluf_(bf_hi(gw[u].y))};
            u32x2 ow; ow.x = cvt_pk_bf16(y[0], y[1]); ow.y = cvt_pk_bf16(y[2], y[3]); *(u32x2*)(OGN + o) = ow; } }
    }
}

struct AttnSeg { const bf16_t* K; const bf16_t* VT; int kstride, vtstride, nk, kpos0; };
template <int DQK, int DV>
__device__ __forceinline__ void attn_item(ldsp lds, int tid, const bf16_t* Qw, int qstride, int qpos0, const AttnSeg s0, const AttnSeg s1, bool window,
                                          float m_init, float l_init, bf16_t* Ow, int ostride, const int variant = 0  ) {
    constexpr int KST = DQK * 2 + 32  , VST = 160, KT_BYTES = 64 * KST, VT_BYTES = DV * VST, BUF = KT_BYTES + VT_BYTES;
    constexpr int NKK = DQK / 32, NDVB = DV / 16, KPR = DQK / 8, KP = (64 * KPR) / NTHR, VP = (DV * 8) / NTHR;
    static_assert((64 * KPR) % NTHR == 0 && (DV * 8) % NTHR == 0 && 2 * BUF <= 131072, "attn tile geometry");
    const int lane = tid & 63, fr = lane & 15, fq = lane >> 4;
    bf16x8 qf[2][NKK];
#pragma unroll
    for (int rb = 0; rb < 2; ++rb)
#pragma unroll
        for (int kk = 0; kk < NKK; ++kk) qf[rb][kk] = *(const bf16x8*)(Qw + (size_t)(rb * 16 + fr) * qstride + kk * 32 + fq * 8);
    f32x4 o[NDVB][2];
#pragma unroll
    for (int d = 0; d < NDVB; ++d) { o[d][0] = (f32x4){0.f, 0.f, 0.f, 0.f}; o[d][1] = (f32x4){0.f, 0.f, 0.f, 0.f}; }
    float mrun[2] = {m_init, m_init}, lrun[2] = {fq == 0 ? l_init : 0.f, fq == 0 ? l_init : 0.f};
    const int nt0 = s0.nk >> 6, nt = nt0 + (s1.nk >> 6);
    u32x4 kreg[KP], vreg[VP];
#define ATT_LOAD(t) do { const bool _a = (t) < nt0; const bf16_t* _K = _a ? s0.K : s1.K; const bf16_t* _V = _a ? s0.VT : s1.VT; const int _ks = _a ? s0.kstride : s1.kstride, _vs = _a ? s0.vtstride : s1.vtstride; \
        const int _k0 = (_a ? (t) : (t) - nt0) * 64; \
        _Pragma("unroll") for (int _j = 0; _j < KP; ++_j) { const int _pi = tid + NTHR * _j, _row = _pi / KPR, _cp = _pi - _row * KPR; kreg[_j] = *(const u32x4*)(_K + (size_t)(_k0 + _row) * _ks + _cp * 8); } \
        _Pragma("unroll") for (int _j = 0; _j < VP; ++_j) { const int _pi = tid + NTHR * _j, _row = _pi >> 3, _cp = _pi & 7; vreg[_j] = *(const u32x4*)(_V + (size_t)_row * _vs + _k0 + _cp * 8); } } while (0)
#define ATT_STORE(buf) do { ldsp _b = lds + (buf) * BUF; \
        _Pragma("unroll") for (int _j = 0; _j < KP; ++_j) { const int _pi = tid + NTHR * _j, _row = _pi / KPR, _cp = _pi - _row * KPR; *(LAS u32x4*)(_b + ATT_KROW(_row) * KST + _cp * 16) = kreg[_j]; } \
        _Pragma("unroll") for (int _j = 0; _j < VP; ++_j) { const int _pi = tid + NTHR * _j, _row = _pi >> 3, _cp = _pi & 7; *(LAS u32x4*)(_b + KT_BYTES + _row * VST + _cp * 16) = vreg[_j]; } } while (0)
#define ATT_KROW(key) (((((key) >> 5) * 2 + (((key) >> 2) & 1)) << 4) + ((((key) >> 3) & 3) << 2) + ((key) & 3))
    ATT_LOAD(0); ATT_STORE(0);
    __syncthreads();
    for (int t = 0; t < nt; ++t) {
        if (t + 1 < nt && !(variant & 4)) ATT_LOAD(t + 1);
        ldsp kb_ = lds + (t & 1) * BUF; ldsp vb_ = kb_ + KT_BYTES;
        f32x4 s[4][2];
#pragma unroll
        for (int kb = 0; kb < 4; ++kb) { s[kb][0] = (f32x4){0.f, 0.f, 0.f, 0.f}; s[kb][1] = (f32x4){0.f, 0.f, 0.f, 0.f}; }
        __builtin_amdgcn_s_setprio(1);
        {
            constexpr int NG = 4 * NKK, KD = 4; bf16x8 af[KD + 1];
#define ATT_KOFF(g) ((((g) / (2 * NKK)) * 2 + ((g) & 1)) * 16 * KST + (((g) >> 1) % NKK) * 64)
#pragma unroll
            for (int j = 0; j < KD; ++j) af[j] = *(const LAS bf16x8*)(kb_ + ATT_KOFF(j) + fr * KST + fq * 16);
#pragma unroll
            for (int g = 0; g < NG; ++g) {
                if (g + KD < NG) af[(g + KD) % (KD + 1)] = *(const LAS bf16x8*)(kb_ + ATT_KOFF(g + KD) + fr * KST + fq * 16);
                __builtin_amdgcn_sched_barrier(0);
                { const int kb = (g / (2 * NKK)) * 2 + (g & 1), kk = (g >> 1) % NKK;
                  if (variant & 2) { s[kb][0][0] += (float)af[g % (KD + 1)][0]; }
                  else { s[kb][0] = __builtin_amdgcn_mfma_f32_16x16x32_bf16(af[g % (KD + 1)], qf[0][kk], s[kb][0], 0, 0, 0);
                         s[kb][1] = __builtin_amdgcn_mfma_f32_16x16x32_bf16(af[g % (KD + 1)], qf[1][kk], s[kb][1], 0, 0, 0); } }
                __builtin_amdgcn_sched_barrier(0);
            }
#undef ATT_KOFF
        }
        __builtin_amdgcn_s_setprio(0);
#pragma unroll
        for (int hf = 0; hf < 2; ++hf) {
            if (window && t < nt0) {
                const int kp0 = s0.kpos0 + t * 64 + fq * 8;
#pragma unroll
                for (int rb = 0; rb < 2; ++rb) { const int qp = qpos0 + rb * 16 + fr;
#pragma unroll
                    for (int kb = 2 * hf; kb < 2 * hf + 2; ++kb)
#pragma unroll
                        for (int i = 0; i < 4; ++i) { const int dlt = qp - (kp0 + (kb >> 1) * 32 + (kb & 1) * 4 + i); if (dlt > 128 || dlt < -128) s[kb][rb][i] = -1e30f; } }
            }
            bf16x8 pb[2];
#pragma unroll
            for (int rb = 0; rb < 2; ++rb) {
                if (variant & 1) { union { u32x4 u; bf16x8 b; } cv; cv.u.x = cvt_pk_bf16(s[2 * hf][rb][0], s[2 * hf][rb][1]); cv.u.y = cvt_pk_bf16(s[2 * hf][rb][2], s[2 * hf][rb][3]);
                    cv.u.z = cvt_pk_bf16(s[2 * hf + 1][rb][0], s[2 * hf + 1][rb][1]); cv.u.w = cvt_pk_bf16(s[2 * hf + 1][rb][2], s[2 * hf + 1][rb][3]); pb[rb] = cv.b; continue; }
                float mx = fmaxf(fmaxf(fmaxf(s[2 * hf][rb][0], s[2 * hf][rb][1]), fmaxf(s[2 * hf][rb][2], s[2 * hf][rb][3])), fmaxf(fmaxf(s[2 * hf + 1][rb][0], s[2 * hf + 1][rb][1]), fmaxf(s[2 * hf + 1][rb][2], s[2 * hf + 1][rb][3])));
                mx = fmaxf(mx, __shfl_xor(mx, 16)); mx = fmaxf(mx, __shfl_xor(mx, 32));
                const float mn = fmaxf(mrun[rb], mx);
                if (__builtin_amdgcn_ballot_w64(mn > mrun[rb]) != 0ull) {
                    const float alpha = fast_exp2(mrun[rb] - mn); lrun[rb] *= alpha;
#pragma unroll
                    for (int d = 0; d < NDVB; ++d) o[d][rb] = o[d][rb] * alpha; }
                mrun[rb] = mn;
                float ps = 0.f;
#pragma unroll
                for (int kb = 2 * hf; kb < 2 * hf + 2; ++kb)
#pragma unroll
                    for (int i = 0; i < 4; ++i) { const float p = fast_exp2(s[kb][rb][i] - mn); s[kb][rb][i] = p; ps += p; }
                lrun[rb] += ps;
                union { u32x4 u; bf16x8 b; } cv;
                cv.u.x = cvt_pk_bf16(s[2 * hf][rb][0], s[2 * hf][rb][1]); cv.u.y = cvt_pk_bf16(s[2 * hf][rb][2], s[2 * hf][rb][3]);
                cv.u.z = cvt_pk_bf16(s[2 * hf + 1][rb][0], s[2 * hf + 1][rb][1]); cv.u.w = cvt_pk_bf16(s[2 * hf + 1][rb][2], s[2 * hf + 1][rb][3]);
                pb[rb] = cv.b;
            }
            __builtin_amdgcn_sched_barrier(0);
            __builtin_amdgcn_s_setprio(1);
            {
                constexpr int VD = NDVB < 4 ? NDVB : 4; bf16x8 vf[VD + 1];
#define ATT_VREAD(d) (*(const LAS bf16x8*)(vb_ + ((d) * 16 + fr) * VST + (hf * 32 + fq * 8) * 2))
#pragma unroll
                for (int j = 0; j < VD; ++j) vf[j] = ATT_VREAD(j);
#pragma unroll
                for (int d = 0; d < NDVB; ++d) {
                    if (d + VD < NDVB) vf[(d + VD) % (VD + 1)] = ATT_VREAD(d + VD);
                    __builtin_amdgcn_sched_barrier(0);
                    if (variant & 2) { o[d][0][0] += (float)vf[d % (VD + 1)][0]; }
                    else { o[d][0] = __builtin_amdgcn_mfma_f32_16x16x32_bf16(vf[d % (VD + 1)], pb[0], o[d][0], 0, 0, 0);
                           o[d][1] = __builtin_amdgcn_mfma_f32_16x16x32_bf16(vf[d % (VD + 1)], pb[1], o[d][1], 0, 0, 0); }
                    __builtin_amdgcn_sched_barrier(0);
                }
#undef ATT_VREAD
            }
            __builtin_amdgcn_s_setprio(0);
        }
        if (t + 1 < nt && !(variant & 4)) ATT_STORE((t + 1) & 1);
        __syncthreads();
    }
#undef ATT_LOAD
#undef ATT_STORE
#undef ATT_KROW
#pragma unroll
    for (int rb = 0; rb < 2; ++rb) { float lt = lrun[rb]; lt += __shfl_xor(lt, 16); lt += __shfl_xor(lt, 32); const float inv = 1.0f / lt;
        bf16_t* orow = Ow + (size_t)(rb * 16 + fr) * ostride + fq * 4;
#pragma unroll
        for (int d = 0; d < NDVB; ++d) { const f32x4 v = o[d][rb] * inv; u32x2 w; w.x = cvt_pk_bf16(v[0], v[1]); w.y = cvt_pk_bf16(v[2], v[3]); *(u32x2*)(orow + d * 16) = w; } }
}

namespace gla {
constexpr int QST = 288, HST = 160, VST = 144, SST = 288;
constexpr int OFF_Q = 0, OFF_K = 64 * QST, OFF_KH = OFF_K + 64 * QST, OFF_V = OFF_KH + 128 * HST, OFF_S = OFF_V + 64 * VST, SBYTES = 64 * SST;
static_assert(OFF_S + 2 * SBYTES <= 131072, "gla lds");
struct Regs { u32x4 q[2], k[2], h[2], v; float dec; };
__device__ __forceinline__ void load(Regs& R, const bf16_t* QG, const bf16_t* KG, const bf16_t* KHT, const bf16_t* VT, const float* DEC, size_t r0, int h, int tid) {
    R.dec = DEC[(r0 >> 6) * 1024];
#pragma unroll
    for (int j = 0; j < 2; ++j) { const int pi = tid + NTHR * j, row = pi >> 4, cp = pi & 15;
        R.q[j] = *(const u32x4*)(QG + (r0 + row) * 512 + h * 128 + cp * 8); R.k[j] = *(const u32x4*)(KG + (r0 + row) * 512 + h * 128 + cp * 8);
        const int hr = pi >> 3, hc = pi & 7; R.h[j] = *(const u32x4*)(KHT + (size_t)(h * 128 + hr) * MROWS + r0 + hc * 8); }
    { const int row = tid >> 3, cp = tid & 7; R.v = *(const u32x4*)(VT + (size_t)row * MROWS + r0 + cp * 8); }
}
__device__ __forceinline__ void store(const Regs& R, ldsp lds, int tid) {
#pragma unroll
    for (int j = 0; j < 2; ++j) { const int pi = tid + NTHR * j, row = pi >> 4, cp = pi & 15;
        *(LAS u32x4*)(lds + OFF_Q + row * QST + cp * 16) = R.q[j]; *(LAS u32x4*)(lds + OFF_K + row * QST + cp * 16) = R.k[j];
        const int hr = pi >> 3, hc = pi & 7; *(LAS u32x4*)(lds + OFF_KH + hr * HST + hc * 16) = R.h[j]; }
    { const int row = tid >> 3, cp = tid & 7; *(LAS u32x4*)(lds + OFF_V + row * VST + cp * 16) = R.v; }
}
__device__ __forceinline__ void puts(const f32x4 (&st)[4], ldsp lds, int buf, int w, int fr, int fq) {
    ldsp s = lds + OFF_S + buf * SBYTES;
#pragma unroll
    for (int d = 0; d < 4; ++d)
#pragma unroll
        for (int i = 0; i < 4; ++i) *(LAS bf16_t*)(s + (d * 16 + fq * 4 + i) * SST + (w * 16 + fr) * 2) = f2bf(st[d][i]);
}
__device__ __forceinline__ void chunk(f32x4 (&st)[4], ldsp lds, int cur, float dec, int dir, float* og  , int w, int fr, int fq) {
    const int pbk = w >> 1, dh = w & 1;
    bf16x8 qf[4];
#pragma unroll
    for (int kk = 0; kk < 4; ++kk) qf[kk] = *(const LAS bf16x8*)(lds + OFF_Q + (pbk * 16 + fr) * QST + kk * 64 + fq * 16);
    f32x4 at[4];
#pragma unroll
    for (int sb = 0; sb < 4; ++sb) { at[sb] = (f32x4){0.f, 0.f, 0.f, 0.f};
#pragma unroll
        for (int kk = 0; kk < 4; ++kk) { const bf16x8 a = *(const LAS bf16x8*)(lds + OFF_K + (sb * 16 + fr) * QST + kk * 64 + fq * 16); at[sb] = __builtin_amdgcn_mfma_f32_16x16x32_bf16(a, qf[kk], at[sb], 0, 0, 0); }
        const int pt = pbk * 16 + fr;
#pragma unroll
        for (int i = 0; i < 4; ++i) { const int stok = sb * 16 + fq * 4 + i; const bool keep = dir ? (stok >= pt) : (stok <= pt); if (!keep) at[sb][i] = 0.f; } }
    bf16x8 pT[2];
#pragma unroll
    for (int ks = 0; ks < 2; ++ks) { union { u32x4 u; bf16x8 b; } cv;
        cv.u.x = cvt_pk_bf16(at[2 * ks][0], at[2 * ks][1]); cv.u.y = cvt_pk_bf16(at[2 * ks][2], at[2 * ks][3]); cv.u.z = cvt_pk_bf16(at[2 * ks + 1][0], at[2 * ks + 1][1]); cv.u.w = cvt_pk_bf16(at[2 * ks + 1][2], at[2 * ks + 1][3]); pT[ks] = cv.b; }
    const ldsp sb_ = lds + OFF_S + cur * SBYTES;
#pragma unroll
    for (int dd = 0; dd < 2; ++dd) { const int dvb = dh * 2 + dd; f32x4 oacc = (f32x4){0.f, 0.f, 0.f, 0.f};
#pragma unroll
        for (int ks = 0; ks < 2; ++ks) { union { u32x4 u; bf16x8 b; } av;
            const u32x2 lo = *(const LAS u32x2*)(lds + OFF_V + (dvb * 16 + fr) * VST + ((2 * ks) * 16 + fq * 4) * 2), hi = *(const LAS u32x2*)(lds + OFF_V + (dvb * 16 + fr) * VST + ((2 * ks + 1) * 16 + fq * 4) * 2);
            av.u.x = lo.x; av.u.y = lo.y; av.u.z = hi.x; av.u.w = hi.y;
            oacc = __builtin_amdgcn_mfma_f32_16x16x32_bf16(av.b, pT[ks], oacc, 0, 0, 0); }
#pragma unroll
        for (int kk = 0; kk < 4; ++kk) { const bf16x8 a = *(const LAS bf16x8*)(sb_ + (dvb * 16 + fr) * SST + kk * 64 + fq * 16); oacc = __builtin_amdgcn_mfma_f32_16x16x32_bf16(a, qf[kk], oacc, 0, 0, 0); }
        *(f32x4*)(og + (size_t)(pbk * 16 + fr) * 1024 + dvb * 16 + fq * 4) = oacc; }
    bf16x8 hb[2];
#pragma unroll
    for (int ks = 0; ks < 2; ++ks) hb[ks] = *(const LAS bf16x8*)(lds + OFF_KH + (w * 16 + fr) * HST + ks * 64 + fq * 16);
#pragma unroll
    for (int d = 0; d < 4; ++d) { st[d] = st[d] * dec;
#pragma unroll
        for (int ks = 0; ks < 2; ++ks) { const bf16x8 a = *(const LAS bf16x8*)(lds + OFF_V + (d * 16 + fr) * VST + ks * 64 + fq * 16); st[d] = __builtin_amdgcn_mfma_f32_16x16x32_bf16(a, hb[ks], st[d], 0, 0, 0); } }
    puts(st, lds, cur ^ 1, w, fr, fq);
}
}
__device__ __forceinline__ void gla_item(const Ctx& C, const int tid, int row0, int nchunk  , int h, int dir, int dvs, const float* s0, float* sout) {
    ldsp lds = C.lds; const int lane = tid & 63, w = C.wave, fr = lane & 15, fq = lane >> 4;
    const bf16_t* QG = WSP(bf16_t, WS_QG + (size_t)dir * SZ_G1); const bf16_t* KG = WSP(bf16_t, WS_KG + (size_t)dir * SZ_G1); const bf16_t* KHT = WSP(bf16_t, WS_KHT + (size_t)dir * SZ_G1);
    const bf16_t* VT = WSP(bf16_t, WS_VT) + (size_t)(h * 256 + dvs * 64) * MROWS; const float* DEC = WSP(float, WS_DEC) + (size_t)dir * 512 + h * 128 + w * 16 + fr;
    float* OG = WSP(float, WS_OG + (size_t)dir * SZ_OG1) + h * 256 + dvs * 64;
    f32x4 st[4];
#pragma unroll
    for (int d = 0; d < 4; ++d) st[d] = s0 ? *(const f32x4*)(s0 + (size_t)(w * 16 + fr) * 256 + dvs * 64 + d * 16 + fq * 4) : (f32x4){0.f, 0.f, 0.f, 0.f};
    const int c_first = dir ? nchunk - 1 : 0, c_step = dir ? -1 : 1;
#define GLA_ROW(n) ((size_t)row0 + (size_t)(c_first + (n) * c_step) * 64)
    gla::Regs RA, RB;
    gla::load(RA, QG, KG, KHT, VT, DEC, GLA_ROW(0), h, tid); gla::store(RA, lds, tid); float dec_cur = RA.dec;
    gla::load(RA, QG, KG, KHT, VT, DEC, GLA_ROW(1), h, tid);
    if (nchunk > 2) gla::load(RB, QG, KG, KHT, VT, DEC, GLA_ROW(2), h, tid);
    gla::puts(st, lds, 0, w, fr, fq);
    __syncthreads();
    for (int n = 0; n < nchunk; n += 2) {
        gla::chunk(st, lds, 0, dec_cur, dir, OG + GLA_ROW(n) * 1024, w, fr, fq);
        __syncthreads();
        gla::store(RA, lds, tid); dec_cur = RA.dec;
        if (n + 3 < nchunk) gla::load(RA, QG, KG, KHT, VT, DEC, GLA_ROW(n + 3), h, tid);
        __syncthreads();
        gla::chunk(st, lds, 1, dec_cur, dir, OG + GLA_ROW(n + 1) * 1024, w, fr, fq);
        __syncthreads();
        if (n + 2 < nchunk) { gla::store(RB, lds, tid); dec_cur = RB.dec;
            if (n + 4 < nchunk) gla::load(RB, QG, KG, KHT, VT, DEC, GLA_ROW(n + 4), h, tid); }
        __syncthreads();
    }
#undef GLA_ROW
    if (sout) {
#pragma unroll
        for (int d = 0; d < 4; ++d) *(f32x4*)(sout + (size_t)(w * 16 + fr) * 256 + dvs * 64 + d * 16 + fq * 4) = st[d]; }
}

#ifdef MIX_ONLY
#define MIXEN(k) ((k) == MIX_ONLY)
#else
#define MIXEN(k) true
#endif
#ifndef CONV_PER_ITEM
#define CONV_PER_ITEM 2
#endif
__device__ __forceinline__ void phase_mixer(const Ctx& C, const int rep, const int mask, const int variant) {
    const int w = C.wave, l = C.l;
    unsigned* head = WSP(unsigned, WS_CTL) + CW_QUEUE + 64 * (l + 2 * rep);
    volatile LAS int* slot = (volatile LAS int*)(C.lds + LDS_MISC + 16);
    constexpr int N_GS = 64, N_MS = 128, N_SS = 256, N_GP = 512, N_MP = 128, N_SP = 256, NTOT = N_GS + N_MS + N_SS + N_GP + N_MP + N_SP;
    const bf16_t* QM = WSP(bf16_t, WS_QM); const bf16_t* KM = WSP(bf16_t, WS_KM); const bf16_t* VMT = WSP(bf16_t, WS_VMT); bf16_t* OMLA = WSP(bf16_t, WS_OMLA);
    const bf16_t* QS = WSP(bf16_t, WS_QS); const bf16_t* KS = WSP(bf16_t, WS_KS); const bf16_t* VT = WSP(bf16_t, WS_VT); const bf16_t* VSCT = WSP(bf16_t, WS_VSCT); bf16_t* OSWA = WSP(bf16_t, WS_OSWA);
    bool did = false;
    for (;;) {
        if (did && l == 0 && rep == 0) conv_some(C, 1, CONV_PER_ITEM);
        __syncthreads();
        if (C.tid == 0) *slot = (int)__hip_atomic_fetch_add(head, 1u, __ATOMIC_RELAXED, __HIP_MEMORY_SCOPE_AGENT);
        __syncthreads();
        int it = *slot;
        if (it >= NTOT) break;
        did = true;
        int tid = C.tid; asm volatile("" : "+v"(tid));
        if (it < N_MS + N_GS) it = (it < N_MS) ? it + N_GS : it - N_MS;
        if (it < N_GS) {
            const int b = it >> 5, h = (it >> 3) & 3, dir = (it >> 2) & 1, dvs = it & 3;
            if (MIXEN(0) && (mask & 1)) gla_item(C, tid, MPROMPT + b * 2048, 32, h, dir, dvs, C.in[6] + ((((size_t)(b * 2 + l) * 2 + dir) * 4 + h) * 128) * 256, nullptr);
            continue; }
        it -= N_GS;
        if (it < N_MS) {
            const int b = it >> 6, h = (it >> 3) & 7, qt = it & 7; const int rq = MPROMPT + b * 2048 + qt * 256 + w * 32;
            AttnSeg a0{KM + (size_t)(MPROMPT + b * 2048) * 1536 + h * 192, VMT + (size_t)(h * 128) * MKV + MPROMPT + b * 2048, 1536, MKV, 2048, 0};
            AttnSeg a1{KM + (size_t)(MROWS + b * 256) * 1536 + h * 192, VMT + (size_t)(h * 128) * MKV + MROWS + b * 256, 1536, MKV, 256, 0};
            if (MIXEN(1) && (mask & 2)) attn_item<192, 128>(C.lds, tid, QM + (size_t)rq * 1536 + h * 192, 1536, 0, a0, a1, false, -1e30f, 0.f, (rep ? WSP(bf16_t, WS_ACT) : OMLA) + (size_t)rq * 1024 + h * 128, 1024, rep ? variant : 0);
            continue; }
        it -= N_MS;
        if (it < N_SS) {
            const int b = it >> 7, kvh = (it >> 5) & 3, qt = it & 31; const int g = w >> 1, t0 = qt * 64, tq0 = t0 + (w & 1) * 32; const int rq = MPROMPT + b * 2048 + tq0, hd = kvh * 4 + g;
            const int tlo = (qt - 2 < 0 ? 0 : qt - 2), thi = (qt + 2 > 31 ? 31 : qt + 2);
            AttnSeg a0{KS + (size_t)(MPROMPT + b * 2048 + tlo * 64) * 256 + kvh * 64, VT + (size_t)(1024 + kvh * 64) * MROWS + MPROMPT + b * 2048 + tlo * 64, 256, MROWS, (thi - tlo + 1) * 64, tlo * 64};
            AttnSeg a1{KS + (size_t)(MROWS + b * 256) * 256 + kvh * 64, VSCT + ((size_t)b * 256 + kvh * 64) * 256, 256, 256, 256, 0};
            if (MIXEN(2) && (mask & 4)) attn_item<64, 64>(C.lds, tid, QS + (size_t)rq * 1024 + hd * 64, 1024, tq0, a0, a1, true, LIN(32, 16)[hd] * LOG2E, 1.0f, OSWA + (size_t)rq * 1024 + hd * 64, 1024);
            continue; }
        it -= N_SS;
        if (it < N_GP) {
            const int b = it >> 5, h = (it >> 3) & 3, dir = (it >> 2) & 1, dvs = it & 3;
            if (MIXEN(0) && (mask & 1)) gla_item(C, tid, b * 256, 4, h, dir, dvs, nullptr, C.out + O_SG + ((((size_t)(b * 2 + l) * 2 + dir) * 4 + h) * 128) * 256);
            continue; }
        it -= N_GP;
        if (it < N_MP) {
            const int b = it >> 3, h = it & 7; const int rq = b * 256 + w * 32;
            AttnSeg a0{KM + (size_t)(b * 256) * 1536 + h * 192, VMT + (size_t)(h * 128) * MKV + b * 256, 1536, MKV, 256, 0};
            AttnSeg a1{KM, VMT, 1536, MKV, 0, 0};
            if (MIXEN(1) && (mask & 2)) attn_item<192, 128>(C.lds, tid, QM + (size_t)rq * 1536 + h * 192, 1536, 0, a0, a1, false, -1e30f, 0.f, OMLA + (size_t)rq * 1024 + h * 128, 1024);
            continue; }
        it -= N_MP;
        {
            const int b = it >> 4, kvh = (it >> 2) & 3, qt = it & 3; const int g = w >> 1, tq0 = qt * 64 + (w & 1) * 32; const int rq = b * 256 + tq0, hd = kvh * 4 + g;
            AttnSeg a0{KS + (size_t)(b * 256) * 256 + kvh * 64, VT + (size_t)(1024 + kvh * 64) * MROWS + b * 256, 256, MROWS, 256, 0};
            AttnSeg a1{KS, VT, 256, MROWS, 0, 0};
            if (MIXEN(2) && (mask & 4)) attn_item<64, 64>(C.lds, tid, QS + (size_t)rq * 1024 + hd * 64, 1024, tq0, a0, a1, false, LIN(32, 16)[hd] * LOG2E, 1.0f, OSWA + (size_t)rq * 1024 + hd * 64, 1024);
        }
    }
}
#define MK_PER_PHASE 0

#ifndef PREP_REP_MODE
#define PREP_REP_MODE 0
#endif
#ifndef MK_PER_PHASE
#define MK_PER_PHASE 0
#endif
constexpr int NPH = 16;
struct Args { const float* in[37]; float* out; unsigned char* ws; int ph_lo, ph_hi; };

__global__ void __launch_bounds__(NTHR, 2) fwd_kernel(Args a) {
    extern __shared__ __attribute__((aligned(16))) unsigned char lds_raw[];
    Ctx C{a.in, a.out, a.ws, (ldsp)lds_raw, 0, 0, 0, 0, 0, 0};
    C.tid = threadIdx.x; C.lane = C.tid & 63; C.wave = __builtin_amdgcn_readfirstlane(C.tid >> 6); C.G = gridDim.x; C.bid = blockIdx.x; C.l = 0;
    if (C.tid < 16) ((LAS unsigned*)(C.lds + LDS_MISC))[C.tid] = 0u;
    __syncthreads();
    unsigned* ctl = (unsigned*)(a.ws + WS_CTL);
    XcdBarrier bar = xcd_barrier_post(ctl + CW_BAR, (volatile LAS unsigned*)(C.lds + LDS_MISC));
    const int lo = a.ph_lo, hi = a.ph_hi;
#define SITE(L) Ctx L = C; { int t_ = C.tid; asm volatile("" : "+v"(t_)); L.tid = t_; L.lane = t_ & 63; L.wave = __builtin_amdgcn_readfirstlane(t_ >> 6); }
    bf16_t* H = WSP(bf16_t, WS_H); bf16_t* ACT = WSP(bf16_t, WS_ACT); bf16_t* IN = WSP(bf16_t, WS_IN);
    for (int l = 0; l < 2; ++l) {
        C.l = l;
        const float* modl = WSP(float, WS_MOD) + (size_t)l * 3 * NMOD; const size_t wl = (size_t)l * SZ_WLAYER;
#ifdef ONLY_SITE
#define EN(s) ((s) == ONLY_SITE)
#else
#define EN(s) true
#endif
#define PH(k) (lo <= l * NPH + (k) && l * NPH + (k) < hi)
#define SEAM(k) do { if (PH(k) && (l * NPH + (k) + 1 < hi)) xcd_barrier(bar); } while (0)
#ifdef REPEAT_SITE
#define REPBEGIN(s) for (int rep = 0; rep < ((s) == REPEAT_SITE ? 2 : 1); ++rep) { if (rep) xcd_barrier(bar);
#define REPEND }
#else
#define REPBEGIN(s) { const int rep = 0; (void)rep;
#define REPEND }
#endif
        REPBEGIN(0) if (EN(0) && PH(0) && l == 0) { SITE(L); phase_prep(L); };
        REPEND if (l == 0) SEAM(0);
        for (int f = 0; f < 2; ++f) {
            const int kb = f ? 13 : 1;
            REPBEGIN(1) if (EN(1) && PH(kb)) { SITE(L); phase_norm(L, f ? 13 : 11, f ? 2 : 0, l == 0 && f == 0); }
            REPEND SEAM(kb);
            REPBEGIN(2) if (EN(2) && PH(kb + 1)) { pg8::MultiOrder<false> S{H, H, H, WSP(bf16_t, (f ? WS_WGU2 : WS_WGU1) + wl), nullptr, nullptr, MROWS / 256, NGU / 256, 0, 0, 0, 0, 1, C.G, C.bid}; pg8::EpiSwiglu E{ACT, DFF, rep};
                pg8::gemm_phase<pg8::EpiSwiglu, pg8::MultiOrder<false>, true, true>(C.lds, 2048, S, E);
                { const int ci = 2 * l + f; if (rep == 0 && ci < 3) { SITE(L); conv_queue(L, (ci + 1) >> 1, ci == 1 ? 0 : 1, 8 + ci, 1 << 30); } } }
            REPEND SEAM(kb + 1);
            REPBEGIN(3) if (EN(3) && PH(kb + 2)) { pg8::MultiOrder<false> S{ACT, ACT, ACT, WSP(bf16_t, (f ? WS_WD2 : WS_WD1) + wl), nullptr, nullptr, MROWS / 256, 2048 / 256, 0, 0, 0, 0, 1, C.G, C.bid}; const bool first = (l == 0 && f == 0 && rep == 0); pg8::EpiResid E{C.out, first ? a.in[0] : C.out, first ? a.in[1] - (size_t)MPROMPT * D : C.out, modl, f ? 8 : 2, rep ? 0.f : 0.5f};
                pg8::gemm_phase<pg8::EpiResid, pg8::MultiOrder<false>, true, true>(C.lds, DFF, S, E); }
            REPEND SEAM(kb + 2);
            if (f == 1) break;
#if defined(REPEAT_SITE) && REPEAT_SITE == 20
            for (int xb = 0; xb < 10; ++xb) xcd_barrier(bar);
#endif
            REPBEGIN(4) if (EN(4) && PH(4)) { SITE(L); phase_norm(L, 12, 1, false); }
            REPEND SEAM(4);
            REPBEGIN(5) if (EN(5) && PH(5)) {
                pg8::MultiOrder<false> S{H, WSP(bf16_t, WS_WINS + wl), nullptr, WSP(bf16_t, WS_WIN + wl), H, nullptr, MROWS / 256, C_GATE / 256, NSW / 256, MROWS / 256, 0, 0, 2, C.G, C.bid};
                pg8::EpiIn E{IN, WSP(float, WS_INF), WSP(bf16_t, WS_VT), rep};
                pg8::gemm_phase<pg8::EpiIn, pg8::MultiOrder<false>, true, true>(C.lds, 2048, S, E); }
            REPEND SEAM(5);
            REPBEGIN(6) if (EN(6) && PH(6)) { SITE(L); phase_prepa(L, rep ? PREP_REP_MODE : 7); };
            REPEND SEAM(6);
            REPBEGIN(7) if (EN(7) && PH(7)) {
                pg8::MultiOrder<false> S{WSP(bf16_t, WS_CQN), WSP(bf16_t, WS_CKVN), WSP(bf16_t, WS_WUV + wl), WSP(bf16_t, WS_WUQ + wl), WSP(bf16_t, WS_WUK + wl), WSP(bf16_t, WS_CKVN),
                                         MROWS / 256, 1536 / 256, MKV / 256, 1024 / 256, 1024 / 256, MKV / 256, 3, C.G, C.bid};
                pg8::EpiBf E{WSP(bf16_t, WS_QRAW), WSP(bf16_t, WS_KNRAW), WSP(bf16_t, WS_VMT), 1536, 1024, MKV};
                pg8::gemm_phase<pg8::EpiBf, pg8::MultiOrder<false>, true, true>(C.lds, 512, S, E); }
            REPEND SEAM(7);
            REPBEGIN(8) if (EN(8) && PH(8)) { SITE(L); phase_prepb(L); };
            REPEND SEAM(8);
            REPBEGIN(9) if (EN(9) && PH(9)) { SITE(L); phase_mixer(L, rep, rep ? (PREP_REP_MODE & 7) : 7, PREP_REP_MODE >> 4); };
            REPEND SEAM(9);
            REPBEGIN(10) if (EN(10) && PH(10)) { SITE(L); phase_post(L); };
            REPEND SEAM(10);
            REPBEGIN(11) if (EN(11) && PH(11)) {
                { const bf16_t* WG = WSP(bf16_t, WS_WIN + wl) + (size_t)C_GATE * 2048;
                  pg8::MultiOrder<true> S1{H, H, H, WG, WG + (size_t)2048 * 2048, WG + (size_t)4096 * 2048, MROWS / 256, 2048 / 256, MROWS / 256, 2048 / 256, MROWS / 256, 2048 / 256, 3, C.G, C.bid};
                  pg8::EpiGate E1{IN + C_GATE, NIN};
                  pg8::gemm_phase<pg8::EpiGate, pg8::MultiOrder<true>, true, true>(C.lds, 2048, S1, E1); }
                pg8::MultiOrder<true> S{WSP(bf16_t, WS_OMLA), WSP(bf16_t, WS_OGN), WSP(bf16_t, WS_OSWA), WSP(bf16_t, WS_WBR + wl), WSP(bf16_t, WS_WBR + SZ_WBR + wl), WSP(bf16_t, WS_WBR + 2 * SZ_WBR + wl),
                                        MROWS / 256, 2048 / 256, MROWS / 256, 2048 / 256, MROWS / 256, 2048 / 256, 3, C.G, C.bid};
                pg8::EpiBranch E{IN + C_GATE, NIN, ACT};
                pg8::gemm_phase<pg8::EpiBranch, pg8::MultiOrder<true>, true, true>(C.lds, 1024, S, E); }
            REPEND SEAM(11);
            REPBEGIN(12) if (EN(12) && PH(12)) { pg8::MultiOrder<false> S{ACT, ACT, ACT, WSP(bf16_t, WS_WOUT + wl), nullptr, nullptr, MROWS / 256, 2048 / 256, 0, 0, 0, 0, 1, C.G, C.bid}; pg8::EpiResid E{C.out, C.out, C.out, modl, 5, rep ? 0.f : 1.0f};
                pg8::gemm_phase<pg8::EpiResid, pg8::MultiOrder<false>, true, true>(C.lds, 2048, S, E); }
            REPEND SEAM(12);
        }
#undef PH
#undef EN
#undef SEAM
    }
}

extern "C" void kernel_launch(void* const* d_in, const int* in_sizes, int n_in, void* d_out, int out_size, void* d_ws, size_t ws_size, hipStream_t stream) {
    static int grid = 0;
    if (grid == 0) {
        if (n_in != 37 || out_size != (int)O_END || ws_size < WS_END) { fprintf(stderr, "kernel_launch: unexpected sizes n_in %d out %d ws %zu (need %zu)\n", n_in, out_size, ws_size, (size_t)WS_END); grid = -1; return; }
        int dev = 0, cus = 0, per_cu = 0;
        if (hipGetDevice(&dev) != hipSuccess || hipDeviceGetAttribute(&cus, hipDeviceAttributeMultiprocessorCount, dev) != hipSuccess) { grid = -1; return; }
        if (hipFuncSetAttribute((const void*)fwd_kernel, hipFuncAttributeMaxDynamicSharedMemorySize, LDS_BYTES) != hipSuccess) { fprintf(stderr, "kernel_launch: hipFuncSetAttribute failed\n"); grid = -1; return; }
        if (hipOccupancyMaxActiveBlocksPerMultiprocessor(&per_cu, (const void*)fwd_kernel, NTHR, LDS_BYTES) != hipSuccess || per_cu < 1) { fprintf(stderr, "kernel_launch: occupancy query says %d blocks per CU\n", per_cu); }
        (void)hipGetLastError();
        grid = cus;
    }
    if (grid < 0) return;
    if (hipMemsetAsync((char*)d_ws + WS_CTL, 0, SZ_CTL, stream) != hipSuccess) return;
    Args a{};
    for (int i = 0; i < 37; ++i) a.in[i] = (const float*)d_in[i];
    a.out = (float*)d_out; a.ws = (unsigned char*)d_ws;
#if MK_PER_PHASE
    for (int p = 0; p < 2 * NPH; ++p) { a.ph_lo = p; a.ph_hi = p + 1; hipLaunchKernelGGL(fwd_kernel, dim3(grid), dim3(NTHR), LDS_BYTES, stream, a); }
#else
    a.ph_lo = 0; a.ph_hi = 2 * NPH;
    hipLaunchKernelGGL(fwd_kernel, dim3(grid), dim3(NTHR), LDS_BYTES, stream, a);
#endif
    (void)in_sizes;
}
```

```cpp
#include <hip/hip_runtime.h>
#include <cstdio>
#include <cstdint>

#define LAS __attribute__((address_space(3)))
typedef unsigned short bf16_t;
typedef short bf16x8 __attribute__((ext_vector_type(8)));
typedef float f32x4 __attribute__((ext_vector_type(4)));
typedef float f32x2 __attribute__((ext_vector_type(2)));
typedef unsigned u32x4 __attribute__((ext_vector_type(4)));
typedef unsigned u32x2 __attribute__((ext_vector_type(2)));
typedef LAS unsigned char* ldsp;

__device__ __forceinline__ unsigned cvt_pk_bf16(float lo, float hi) { unsigned r; asm volatile("v_cvt_pk_bf16_f32 %0, %1, %2" : "=v"(r) : "v"(lo), "v"(hi)); return r; }
__device__ __forceinline__ float bf_lo(unsigned w) { return __uint_as_float(w << 16); }
__device__ __forceinline__ float bf_hi(unsigned w) { return __uint_as_float(w & 0xffff0000u); }
__device__ __forceinline__ float bf1(bf16_t b) { return __uint_as_float(((unsigned)b) << 16); }
__device__ __forceinline__ bf16_t f2bf(float f) { return (bf16_t)(cvt_pk_bf16(f, 0.f) & 0xffffu); }
__device__ __forceinline__ float fast_rcp(float x) { return __builtin_amdgcn_rcpf(x); }
__device__ __forceinline__ float fast_exp2(float x) { return __builtin_amdgcn_exp2f(x); }
__device__ __forceinline__ float sigmoidf_(float a) { return fast_rcp(1.0f + fast_exp2(-1.44269504f * a)); }
__device__ __forceinline__ float siluf_(float a) { return a * sigmoidf_(a); }
__device__ __forceinline__ float wave_sum(float v) {
#pragma unroll
    for (int o = 1; o < 64; o <<= 1) v += __shfl_xor(v, o);
    return v;
}
namespace pg8 {
#define PG8_LAS __attribute__((address_space(3)))
constexpr int BM = 256, BK = 64, HALF = 128, HTB = HALF * BK * 2  , STAGE_BYTES = 8 * HTB, NXCD = 8, WGM = 8;

__host__ __device__ __forceinline__ int lds_byte(int r, int c) { const int st = (r >> 4) * 2 + (c >> 5), rr = r & 15, cc = c & 31, ob = rr * 64 + cc * 2; return st * 1024 + (ob ^ (((ob >> 9) & 1) << 5)); }
__host__ __device__ __forceinline__ void stage_rc(int b, int& R, int& C) { const int st = b / 1024, sb = b % 1024, swz = sb ^ (((sb >> 9) & 1) << 5); R = (st >> 1) * 16 + swz / 64; C = (st & 1) * 32 + (swz % 64) / 2; }
__host__ __device__ __forceinline__ int perm32(int rho) { const int n = rho >> 4, i = rho & 15; return 8 * (i >> 2) + 4 * n + (i & 3); }

template <class T> __device__ __forceinline__ T sel3(int s, T a, T b, T c) { T r = a; if (s == 1) r = b; if (s == 2) r = c; return r; }
struct Unit { int pm, pn, sub; };
__device__ __forceinline__ void tile_of(int wgid, int nwg, int nM, int nN, int& pm, int& pn) {
    { const int q = nwg / NXCD, r = nwg % NXCD, xcd = wgid % NXCD, off = wgid / NXCD; wgid = (xcd < r ? xcd * (q + 1) : r * (q + 1) + (xcd - r) * q) + off; }
    const int nig = WGM * nN, gid = wgid / nig, fm = gid * WGM, gsz = (nM - fm) < WGM ? (nM - fm) : WGM;
    pm = fm + ((wgid % nig) % gsz); pn = (wgid % nig) / gsz;
}
template <bool TILEMAJOR> struct MultiOrder {
    const bf16_t* A0; const bf16_t* A1; const bf16_t* A2; const bf16_t* B0; const bf16_t* B1; const bf16_t* B2;
    int nM0, nN0, nM1, nN1, nM2, nN2, nsub, G, c;
    __device__ __forceinline__ bool next(int i, Unit& u) const {
        if (TILEMAJOR) { const int j = i / nsub, s = i - j * nsub; const long L = (long)j * G + c; const int nwg = nM0 * nN0; if (L >= nwg) return false;
            u.sub = s; tile_of((int)L, nwg, nM0, nN0, u.pm, u.pn); return true; }
        long L = (long)i * G + c; const int w0 = nM0 * nN0, w1 = nM1 * nN1, w2 = nM2 * nN2;
        if (L < w0) { u.sub = 0; tile_of((int)L, w0, nM0, nN0, u.pm, u.pn); return true; } L -= w0;
        if (L < w1) { u.sub = 1; tile_of((int)L, w1, nM1, nN1, u.pm, u.pn); return true; } L -= w1;
        if (L < w2) { u.sub = 2; tile_of((int)L, w2, nM2, nN2, u.pm, u.pn); return true; }
        return false;
    }
    __device__ __forceinline__ const char* a_tile(const Unit& u, size_t tstep) const { const bf16_t* p = sel3<const bf16_t*>(u.sub, A0, A1, A2); return (const char*)p + (size_t)u.pm * tstep; }
    __device__ __forceinline__ const char* b_tile(const Unit& u, size_t tstep) const { const bf16_t* p = sel3<const bf16_t*>(u.sub, B0, B1, B2); return (const char*)p + (size_t)u.pn * tstep; }
    __device__ __forceinline__ void a_ready(const Unit&) const {}
    __device__ __forceinline__ void done(const Unit&) const {}
};

__device__ __forceinline__ int cond_of_tile(int pm) { return pm < 16 ? 0 : 1 + ((pm - 16) >> 3); }

struct EpiSwiglu {
    static constexpr bool PERM = true, AFTER_DRAIN = false, KEEP_ACC = false;
    bf16_t* O; int ldc; int skip;
    __device__ __forceinline__ void operator()(const f32x4 (&acc)[2][2][4][2], const Unit& u, int wr, int wc, int fr, int fq) const {
        if (skip) { asm volatile("" :: "v"(acc[0][0][0][0]), "v"(acc[1][1][3][1])); return; }
        const int row0 = u.pm * BM + wr * 64 + fr, col0 = u.pn * HALF + wc * 32 + 8 * fq;
#pragma unroll
        for (int ai = 0; ai < 2; ++ai)
#pragma unroll
            for (int m = 0; m < 4; ++m) {
                bf16_t* rowp = O + (size_t)(row0 + ai * HALF + m * 16) * ldc + col0;
                f32x4 r0, r1;
#pragma unroll
                for (int j = 0; j < 4; ++j) { r0[j] = siluf_(acc[ai][0][m][0][j]) * acc[ai][1][m][0][j]; r1[j] = siluf_(acc[ai][0][m][1][j]) * acc[ai][1][m][1][j]; }
                u32x4 w; w.x = cvt_pk_bf16(r0[0], r0[1]); w.y = cvt_pk_bf16(r0[2], r0[3]); w.z = cvt_pk_bf16(r1[0], r1[1]); w.w = cvt_pk_bf16(r1[2], r1[3]);
                *(u32x4*)rowp = w;
            }
    }
};
struct EpiResid {
    static constexpr bool PERM = false, AFTER_DRAIN = false, KEEP_ACC = false;
    float* X; const float* Xin0; const float* Xin1; const float* modl; int gidx; float coef;
    __device__ __forceinline__ void operator()(const f32x4 (&acc)[2][2][4][2], const Unit& u, int wr, int wc, int fr, int fq) const {
        const int row0 = u.pm * BM + wr * 64 + fr, col0 = u.pn * BM + wc * 32 + 4 * fq;
        const float* g = modl + cond_of_tile(u.pm) * 18432 + gidx * 2048 + col0;
        f32x4 gv[2][2];
#pragma unroll
        for (int bj = 0; bj < 2; ++bj)
#pragma unroll
            for (int n = 0; n < 2; ++n) gv[bj][n] = *(const f32x4*)(g + bj * HALF + n * 16) * coef;
        const float* src = (u.pm < 16 ? Xin0 : Xin1);
#pragma unroll
        for (int ai = 0; ai < 2; ++ai)
#pragma unroll
            for (int mp = 0; mp < 2; ++mp) {
                f32x4 xv[2][2][2];
#pragma unroll
                for (int m = 0; m < 2; ++m) { const float* srcp = src + (size_t)(row0 + ai * HALF + (mp * 2 + m) * 16) * 2048 + col0;
#pragma unroll
                    for (int bj = 0; bj < 2; ++bj)
#pragma unroll
                        for (int n = 0; n < 2; ++n) xv[m][bj][n] = *(const f32x4*)(srcp + bj * HALF + n * 16); }
#pragma unroll
                for (int m = 0; m < 2; ++m) { float* rowp = X + (size_t)(row0 + ai * HALF + (mp * 2 + m) * 16) * 2048 + col0;
#pragma unroll
                    for (int bj = 0; bj < 2; ++bj)
#pragma unroll
                        for (int n = 0; n < 2; ++n) *(f32x4*)(rowp + bj * HALF + n * 16) = xv[m][bj][n] + gv[bj][n] * acc[ai][bj][mp * 2 + m][n]; }
            }
    }
};
struct EpiIn {
    static constexpr bool PERM = true, AFTER_DRAIN = false, KEEP_ACC = false;
    bf16_t* IN; float* INF; bf16_t* VT; int skip;
    __device__ __forceinline__ void operator()(const f32x4 (&acc)[2][2][4][2], const Unit& u, int wr, int wc, int fr, int fq) const {
        if (skip) { asm volatile("" :: "v"(acc[0][0][0][0]), "v"(acc[1][1][3][1])); return; }
        const int row0 = u.pm * BM + wr * 64 + fr, cin = wc * 32 + 8 * fq, pn = u.pn;
        if (u.sub == 1) {
#pragma unroll
            for (int ai = 0; ai < 2; ++ai)
#pragma unroll
                for (int m = 0; m < 4; ++m) { bf16_t* rowp = VT + (size_t)(row0 + ai * HALF + m * 16) * 8192 + pn * BM + cin;
#pragma unroll
                    for (int bj = 0; bj < 2; ++bj) { const f32x4 v0 = acc[ai][bj][m][0], v1 = acc[ai][bj][m][1];
                        u32x4 w; w.x = cvt_pk_bf16(v0[0], v0[1]); w.y = cvt_pk_bf16(v0[2], v0[3]); w.z = cvt_pk_bf16(v1[0], v1[1]); w.w = cvt_pk_bf16(v1[2], v1[3]);
                        *(u32x4*)(rowp + bj * HALF) = w; } }
            return; }
        int fbase = -1;
        if (pn == 2) fbase = 0; else if (pn == 3) fbase = 256; else if (pn == 4) fbase = 512; else if (pn == 17) fbase = 768; else if (pn == 18) fbase = 1024;
        if (fbase >= 0) {
#pragma unroll
            for (int ai = 0; ai < 2; ++ai)
#pragma unroll
                for (int m = 0; m < 4; ++m) { float* rowp = INF + (size_t)(row0 + ai * HALF + m * 16) * 1280 + fbase + cin;
#pragma unroll
                    for (int bj = 0; bj < 2; ++bj) { *(f32x4*)(rowp + bj * HALF) = acc[ai][bj][m][0]; *(f32x4*)(rowp + bj * HALF + 4) = acc[ai][bj][m][1]; } }
        } else {
#pragma unroll
            for (int ai = 0; ai < 2; ++ai)
#pragma unroll
                for (int m = 0; m < 4; ++m) { bf16_t* rowp = IN + (size_t)(row0 + ai * HALF + m * 16) * 11008 + pn * BM + cin;
#pragma unroll
                    for (int bj = 0; bj < 2; ++bj) { const f32x4 v0 = acc[ai][bj][m][0], v1 = acc[ai][bj][m][1];
                        u32x4 w; w.x = cvt_pk_bf16(v0[0], v0[1]); w.y = cvt_pk_bf16(v0[2], v0[3]); w.z = cvt_pk_bf16(v1[0], v1[1]); w.w = cvt_pk_bf16(v1[2], v1[3]);
                        *(u32x4*)(rowp + bj * HALF) = w; } }
        }
    }
};
struct EpiBf {
    static constexpr bool PERM = true, AFTER_DRAIN = false, KEEP_ACC = false;
    bf16_t* O0; bf16_t* O1; bf16_t* O2; int ld0, ld1, ld2;
    __device__ __forceinline__ void operator()(const f32x4 (&acc)[2][2][4][2], const Unit& u, int wr, int wc, int fr, int fq) const {
        const int row0 = u.pm * BM + wr * 64 + fr, col0 = u.pn * BM + wc * 32 + 8 * fq;
        bf16_t* O = sel3<bf16_t*>(u.sub, O0, O1, O2); const int ldc = sel3<int>(u.sub, ld0, ld1, ld2);
#pragma unroll
        for (int ai = 0; ai < 2; ++ai)
#pragma unroll
            for (int m = 0; m < 4; ++m) { bf16_t* rowp = O + (size_t)(row0 + ai * HALF + m * 16) * ldc + col0;
#pragma unroll
                for (int bj = 0; bj < 2; ++bj) { const f32x4 v0 = acc[ai][bj][m][0], v1 = acc[ai][bj][m][1];
                    u32x4 w; w.x = cvt_pk_bf16(v0[0], v0[1]); w.y = cvt_pk_bf16(v0[2], v0[3]); w.z = cvt_pk_bf16(v1[0], v1[1]); w.w = cvt_pk_bf16(v1[2], v1[3]);
                    *(u32x4*)(rowp + bj * HALF) = w; } }
    }
};
struct EpiGate {
    static constexpr bool PERM = true, AFTER_DRAIN = false, KEEP_ACC = false;
    bf16_t* G; int ldg;
    __device__ __forceinline__ void operator()(const f32x4 (&acc)[2][2][4][2], const Unit& u, int wr, int wc, int fr, int fq) const {
        const int row0 = u.pm * BM + wr * 64 + fr, col0 = u.sub * 2048 + u.pn * BM + wc * 32 + 8 * fq;
#pragma unroll
        for (int ai = 0; ai < 2; ++ai)
#pragma unroll
            for (int m = 0; m < 4; ++m) { bf16_t* rowp = G + (size_t)(row0 + ai * HALF + m * 16) * ldg + col0;
#pragma unroll
                for (int bj = 0; bj < 2; ++bj) { const f32x4 v0 = acc[ai][bj][m][0], v1 = acc[ai][bj][m][1];
                    u32x4 w; w.x = cvt_pk_bf16(v0[0], v0[1]); w.y = cvt_pk_bf16(v0[2], v0[3]); w.z = cvt_pk_bf16(v1[0], v1[1]); w.w = cvt_pk_bf16(v1[2], v1[3]);
                    *(u32x4*)(rowp + bj * HALF) = w; } }
    }
};
struct EpiBranch {
    static constexpr bool PERM = true, AFTER_DRAIN = false, KEEP_ACC = true;
    const bf16_t* gate0; int ldg; bf16_t* OUT;
    __device__ __forceinline__ float ratio(float a, float b, bool last) const {
        a = fminf(fmaxf(a, -30.f), 30.f); b = fminf(fmaxf(b, -30.f), 30.f);
        const float ia = fast_rcp(1.0f + fast_exp2(-1.44269504f * a)); return last ? ia : ia * (1.0f + fast_exp2(-1.44269504f * b)); }
    __device__ __forceinline__ void operator()(f32x4 (&acc)[2][2][4][2], const Unit& u, int wr, int wc, int fr, int fq) const {
        const int row0 = u.pm * BM + wr * 64 + fr, col0 = u.pn * BM + wc * 32 + 8 * fq; const int s = u.sub; const bool last = s == 2;
        const bf16_t* ga = gate0 + s * 2048; const bf16_t* gb = gate0 + (last ? s : s + 1) * 2048;
#pragma unroll
        for (int ai = 0; ai < 2; ++ai)
#pragma unroll
            for (int m = 0; m < 4; ++m) { const size_t row = (size_t)(row0 + ai * HALF + m * 16);
#pragma unroll
                for (int bj = 0; bj < 2; ++bj) {
                    const u32x4 wa = *(const u32x4*)(ga + row * ldg + col0 + bj * HALF), wb = *(const u32x4*)(gb + row * ldg + col0 + bj * HALF);
                    f32x4 r0, r1;
                    r0[0] = ratio(bf_lo(wa.x), bf_lo(wb.x), last); r0[1] = ratio(bf_hi(wa.x), bf_hi(wb.x), last); r0[2] = ratio(bf_lo(wa.y), bf_lo(wb.y), last); r0[3] = ratio(bf_hi(wa.y), bf_hi(wb.y), last);
                    r1[0] = ratio(bf_lo(wa.z), bf_lo(wb.z), last); r1[1] = ratio(bf_hi(wa.z), bf_hi(wb.z), last); r1[2] = ratio(bf_lo(wa.w), bf_lo(wb.w), last); r1[3] = ratio(bf_hi(wa.w), bf_hi(wb.w), last);
                    const f32x4 v0 = acc[ai][bj][m][0] * r0, v1 = acc[ai][bj][m][1] * r1;
                    acc[ai][bj][m][0] = v0; acc[ai][bj][m][1] = v1;
                    if (last) { u32x4 w; w.x = cvt_pk_bf16(v0[0], v0[1]); w.y = cvt_pk_bf16(v0[2], v0[3]); w.z = cvt_pk_bf16(v1[0], v1[1]); w.w = cvt_pk_bf16(v1[2], v1[3]);
                        *(u32x4*)(OUT + row * 2048 + col0 + bj * HALF) = w; }
                } }
    }
};
template <class Epi, class Sched, bool ALIGN_EPI = false, bool SP2 = false>
__device__ __forceinline__ void gemm_phase(PG8_LAS unsigned char* lds, const int K, const Sched& S, const Epi& E) {
    int tid_ = threadIdx.x; asm volatile("" : "+v"(tid_));
    const int tid = tid_, wid = __builtin_amdgcn_readfirstlane(tid >> 6), lane = tid & 63, wr = wid >> 2, wc = wid & 3, fr = lane & 15, fq = lane >> 4;
    const int nt = K / BK;
    unsigned voffA[2], voffB[2];
#pragma unroll
    for (int i = 0; i < 2; ++i) { int R, C; stage_rc(tid * 16 + i * 8192, R, C); const int Rb = Epi::PERM ? ((R & ~31) + perm32(R & 31)) : R;
        voffA[i] = (unsigned)(R * K + C) * 2u; voffB[i] = (unsigned)(Rb * K + C) * 2u; }
    const size_t kstep = (size_t)(BK * 2);
    const size_t hstep = (size_t)HALF * K * 2;
    const size_t tstep = 2 * hstep;
    const unsigned ldsw = (unsigned)wid * 1024u;
    const int aoff = lds_byte(wr * 64 + fr, fq * 8), boff = lds_byte(wc * 32 + fr, fq * 8);
#define PG8_SA(b, h) (((b) * 2 + (h)) * HTB)
#define PG8_SB(b, h) ((4 + (b) * 2 + (h)) * HTB)
#define PG8_STAGE(bufoff, gbase, voff) do { _Pragma("unroll") for (int _i = 0; _i < 2; ++_i) \
        __builtin_amdgcn_global_load_lds((const unsigned*)((const char*)(gbase) + (voff)[_i]), (PG8_LAS unsigned*)(lds + (bufoff) + ldsw + _i * 8192), 16, 0, 0); } while (0)
#define PG8_LDA(dst, b, h) do { _Pragma("unroll") for (int m = 0; m < 4; ++m) _Pragma("unroll") for (int k = 0; k < 2; ++k) dst[m][k] = *(const PG8_LAS bf16x8*)(lds + PG8_SA(b, h) + aoff + m * 2048 + k * 1024); } while (0)
#define PG8_LDB(dst, b, h) do { _Pragma("unroll") for (int n = 0; n < 2; ++n) _Pragma("unroll") for (int k = 0; k < 2; ++k) dst[n][k] = *(const PG8_LAS bf16x8*)(lds + PG8_SB(b, h) + boff + n * 2048 + k * 1024); } while (0)
#define PG8_MMA(ai, bj, At, Bt) do { __builtin_amdgcn_s_setprio(1); _Pragma("unroll") for (int m = 0; m < 4; ++m) _Pragma("unroll") for (int n = 0; n < 2; ++n) _Pragma("unroll") for (int k = 0; k < 2; ++k) \
        acc[ai][bj][m][n] = __builtin_amdgcn_mfma_f32_16x16x32_bf16(Bt[n][k], At[m][k], acc[ai][bj][m][n], 0, 0, 0); __builtin_amdgcn_s_setprio(0); } while (0)
#define PG8_WAIT_V(n) asm volatile("s_waitcnt vmcnt(" #n ")" ::: "memory")
#define PG8_WAIT_L(n) asm volatile("s_waitcnt lgkmcnt(" #n ")" ::: "memory")
#define PG8_BAR __builtin_amdgcn_s_barrier()
#define PG8_SCHED __builtin_amdgcn_sched_barrier(0)
    Unit cur, nxt; int ui = 0;
    if (!S.next(0, cur)) return;
    f32x4 acc[2][2][4][2];
#pragma unroll
    for (int a = 0; a < 2; ++a)
#pragma unroll
        for (int b = 0; b < 2; ++b)
#pragma unroll
            for (int m = 0; m < 4; ++m)
#pragma unroll
                for (int n = 0; n < 2; ++n) acc[a][b][m][n] = (f32x4){0.f, 0.f, 0.f, 0.f};
    bf16x8 At[4][2], B0[2][2], B1[2][2];
    const char* cA = S.a_tile(cur, tstep); const char* cB = S.b_tile(cur, tstep);
    S.a_ready(cur);
    if constexpr (SP2) {
        PG8_STAGE(PG8_SB(0, 0), cB, voffB); PG8_STAGE(PG8_SB(0, 1), cB + hstep, voffB); PG8_STAGE(PG8_SA(0, 0), cA, voffA); PG8_STAGE(PG8_SA(0, 1), cA + hstep, voffA);
        if (wr == 1) PG8_BAR;
        PG8_WAIT_V(2); PG8_BAR;
        PG8_STAGE(PG8_SB(1, 0), cB + kstep, voffB); PG8_STAGE(PG8_SA(1, 0), cA + kstep, voffA); PG8_STAGE(PG8_SB(1, 1), cB + hstep + kstep, voffB);
        PG8_WAIT_V(6); PG8_BAR;
    } else {
        PG8_STAGE(PG8_SB(0, 0), cB, voffB); PG8_STAGE(PG8_SA(0, 0), cA, voffA); PG8_STAGE(PG8_SB(0, 1), cB + hstep, voffB); PG8_STAGE(PG8_SA(0, 1), cA + hstep, voffA);
        if (wr == 1) PG8_BAR;
        PG8_WAIT_V(4); PG8_BAR;
        PG8_STAGE(PG8_SB(1, 0), cB + kstep, voffB); PG8_STAGE(PG8_SA(1, 0), cA + kstep, voffA); PG8_STAGE(PG8_SB(1, 1), cB + hstep + kstep, voffB);
        PG8_WAIT_V(6); PG8_BAR;
    }
    for (;;) {
        const bool has_next = S.next(ui + 1, nxt);
        const char* nA = has_next ? S.a_tile(nxt, tstep) : cA; const char* nB = has_next ? S.b_tile(nxt, tstep) : cB;
        asm volatile(".p2align 8" ::: );
        for (int t = 0; t < nt; t += 2) {
            const bool last = (t == nt - 2);
            const char* a1 = cA + (size_t)(t + 1) * kstep;
            const char* a2 = last ? nA : cA + (size_t)(t + 2) * kstep; const char* b2 = last ? nB : cB + (size_t)(t + 2) * kstep;
            const char* a3 = a2 + kstep; const char* b3 = b2 + kstep;
            if (last && has_next) S.a_ready(nxt);
            if constexpr (SP2) {
            PG8_LDB(B0, 0, 0); PG8_LDB(B1, 0, 1); PG8_SCHED; PG8_LDA(At, 0, 0); PG8_STAGE(PG8_SA(1, 1), a1 + hstep, voffA);
            PG8_WAIT_V(8); PG8_WAIT_L(0); PG8_BAR; PG8_MMA(0, 0, At, B0); PG8_MMA(0, 1, At, B1); PG8_BAR; PG8_SCHED;
            PG8_LDA(At, 0, 1); PG8_STAGE(PG8_SB(0, 0), b2, voffB); PG8_STAGE(PG8_SB(0, 1), b2 + hstep, voffB); PG8_STAGE(PG8_SA(0, 0), a2, voffA);
            PG8_WAIT_V(8); PG8_WAIT_L(0); PG8_BAR; PG8_MMA(1, 0, At, B0); PG8_MMA(1, 1, At, B1); PG8_BAR; PG8_SCHED;
            PG8_LDB(B0, 1, 0); PG8_LDB(B1, 1, 1); PG8_SCHED; PG8_LDA(At, 1, 0); PG8_STAGE(PG8_SA(0, 1), a2 + hstep, voffA);
            PG8_WAIT_V(8); PG8_WAIT_L(0); PG8_BAR; PG8_MMA(0, 0, At, B0); PG8_MMA(0, 1, At, B1); PG8_BAR; PG8_SCHED;
            PG8_LDA(At, 1, 1); PG8_STAGE(PG8_SB(1, 0), b3, voffB); PG8_STAGE(PG8_SB(1, 1), b3 + hstep, voffB); PG8_STAGE(PG8_SA(1, 0), a3, voffA);
            PG8_WAIT_V(8); PG8_WAIT_L(0); PG8_BAR; PG8_MMA(1, 0, At, B0); PG8_MMA(1, 1, At, B1); PG8_BAR; PG8_SCHED;
            } else {
            PG8_LDB(B0, 0, 0); PG8_SCHED; PG8_LDA(At, 0, 0); PG8_STAGE(PG8_SA(1, 1), a1 + hstep, voffA);
            PG8_WAIT_L(8); PG8_BAR; PG8_WAIT_L(0); PG8_MMA(0, 0, At, B0); PG8_BAR; PG8_SCHED;
            PG8_LDB(B1, 0, 1); PG8_STAGE(PG8_SB(0, 0), b2, voffB);
            PG8_BAR; PG8_WAIT_L(0); PG8_MMA(0, 1, At, B1); PG8_BAR;
            PG8_LDA(At, 0, 1); PG8_STAGE(PG8_SA(0, 0), a2, voffA);
            PG8_BAR; PG8_WAIT_L(0); PG8_MMA(1, 0, At, B0); PG8_BAR; PG8_SCHED;
            PG8_STAGE(PG8_SB(0, 1), b2 + hstep, voffB);
            PG8_WAIT_V(6); PG8_BAR; PG8_MMA(1, 1, At, B1); PG8_BAR;
            PG8_LDB(B0, 1, 0); PG8_SCHED; PG8_LDA(At, 1, 0); PG8_STAGE(PG8_SA(0, 1), a2 + hstep, voffA);
            PG8_WAIT_L(8); PG8_BAR; PG8_WAIT_L(0); PG8_MMA(0, 0, At, B0); PG8_BAR; PG8_SCHED;
            PG8_LDB(B1, 1, 1); PG8_STAGE(PG8_SB(1, 0), b3, voffB);
            PG8_BAR; PG8_WAIT_L(0); PG8_MMA(0, 1, At, B1); PG8_BAR;
            PG8_LDA(At, 1, 1); PG8_STAGE(PG8_SA(1, 0), a3, voffA);
            PG8_BAR; PG8_WAIT_L(0); PG8_MMA(1, 0, At, B0); PG8_BAR; PG8_SCHED;
            PG8_STAGE(PG8_SB(1, 1), b3 + hstep, voffB);
            PG8_WAIT_V(6); PG8_BAR; PG8_MMA(1, 1, At, B1); PG8_BAR;
            }
        }
        if constexpr (ALIGN_EPI) { if (wr == 0) PG8_BAR; }
        if constexpr (!Epi::AFTER_DRAIN) { E(acc, cur, wr, wc, fr, fq); S.done(cur); }
        if (!has_next) break;
        if (!(Epi::KEEP_ACC && nxt.sub != 0)) {
#pragma unroll
        for (int a = 0; a < 2; ++a)
#pragma unroll
            for (int b = 0; b < 2; ++b)
#pragma unroll
                for (int m = 0; m < 4; ++m)
#pragma unroll
                    for (int n = 0; n < 2; ++n) acc[a][b][m][n] = (f32x4){0.f, 0.f, 0.f, 0.f};
        }
        cur = nxt; cA = nA; cB = nB; ++ui;
        if constexpr (ALIGN_EPI) { if (wr == 1) PG8_BAR; }
    }
    PG8_WAIT_V(0);
    if constexpr (!ALIGN_EPI) { if (wr == 0) PG8_BAR; }
    PG8_BAR;
    if constexpr (Epi::AFTER_DRAIN) { E.fused(acc, cur, wr, wc, fr, fq, lds, wid, lane); S.done(cur); }
#undef PG8_SA
#undef PG8_SB
#undef PG8_STAGE
#undef PG8_LDA
#undef PG8_LDB
#undef PG8_MMA
#undef PG8_WAIT_V
#undef PG8_WAIT_L
#undef PG8_BAR
#undef PG8_SCHED
}
}

constexpr int NWAVES = 8, NTHR = 512;
constexpr int D = 2048, MROWS = 8192, MPROMPT = 4096, DFF = 5632, NGU = 11264, NMOD = 18432;
constexpr int NIN = 11008, LDF = 1280, NSW = 1280, MKV = 8704;
constexpr int C_CQ = 0, C_GQ = 1280, C_GK = 1792, C_GOUT = 2304, C_SQ = 3328, C_GATE = 4864;
constexpr int F_CKV = 0, F_KPE = 512, F_GG = 576, F_SK = 768, F_SV = 1024;
constexpr float EPS = 1e-6f, LOG2E = 1.4426950408889634f;
constexpr float MLA_QSCALE = 0.07216878364870322f * LOG2E;
constexpr float SWA_QSCALE = 0.125f * LOG2E;
constexpr float GLA_QSCALE = 0.08838834764831845f;
constexpr size_t O_X = 0, O_CKV = 16777216, O_KPE = 20971520, O_SK = 21495808, O_SV = 23592960, O_SG = 25690112, O_END = 34078720;
constexpr size_t al4k(size_t x) { return (x + 4095) & ~(size_t)4095; }
constexpr size_t WS_CTL = 0, SZ_CTL = 1u << 20;
constexpr size_t WS_MOD = WS_CTL + SZ_CTL;                 constexpr size_t SZ_MOD = al4k((size_t)2 * 3 * NMOD * 4);
constexpr size_t WS_ROPE = WS_MOD + SZ_MOD;                constexpr size_t SZ_ROPE = al4k(2 * 1024 * 4);
constexpr size_t WS_DEC = WS_ROPE + SZ_ROPE;               constexpr size_t SZ_DEC = al4k((size_t)128 * 2 * 512 * 4);
constexpr size_t WS_WGU1 = WS_DEC + SZ_DEC;                constexpr size_t SZ_WGU = (size_t)NGU * D * 2;
constexpr size_t WS_WD1 = WS_WGU1 + SZ_WGU;                constexpr size_t SZ_WD = (size_t)D * DFF * 2;
constexpr size_t WS_WGU2 = WS_WD1 + SZ_WD;
constexpr size_t WS_WD2 = WS_WGU2 + SZ_WGU;
constexpr size_t WS_WIN = WS_WD2 + SZ_WD;                  constexpr size_t SZ_WIN = (size_t)NIN * D * 2;
constexpr size_t WS_WINS = WS_WIN + SZ_WIN;                constexpr size_t SZ_WINS = (size_t)NSW * D * 2;
constexpr size_t WS_WUQ = WS_WINS + SZ_WINS;               constexpr size_t SZ_WUQ = (size_t)1536 * 512 * 2;
constexpr size_t WS_WUK = WS_WUQ + SZ_WUQ;                 constexpr size_t SZ_WUK = (size_t)1024 * 512 * 2;
constexpr size_t WS_WUV = WS_WUK + SZ_WUK;
constexpr size_t WS_WBR = WS_WUV + SZ_WUK;                 constexpr size_t SZ_WBR = (size_t)2048 * 1024 * 2;
constexpr size_t WS_WOUT = WS_WBR + 3 * SZ_WBR;            constexpr size_t SZ_WOUT = (size_t)2048 * 2048 * 2;
constexpr size_t SZ_WLAYER = WS_WOUT + SZ_WOUT - WS_WGU1;
constexpr size_t WS_H = WS_WGU1 + 2 * SZ_WLAYER;                 constexpr size_t SZ_H = (size_t)MROWS * D * 2;
constexpr size_t WS_ACT = WS_H + SZ_H;                     constexpr size_t SZ_ACT = (size_t)MROWS * DFF * 2;
constexpr size_t WS_MF = WS_ACT;                           constexpr size_t SZ_MF = (size_t)MROWS * 2048 * 4;
constexpr size_t WS_QRAW = WS_MF + SZ_MF;                  constexpr size_t SZ_QRAW = (size_t)MROWS * 1536 * 2;
static_assert(SZ_MF + SZ_QRAW <= SZ_ACT, "alias");
constexpr size_t WS_IN = WS_ACT + SZ_ACT;                  constexpr size_t SZ_IN = (size_t)MROWS * NIN * 2;
constexpr size_t WS_INF = WS_IN + SZ_IN;                   constexpr size_t SZ_INF = (size_t)MROWS * LDF * 4;
constexpr size_t WS_VT = WS_INF + SZ_INF;                  constexpr size_t SZ_VT = (size_t)NSW * MROWS * 2;
constexpr size_t WS_CQN = WS_VT + SZ_VT;                   constexpr size_t SZ_CQN = (size_t)MROWS * 512 * 2;
constexpr size_t WS_CKVN = WS_CQN + SZ_CQN;                constexpr size_t SZ_CKVN = (size_t)MKV * 512 * 2;
constexpr size_t WS_KNRAW = WS_CKVN + SZ_CKVN;             constexpr size_t SZ_KNRAW = (size_t)MKV * 1024 * 2;
constexpr size_t WS_QM = WS_KNRAW + SZ_KNRAW;              constexpr size_t SZ_QM = (size_t)MROWS * 1536 * 2;
constexpr size_t WS_KM = WS_QM + SZ_QM;                    constexpr size_t SZ_KM = (size_t)MKV * 1536 * 2;
constexpr size_t WS_VMT = WS_KM + SZ_KM;                   constexpr size_t SZ_VMT = (size_t)1024 * MKV * 2;
constexpr size_t WS_QS = WS_VMT + SZ_VMT;                  constexpr size_t SZ_QS = (size_t)MROWS * 1024 * 2;
constexpr size_t WS_KS = WS_QS + SZ_QS;                    constexpr size_t SZ_KS = (size_t)MKV * 256 * 2;
constexpr size_t WS_VSCT = WS_KS + SZ_KS;                  constexpr size_t SZ_VSCT = (size_t)2 * 256 * 256 * 2;
constexpr size_t WS_QG = WS_VSCT + SZ_VSCT;                constexpr size_t SZ_G1 = (size_t)MROWS * 512 * 2;
constexpr size_t WS_KG = WS_QG + 2 * SZ_G1;
constexpr size_t WS_KHT = WS_KG + 2 * SZ_G1;
constexpr size_t WS_OG = WS_KHT + 2 * SZ_G1;               constexpr size_t SZ_OG1 = (size_t)MROWS * 1024 * 4;
constexpr size_t WS_OMLA = WS_OG + 2 * SZ_OG1;             constexpr size_t SZ_O = (size_t)MROWS * 1024 * 2;
constexpr size_t WS_OGN = WS_OMLA + SZ_O;
constexpr size_t WS_OSWA = WS_OGN + SZ_O;
constexpr size_t WS_END = WS_OSWA + SZ_O;
static_assert(WS_END < (size_t)1150 * 1024 * 1024, "workspace budget");
constexpr int CW_BAR = 4096, CW_QUEUE = 16384, CW_PANEL = 32768;
constexpr int LDS_MISC = 131072, LDS_BYTES = 147456;

#define XB_TMO      128
#define XB_XCNT(j)  (256  + 64 * (j))
#define XB_XSUB(j)  (1280 + 64 * (j))
#define XB_XGEN(j)  (2304 + 64 * (j))
#define XB_TOP      3328
#define XB_TOPGEN   3392
#define XCD_BAR_WORDS 3456
#define XB_SPIN_CAP (1u << 18)
__device__ __forceinline__ unsigned xb_ld(unsigned* p)              { return __hip_atomic_load(p, __ATOMIC_RELAXED, __HIP_MEMORY_SCOPE_AGENT); }
__device__ __forceinline__ unsigned xb_add(unsigned* p, unsigned v) { return __hip_atomic_fetch_add(p, v, __ATOMIC_RELAXED, __HIP_MEMORY_SCOPE_AGENT); }
__device__ __forceinline__ unsigned xb_xcc_id() { return (unsigned)__builtin_amdgcn_s_getreg((3 << 11) | 20) & 0xFu; }
#define XB_SPIN(cond, bar) do { unsigned _sp = 0; while (cond) { __builtin_amdgcn_s_sleep(1); \
    if ((++_sp & 255u) == 0u) { if (xb_ld(&(bar)[XB_TMO])) break; if (_sp > XB_SPIN_CAP) { atomicAdd(&(bar)[XB_TMO], 1u); break; } } } } while (0)
struct XcdBarrier { unsigned* bar; unsigned x; volatile LAS unsigned* st; };
__device__ __forceinline__ XcdBarrier xcd_barrier_post(unsigned* bar, volatile LAS unsigned* st) {
    XcdBarrier b; b.bar = bar; b.x = xb_xcc_id(); b.st = st;
    if (threadIdx.x == 0) (void)xb_add(&bar[XB_XCNT(b.x)], 1u);
    return b;
}
__device__ __forceinline__ void xcd_barrier_complete(unsigned* bar, unsigned x, unsigned& nloc, unsigned& nx) {
    const unsigned G = gridDim.x * gridDim.y * gridDim.z;
    unsigned sum, cnt, mine, sp = 0u;
    for (;;) {
        sum = 0u; cnt = 0u; mine = 0u;
#pragma unroll
        for (unsigned j = 0; j < 16; ++j) { const unsigned c = xb_ld(&bar[XB_XCNT(j)]); sum += c; cnt += (c > 0u) ? 1u : 0u; mine = (j == x) ? c : mine; }
        if (sum == G) break;
        __builtin_amdgcn_s_sleep(1);
        if ((++sp & 255u) == 0u) { if (xb_ld(&bar[XB_TMO])) break; if (sp > XB_SPIN_CAP) { atomicAdd(&bar[XB_TMO], 1u); break; } }
    }
    nloc = mine > 0u ? mine : 1u; nx = cnt > 0u ? cnt : 1u;
}
__device__ __forceinline__ void xcd_barrier(const XcdBarrier& b) {
    asm volatile("s_waitcnt vmcnt(0)" ::: "memory");
    __syncthreads();
    if (threadIdx.x == 0) {
        unsigned* bar = b.bar;
        __builtin_amdgcn_s_waitcnt(0);
        unsigned nloc = b.st[0], nx = b.st[1];
        if (nloc == 0u) { xcd_barrier_complete(bar, b.x, nloc, nx); b.st[0] = nloc; b.st[1] = nx; }
        const unsigned old = xb_add(&bar[XB_XSUB(b.x)], 1u);
        const unsigned gen = old / nloc;
        if (old + 1u == (gen + 1u) * nloc) {
            __builtin_amdgcn_fence(__ATOMIC_RELEASE, "agent");
            asm volatile("s_waitcnt vmcnt(0)" ::: "memory");
            const unsigned og = xb_add(&bar[XB_TOP], 1u);
            const unsigned tg = og / nx;
            if (og + 1u == (tg + 1u) * nx) xb_add(&bar[XB_TOPGEN], 1u);
            else XB_SPIN(xb_ld(&bar[XB_TOPGEN]) == tg, bar);
            __builtin_amdgcn_fence(__ATOMIC_ACQUIRE, "agent");
            xb_add(&bar[XB_XGEN(b.x)], 1u);
            asm volatile("s_waitcnt vmcnt(0)" ::: "memory");
        } else {
            XB_SPIN(xb_ld(&bar[XB_XGEN(b.x)]) == gen, bar);
            __builtin_amdgcn_fence(__ATOMIC_ACQUIRE, "agent");
            asm volatile("s_waitcnt vmcnt(0)" ::: "memory");
        }
    }
    __syncthreads();
}

struct Ctx {
    const float* const* in; float* out; unsigned char* ws; ldsp lds;
    int tid, lane, wave, G, bid, l;
};
#define WSP(T, off) ((T*)(C.ws + (off)))
#define LIN(i, per) (C.in[i] + (size_t)C.l * (per))

template <int KIND> __device__ __forceinline__ int rowmap(int j) {
    if (KIND == 0) return j;
    if (KIND == 1) { const int p = j >> 8, q = j & 255; return q < 128 ? 128 * p + q : DFF + 128 * p + (q - 128); }
    if (KIND == 2) {
        if (j < 1024) return j;
        if (j < 1280) { const int m = j - 1024; return m < 64 ? 1024 + m : (m < 96 ? 4160 + (m - 64) : -1); }
        if (j < 1792) return 1088 + (j - 1280);
        if (j < 2304) return 1600 + (j - 1792);
        if (j < 3328) return 3136 + (j - 2304);
        if (j < 4352) return 4192 + (j - 3328);
        if (j < 4608) return 5216 + (j - 4352);
        if (j < 4864) return 5472 + (j - 4608);
        return 5728 + (j - 4864);
    }
    if (KIND == 3) return j < 1024 ? 2112 + j : 5472 + (j - 1024);
    if (KIND == 4) return (j >> 7) * 256 + (j & 127);
    return (j >> 7) * 256 + 128 + (j & 127);
}
template <int KIND> __device__ __forceinline__ void conv_item(const float* __restrict__ src, bf16_t* __restrict__ dst, int K, int N, int item, int tid) {
    const int nkb = K >> 7, jb = item / nkb, kb = item - jb * nkb, lane = tid & 63, w = tid >> 6;
    const int j = jb * 256 + lane * 4, sc = rowmap<KIND>(j), k0 = kb * 128 + w * 16;
    f32x4 v[16];
    if (sc >= 0) { const float* p = src + (size_t)k0 * N + sc;
#pragma unroll
        for (int i = 0; i < 16; ++i) v[i] = __builtin_nontemporal_load((const f32x4*)(p + (size_t)i * N)); }
    else {
#pragma unroll
        for (int i = 0; i < 16; ++i) v[i] = (f32x4){0.f, 0.f, 0.f, 0.f}; }
#pragma unroll
    for (int jj = 0; jj < 4; ++jj) { bf16_t* o = dst + (size_t)(j + jj) * K + k0;
#pragma unroll
        for (int g = 0; g < 2; ++g) { u32x4 wv; wv.x = cvt_pk_bf16(v[g * 8 + 0][jj], v[g * 8 + 1][jj]); wv.y = cvt_pk_bf16(v[g * 8 + 2][jj], v[g * 8 + 3][jj]); wv.z = cvt_pk_bf16(v[g * 8 + 4][jj], v[g * 8 + 5][jj]); wv.w = cvt_pk_bf16(v[g * 8 + 6][jj], v[g * 8 + 7][jj]);
            *(u32x4*)(o + g * 8) = wv; } }
}
constexpr int I_GU = (NGU / 256) * 16, I_DN = (2048 / 256) * 44, I_IN = (NIN / 256) * 16, I_INS = (NSW / 256) * 16, I_UQ = 6 * 4, I_UK = 4 * 4, I_BR = 8 * 8, I_OUT = 8 * 16;
constexpr int NCONV_A = 2 * I_GU + I_DN, NCONV_B = I_DN + I_IN + I_INS + I_UQ + 2 * I_UK + 3 * I_BR + I_OUT;
#define LINW(i, per) (C.in[i] + (size_t)lw * (per))
#define WSW(off) ((bf16_t*)(C.ws + (off) + (size_t)lw * SZ_WLAYER))
__device__ __forceinline__ void conv_dispatch(const Ctx& C, const int lw, const int win, int r, const int tid) {
    if (win == 0) {
        if (r < I_GU) { conv_item<1>(LINW(14, (size_t)2048 * NGU), WSW(WS_WGU1), 2048, NGU, r, tid); return; } r -= I_GU;
        if (r < I_GU) { conv_item<1>(LINW(16, (size_t)2048 * NGU), WSW(WS_WGU2), 2048, NGU, r, tid); return; } r -= I_GU;
        conv_item<0>(LINW(17, (size_t)DFF * 2048), WSW(WS_WD2), DFF, 2048, r, tid); return;
    }
    if (r < I_DN) { conv_item<0>(LINW(15, (size_t)DFF * 2048), WSW(WS_WD1), DFF, 2048, r, tid); return; } r -= I_DN;
    if (r < I_IN) { conv_item<2>(LINW(18, (size_t)2048 * 11872), WSW(WS_WIN), 2048, 11872, r, tid); return; } r -= I_IN;
    if (r < I_INS) { conv_item<3>(LINW(18, (size_t)2048 * 11872), WSW(WS_WINS), 2048, 11872, r, tid); return; } r -= I_INS;
    if (r < I_UQ) { conv_item<0>(LINW(20, (size_t)512 * 1536), WSW(WS_WUQ), 512, 1536, r, tid); return; } r -= I_UQ;
    if (r < I_UK) { conv_item<4>(LINW(22, (size_t)512 * 2048), WSW(WS_WUK), 512, 2048, r, tid); return; } r -= I_UK;
    if (r < I_UK) { conv_item<5>(LINW(22, (size_t)512 * 2048), WSW(WS_WUV), 512, 2048, r, tid); return; } r -= I_UK;
    if (r < I_BR) { conv_item<0>(LINW(33, (size_t)1024 * 2048), WSW(WS_WBR), 1024, 2048, r, tid); return; } r -= I_BR;
    if (r < I_BR) { conv_item<0>(LINW(34, (size_t)1024 * 2048), WSW(WS_WBR + SZ_WBR), 1024, 2048, r, tid); return; } r -= I_BR;
    if (r < I_BR) { conv_item<0>(LINW(35, (size_t)1024 * 2048), WSW(WS_WBR + 2 * SZ_WBR), 1024, 2048, r, tid); return; } r -= I_BR;
    conv_item<0>(LINW(36, (size_t)2048 * 2048), WSW(WS_WOUT), 2048, 2048, r, tid);
}
__device__ __forceinline__ void conv_queue(const Ctx& C, const int lw, const int win, const int q, const int maxitems) {
    unsigned* head = WSP(unsigned, WS_CTL) + CW_QUEUE + 64 * q; volatile LAS int* slot = (volatile LAS int*)(C.lds + LDS_MISC + 16);
    const int n = win == 0 ? NCONV_A : NCONV_B;
    for (int cnt = 0; cnt < maxitems; ++cnt) {
        __syncthreads();
        if (C.tid == 0) *slot = (int)__hip_atomic_fetch_add(head, 1u, __ATOMIC_RELAXED, __HIP_MEMORY_SCOPE_AGENT);
        __syncthreads();
        const int it = *slot;
        if (it >= n) break;
        int tid = C.tid; asm volatile("" : "+v"(tid));
        conv_dispatch(C, lw, win, it, tid);
    }
}
__device__ __forceinline__ void phase_prep(const Ctx& C) {
    const int tid = C.tid, lane = C.lane, w = C.wave;
    LAS float* sc = (LAS float*)C.lds; LAS float* red = (LAS float*)(C.lds + 24576);
    for (int i = tid; i < 3 * 2048; i += NTHR) { const int c = i >> 11, k = i & 2047; const float v = (c == 0) ? C.in[8][k] : C.in[7][(c - 1) * 2048 + k]; sc[i] = siluf_(v); }
    __syncthreads();
    constexpr int I_ADA = 2 * (NMOD / 64);
    static_assert(I_ADA == 576 && NCONV_A == 1760, "static prologue schedule");
    const bool sched = C.G == 256; const int sb = C.bid, nada = sb < 64 ? 3 : 2, ncv = sb < 64 ? 5 : (sb < 160 ? 8 : 7);
    const int cv0 = sb < 64 ? sb * 5 : (sb < 160 ? 320 + (sb - 64) * 8 : 1088 + (sb - 160) * 7);
    for (int j = 0;; ++j) {
        int it;
        if (sched) { if (j >= nada + ncv) break; it = j < nada ? sb + 256 * j : I_ADA + cv0 + (j - nada); }
        else { it = C.bid + j * C.G; if (it >= I_ADA + NCONV_A) break; }
        if (it < I_ADA) {
            const int la = it / (NMOD / 64), r = it - la * (NMOD / 64);
            const float* Wada = C.in[9] + (size_t)la * 2048 * NMOD; const float* bada = C.in[10] + (size_t)la * NMOD; float* modl = WSP(float, WS_MOD) + (size_t)la * 3 * NMOD;
            const int col = r * 64 + lane; float a0 = 0.f, a1 = 0.f, a2 = 0.f; const float* p = Wada + (size_t)(w * 256) * NMOD + col;
            for (int k = 0; k < 256; k += 32) { float wv[32];
#pragma unroll
                for (int i = 0; i < 32; ++i) wv[i] = __builtin_nontemporal_load(p + (size_t)(k + i) * NMOD);
#pragma unroll
                for (int i = 0; i < 32; ++i) { const int kk = w * 256 + k + i; a0 += sc[kk] * wv[i]; a1 += sc[2048 + kk] * wv[i]; a2 += sc[4096 + kk] * wv[i]; } }
            red[(w * 3 + 0) * 64 + lane] = a0; red[(w * 3 + 1) * 64 + lane] = a1; red[(w * 3 + 2) * 64 + lane] = a2;
            __syncthreads();
            if (w < 3) { float s = bada[col]; for (int ww = 0; ww < 8; ++ww) s += red[(ww * 3 + w) * 64 + lane]; modl[w * NMOD + col] = s; }
            __syncthreads();
            continue; }
        conv_dispatch(C, 0, 0, it - I_ADA, tid);
    }
    if (C.bid == 0) { float* rp = WSP(float, WS_ROPE);
        for (int i = tid; i < 1024; i += NTHR) { const int pos = i >> 4, f = i & 15; const float inv = fast_exp2(-(float)f * (13.287712379549449f / 16.0f));
            float rev = (float)pos * inv * 0.15915494309189535f; rev -= floorf(rev);
            rp[i] = __builtin_amdgcn_cosf(rev); rp[1024 + i] = __builtin_amdgcn_sinf(rev); } }
}

__device__ __forceinline__ void phase_norm(const Ctx& C, int gin, int mi, bool from_input) {
    const float* g = LIN(gin, D); const float* modl = WSP(float, WS_MOD) + (size_t)C.l * 3 * NMOD; bf16_t* H = WSP(bf16_t, WS_H);
    const int lane = C.lane; const float* x0 = from_input ? C.in[0] : C.out; const float* x1 = from_input ? C.in[1] - (size_t)MPROMPT * D : C.out;
    constexpr int U = 4;
    for (int q = C.bid * NWAVES + C.wave; q < MROWS / U; q += C.G * NWAVES) {
        const int r = U * q; const int c = r < MPROMPT ? 0 : 1 + ((r - MPROMPT) >> 11);
        const float* sh = modl + c * NMOD + (3 * mi) * 2048; const float* scl = sh + 2048;
        const f32x4* xr = (const f32x4*)((r < MPROMPT ? x0 : x1) + (size_t)r * D) + lane;
        f32x4 v[U][8]; float ss[U];
#pragma unroll
        for (int u = 0; u < U; ++u)
#pragma unroll
            for (int j = 0; j < 8; ++j) v[u][j] = __builtin_nontemporal_load(xr + u * 512 + 64 * j);
#pragma unroll
        for (int u = 0; u < U; ++u) { ss[u] = 0.f;
#pragma unroll
            for (int j = 0; j < 8; ++j) ss[u] += (v[u][j][0] * v[u][j][0] + v[u][j][1] * v[u][j][1]) + (v[u][j][2] * v[u][j][2] + v[u][j][3] * v[u][j][3]); }
#pragma unroll
        for (int o = 1; o < 64; o <<= 1) {
#pragma unroll
            for (int u = 0; u < U; ++u) ss[u] += __shfl_xor(ss[u], o); }
        float rs[U];
#pragma unroll
        for (int u = 0; u < U; ++u) rs[u] = rsqrtf(ss[u] * (1.0f / D) + EPS);
        u32x2* o = (u32x2*)(H + (size_t)r * D) + lane;
#pragma unroll
        for (int j = 0; j < 8; ++j) { const int col = 4 * lane + 256 * j; const f32x4 gg = *(const f32x4*)(g + col), s1 = *(const f32x4*)(scl + col), s0 = *(const f32x4*)(sh + col);
            f32x4 gm;
#pragma unroll
            for (int e = 0; e < 4; ++e) gm[e] = gg[e] * (1.0f + s1[e]);
#pragma unroll
            for (int u = 0; u < U; ++u) { const f32x4 y = v[u][j] * rs[u] * gm + s0; u32x2 w; w.x = cvt_pk_bf16(y[0], y[1]); w.y = cvt_pk_bf16(y[2], y[3]); o[u * 512 + 64 * j] = w; } }
    }
}

__device__ __forceinline__ float logsig16(float z) { return (fminf(z, 0.f) - __logf(1.0f + __expf(-fabsf(z)))) * (1.0f / 16.0f); }
__device__ __forceinline__ void prepa_gla_item(const Ctx& C, int chunk, int h) {
    const int tid = C.tid, l = C.l, k = tid & 127, tq = tid >> 7, r0 = chunk * 64;
    LAS float* gg = (LAS float*)C.lds; LAS float* tot = (LAS float*)(C.lds + 8192);
    const float* INF = WSP(float, WS_INF); const bf16_t* IN = WSP(bf16_t, WS_IN);
    { const int idx = tid * 4, t = idx >> 5, j = idx & 31; *(LAS f32x4*)(gg + idx) = *(const f32x4*)(INF + (size_t)(r0 + t) * LDF + F_GG + j); }
    __syncthreads();
    const float* wgf = LIN(25, 16 * 512) + h * 128 + k; const float* wgb = LIN(27, 16 * 512) + h * 128 + k;
    float wf[16], wb[16];
#pragma unroll
    for (int j = 0; j < 16; ++j) { wf[j] = wgf[j * 512]; wb[j] = wgb[j * 512]; }
    const float bfv = LIN(26, 512)[h * 128 + k], bbv = LIN(28, 512)[h * 128 + k];
    float cf[16], cb[16];
#pragma unroll
    for (int i = 0; i < 16; ++i) { const LAS float* gr = gg + (tq * 16 + i) * 32; float zf = bfv, zb = bbv;
#pragma unroll
        for (int j = 0; j < 16; ++j) { zf += gr[j] * wf[j]; zb += gr[16 + j] * wb[j]; }
        cf[i] = logsig16(zf); cb[i] = logsig16(zb); }
#pragma unroll
    for (int i = 1; i < 16; ++i) cf[i] += cf[i - 1];
#pragma unroll
    for (int i = 14; i >= 0; --i) cb[i] += cb[i + 1];
    tot[(0 * 4 + tq) * 128 + k] = cf[15]; tot[(1 * 4 + tq) * 128 + k] = cb[0];
    __syncthreads();
    float off_f = 0.f, off_b = 0.f, bl_f = 0.f, bl_b = 0.f;
#pragma unroll
    for (int q = 0; q < 4; ++q) { const float tf = tot[q * 128 + k], tb = tot[(4 + q) * 128 + k]; bl_f += tf; bl_b += tb; if (q < tq) off_f += tf; if (q > tq) off_b += tb; }
    bf16_t* QG0 = WSP(bf16_t, WS_QG); bf16_t* QG1 = WSP(bf16_t, WS_QG + SZ_G1); bf16_t* KG0 = WSP(bf16_t, WS_KG); bf16_t* KG1 = WSP(bf16_t, WS_KG + SZ_G1);
    bf16_t* KHT0 = WSP(bf16_t, WS_KHT); bf16_t* KHT1 = WSP(bf16_t, WS_KHT + SZ_G1);
    float khf[16], khb[16];
#pragma unroll
    for (int i = 0; i < 16; ++i) { const size_t r = (size_t)(r0 + tq * 16 + i);
        const float q = bf1(IN[r * NIN + C_GQ + h * 128 + k]) * GLA_QSCALE, kk = bf1(IN[r * NIN + C_GK + h * 128 + k]);
        const float bf_ = off_f + cf[i], bb_ = off_b + cb[i];
        const size_t o = r * 512 + h * 128 + k;
        QG0[o] = f2bf(q * __expf(bf_)); KG0[o] = f2bf(kk * __expf(-bf_)); khf[i] = kk * __expf(bl_f - bf_);
        QG1[o] = f2bf(q * __expf(bb_)); KG1[o] = f2bf(kk * __expf(-bb_)); khb[i] = kk * __expf(bl_b - bb_); }
    { u32x4 a, b; a.x = cvt_pk_bf16(khf[0], khf[1]); a.y = cvt_pk_bf16(khf[2], khf[3]); a.z = cvt_pk_bf16(khf[4], khf[5]); a.w = cvt_pk_bf16(khf[6], khf[7]);
      b.x = cvt_pk_bf16(khf[8], khf[9]); b.y = cvt_pk_bf16(khf[10], khf[11]); b.z = cvt_pk_bf16(khf[12], khf[13]); b.w = cvt_pk_bf16(khf[14], khf[15]);
      u32x4* p = (u32x4*)(KHT0 + (size_t)(h * 128 + k) * MROWS + r0 + tq * 16); p[0] = a; p[1] = b; }
    { u32x4 a, b; a.x = cvt_pk_bf16(khb[0], khb[1]); a.y = cvt_pk_bf16(khb[2], khb[3]); a.z = cvt_pk_bf16(khb[4], khb[5]); a.w = cvt_pk_bf16(khb[6], khb[7]);
      b.x = cvt_pk_bf16(khb[8], khb[9]); b.y = cvt_pk_bf16(khb[10], khb[11]); b.z = cvt_pk_bf16(khb[12], khb[13]); b.w = cvt_pk_bf16(khb[14], khb[15]);
      u32x4* p = (u32x4*)(KHT1 + (size_t)(h * 128 + k) * MROWS + r0 + tq * 16); p[0] = a; p[1] = b; }
    if (tq == 0) { float* DEC = WSP(float, WS_DEC); DEC[(size_t)(chunk * 2 + 0) * 512 + h * 128 + k] = __expf(bl_f); DEC[(size_t)(chunk * 2 + 1) * 512 + h * 128 + k] = __expf(bl_b); }
    __syncthreads();
}
template <int U> __device__ __forceinline__ void prepa_tokens(const Ctx& C, int r0) {
    const int lane = C.lane, l = C.l; const bool prompt = r0 < MPROMPT;
    const float* ROPE = WSP(float, WS_ROPE);
    u32x4 wq[U], ws0[U], ws1[U]; f32x4 a[U], bb[U], kv[U], sv[U]; float kp[U];
#pragma unroll
    for (int u = 0; u < U; ++u) { const int r = r0 + u; const float* INF = WSP(float, WS_INF) + (size_t)r * LDF; const bf16_t* IN = WSP(bf16_t, WS_IN) + (size_t)r * NIN;
        wq[u] = __builtin_nontemporal_load((const u32x4*)(IN + C_CQ + lane * 8)); a[u] = __builtin_nontemporal_load((const f32x4*)(INF + F_CKV + lane * 8)); bb[u] = __builtin_nontemporal_load((const f32x4*)(INF + F_CKV + lane * 8 + 4));
        ws0[u] = __builtin_nontemporal_load((const u32x4*)(IN + C_SQ + lane * 16)); ws1[u] = __builtin_nontemporal_load((const u32x4*)(IN + C_SQ + lane * 16 + 8)); kv[u] = *(const f32x4*)(INF + F_SK + lane * 4);
        if (prompt) { kp[u] = INF[F_KPE + lane]; sv[u] = __builtin_nontemporal_load((const f32x4*)(INF + F_SV + lane * 4)); } }
    float vq[U][8], vs[U][16], s1[U], s2[U], s3[U], s4[U];
#pragma unroll
    for (int u = 0; u < U; ++u) {
        vq[u][0] = bf_lo(wq[u].x); vq[u][1] = bf_hi(wq[u].x); vq[u][2] = bf_lo(wq[u].y); vq[u][3] = bf_hi(wq[u].y); vq[u][4] = bf_lo(wq[u].z); vq[u][5] = bf_hi(wq[u].z); vq[u][6] = bf_lo(wq[u].w); vq[u][7] = bf_hi(wq[u].w);
        vs[u][0] = bf_lo(ws0[u].x); vs[u][1] = bf_hi(ws0[u].x); vs[u][2] = bf_lo(ws0[u].y); vs[u][3] = bf_hi(ws0[u].y); vs[u][4] = bf_lo(ws0[u].z); vs[u][5] = bf_hi(ws0[u].z); vs[u][6] = bf_lo(ws0[u].w); vs[u][7] = bf_hi(ws0[u].w);
        vs[u][8] = bf_lo(ws1[u].x); vs[u][9] = bf_hi(ws1[u].x); vs[u][10] = bf_lo(ws1[u].y); vs[u][11] = bf_hi(ws1[u].y); vs[u][12] = bf_lo(ws1[u].z); vs[u][13] = bf_hi(ws1[u].z); vs[u][14] = bf_lo(ws1[u].w); vs[u][15] = bf_hi(ws1[u].w);
        s1[u] = 0.f; s3[u] = 0.f;
#pragma unroll
        for (int i = 0; i < 8; ++i) s1[u] += vq[u][i] * vq[u][i];
#pragma unroll
        for (int i = 0; i < 16; ++i) s3[u] += vs[u][i] * vs[u][i];
        s2[u] = (a[u][0] * a[u][0] + a[u][1] * a[u][1]) + (a[u][2] * a[u][2] + a[u][3] * a[u][3]) + (bb[u][0] * bb[u][0] + bb[u][1] * bb[u][1]) + (bb[u][2] * bb[u][2] + bb[u][3] * bb[u][3]);
        s4[u] = (kv[u][0] * kv[u][0] + kv[u][1] * kv[u][1]) + (kv[u][2] * kv[u][2] + kv[u][3] * kv[u][3]); }
#pragma unroll
    for (int o = 1; o < 64; o <<= 1) {
#pragma unroll
        for (int u = 0; u < U; ++u) { s1[u] += __shfl_xor(s1[u], o); s2[u] += __shfl_xor(s2[u], o); if (o < 4) s3[u] += __shfl_xor(s3[u], o); if (o < 16) s4[u] += __shfl_xor(s4[u], o); } }
    const float* gq = LIN(19, 512) + lane * 8; const float* gk = LIN(21, 512) + lane * 8;
    const int sub = lane & 3, s16 = lane & 15; const float* g = LIN(30, 64) + sub * 16; const f32x4 gkn = *(const f32x4*)(LIN(31, 64) + s16 * 4);
#pragma unroll
    for (int u = 0; u < U; ++u) { const int r = r0 + u; const size_t orow = (size_t)(((r >> 8) * 2 + l) * 256 + (r & 255)); const int t = (r - MPROMPT) & 2047, trow = t >> 6, tcol = t & 63;
        const float rs1 = rsqrtf(s1[u] * (1.0f / 512.0f) + EPS), rs2 = rsqrtf(s2[u] * (1.0f / 512.0f) + EPS), rs3 = rsqrtf(s3[u] * (1.0f / 64.0f) + EPS), rs4 = rsqrtf(s4[u] * (1.0f / 64.0f) + EPS);
        {
            u32x4 o; o.x = cvt_pk_bf16(vq[u][0] * rs1 * gq[0], vq[u][1] * rs1 * gq[1]); o.y = cvt_pk_bf16(vq[u][2] * rs1 * gq[2], vq[u][3] * rs1 * gq[3]); o.z = cvt_pk_bf16(vq[u][4] * rs1 * gq[4], vq[u][5] * rs1 * gq[5]); o.w = cvt_pk_bf16(vq[u][6] * rs1 * gq[6], vq[u][7] * rs1 * gq[7]);
            *(u32x4*)(WSP(bf16_t, WS_CQN) + (size_t)r * 512 + lane * 8) = o; }
        {
            const f32x4 ya = a[u] * rs2 * *(const f32x4*)gk, yb = bb[u] * rs2 * *(const f32x4*)(gk + 4);
            if (prompt) { float* op = C.out + O_CKV + orow * 512 + lane * 8; *(f32x4*)op = ya; *(f32x4*)(op + 4) = yb; }
            u32x4 o2; o2.x = cvt_pk_bf16(ya[0], ya[1]); o2.y = cvt_pk_bf16(ya[2], ya[3]); o2.z = cvt_pk_bf16(yb[0], yb[1]); o2.w = cvt_pk_bf16(yb[2], yb[3]);
            *(u32x4*)(WSP(bf16_t, WS_CKVN) + (size_t)r * 512 + lane * 8) = o2; }
        if (prompt) { C.out[O_KPE + orow * 64 + lane] = kp[u]; *(f32x4*)(C.out + O_SV + orow * 256 + lane * 4) = sv[u]; }
        {
#pragma unroll
            for (int i = 0; i < 16; ++i) vs[u][i] = vs[u][i] * rs3 * g[i];
            if (!prompt) { const int pos = sub < 2 ? trow : tcol; const float* cp = ROPE + pos * 16; const float* sp = cp + 1024;
#pragma unroll
                for (int i = 0; i < 16; ++i) { const float oth = __shfl_xor(vs[u][i], 1), c = cp[i], sn = sp[i]; vs[u][i] = (sub & 1) ? (oth * sn + vs[u][i] * c) : (vs[u][i] * c - oth * sn); } }
            u32x4 o0, o1;
            o0.x = cvt_pk_bf16(vs[u][0] * SWA_QSCALE, vs[u][1] * SWA_QSCALE); o0.y = cvt_pk_bf16(vs[u][2] * SWA_QSCALE, vs[u][3] * SWA_QSCALE); o0.z = cvt_pk_bf16(vs[u][4] * SWA_QSCALE, vs[u][5] * SWA_QSCALE); o0.w = cvt_pk_bf16(vs[u][6] * SWA_QSCALE, vs[u][7] * SWA_QSCALE);
            o1.x = cvt_pk_bf16(vs[u][8] * SWA_QSCALE, vs[u][9] * SWA_QSCALE); o1.y = cvt_pk_bf16(vs[u][10] * SWA_QSCALE, vs[u][11] * SWA_QSCALE); o1.z = cvt_pk_bf16(vs[u][12] * SWA_QSCALE, vs[u][13] * SWA_QSCALE); o1.w = cvt_pk_bf16(vs[u][14] * SWA_QSCALE, vs[u][15] * SWA_QSCALE);
            u32x4* op = (u32x4*)(WSP(bf16_t, WS_QS) + (size_t)r * 1024 + lane * 16); op[0] = o0; op[1] = o1; }
        {
            f32x4 kk = kv[u] * rs4 * gkn;
            if (prompt) *(f32x4*)(C.out + O_SK + orow * 256 + lane * 4) = kk;
            else { const int pos = s16 < 8 ? trow : tcol; const f32x4 c = *(const f32x4*)(ROPE + pos * 16 + (lane & 3) * 4), sn = *(const f32x4*)(ROPE + 1024 + pos * 16 + (lane & 3) * 4);
#pragma unroll
                for (int j = 0; j < 4; ++j) { const float oth = __shfl_xor(kk[j], 4); kk[j] = (s16 & 4) ? (oth * sn[j] + kk[j] * c[j]) : (kk[j] * c[j] - oth * sn[j]); } }
            u32x2 o; o.x = cvt_pk_bf16(kk[0], kk[1]); o.y = cvt_pk_bf16(kk[2], kk[3]);
            *(u32x2*)(WSP(bf16_t, WS_KS) + (size_t)r * 256 + lane * 4) = o; } }
}
__device__ __forceinline__ void prepa_ctx_item(const Ctx& C, int j) {
    const int tid = C.tid, l = C.l;
    {   bf16_t* CKVN = WSP(bf16_t, WS_CKVN) + (size_t)(MROWS + j * 64) * 512;
        const int b = (j * 64) >> 8, key0 = (j * 64) & 255; const float* src = C.in[2] + ((size_t)(b * 2 + l) * 256 + key0) * 512;
#pragma unroll
        for (int i = 0; i < 8; ++i) { const int idx = (i * NTHR + tid) * 8; const f32x4 a = *(const f32x4*)(src + idx), bb = *(const f32x4*)(src + idx + 4);
            u32x4 o; o.x = cvt_pk_bf16(a[0], a[1]); o.y = cvt_pk_bf16(a[2], a[3]); o.z = cvt_pk_bf16(bb[0], bb[1]); o.w = cvt_pk_bf16(bb[2], bb[3]); *(u32x4*)(CKVN + idx) = o; }
        bf16_t* KS = WSP(bf16_t, WS_KS) + (size_t)(MROWS + j * 64) * 256; const float* sk = C.in[4] + ((size_t)(b * 2 + l) * 256 + key0) * 256;
#pragma unroll
        for (int i = 0; i < 4; ++i) { const int idx = (i * NTHR + tid) * 8; const f32x4 a = *(const f32x4*)(sk + idx), bb = *(const f32x4*)(sk + idx + 4);
            u32x4 o; o.x = cvt_pk_bf16(a[0], a[1]); o.y = cvt_pk_bf16(a[2], a[3]); o.z = cvt_pk_bf16(bb[0], bb[1]); o.w = cvt_pk_bf16(bb[2], bb[3]); *(u32x4*)(KS + idx) = o; }
        const int c = tid & 255, kh = tid >> 8; const float* sv = C.in[5] + ((size_t)(b * 2 + l) * 256 + key0 + kh * 32) * 256 + c;
        float v[32];
#pragma unroll
        for (int i = 0; i < 32; ++i) v[i] = sv[(size_t)i * 256];
        u32x4* op = (u32x4*)(WSP(bf16_t, WS_VSCT) + ((size_t)b * 256 + c) * 256 + key0 + kh * 32);
#pragma unroll
        for (int g = 0; g < 4; ++g) { u32x4 o; o.x = cvt_pk_bf16(v[g * 8], v[g * 8 + 1]); o.y = cvt_pk_bf16(v[g * 8 + 2], v[g * 8 + 3]); o.z = cvt_pk_bf16(v[g * 8 + 4], v[g * 8 + 5]); o.w = cvt_pk_bf16(v[g * 8 + 6], v[g * 8 + 7]); op[g] = o; }
    }
}
__device__ __forceinline__ void phase_prepa(const Ctx& C, const int mask) {
    constexpr int I_GLA = 512, I_TOK = 256, I_CTX = 8;
    for (int it = C.bid; it < I_GLA + I_TOK + I_CTX; it += C.G) {
        if (it < I_GLA) { if (mask & 1) prepa_gla_item(C, it >> 2, it & 3); continue; }
        if (it < I_GLA + I_TOK) { const int r0 = (it - I_GLA) * 32 + C.wave * 4;
            if (mask & 2) { prepa_tokens<2>(C, r0); prepa_tokens<2>(C, r0 + 2); }
            continue; }
        if (mask & 4) prepa_ctx_item(C, it - I_GLA - I_TOK);
    }
}

__device__ __forceinline__ void prepb_unpack(const u32x4 w, float (&v)[8]) { v[0] = bf_lo(w.x); v[1] = bf_hi(w.x); v[2] = bf_lo(w.y); v[3] = bf_hi(w.y); v[4] = bf_lo(w.z); v[5] = bf_hi(w.z); v[6] = bf_lo(w.w); v[7] = bf_hi(w.w); }
__device__ __forceinline__ u32x4 prepb_pack(const float (&v)[8], float s) { u32x4 o; o.x = cvt_pk_bf16(v[0] * s, v[1] * s); o.y = cvt_pk_bf16(v[2] * s, v[3] * s); o.z = cvt_pk_bf16(v[4] * s, v[5] * s); o.w = cvt_pk_bf16(v[6] * s, v[7] * s); return o; }
__device__ __forceinline__ void phase_prepb(const Ctx& C) {
    const int lane = C.lane, l = C.l, h = lane >> 3, sub = lane & 7; const float* ROPE = WSP(float, WS_ROPE);
    constexpr int NT = MROWS + MKV, U = 2; const int nw = C.G * NWAVES;
    float gq[3][8], gk[3][8];
#pragma unroll
    for (int c = 0; c < 3; ++c)
#pragma unroll
        for (int j = 0; j < 8; ++j) { gq[c][j] = LIN(23, 192)[64 * c + 8 * sub + j]; gk[c][j] = LIN(24, 192)[64 * c + 8 * sub + j]; }
    const bf16_t* QRAW = WSP(bf16_t, WS_QRAW); const bf16_t* KNRAW = WSP(bf16_t, WS_KNRAW); const float* INF = WSP(float, WS_INF);
    for (int t0 = C.bid * NWAVES + C.wave; t0 < NT; t0 += U * nw) {
        float v[U][3][8];
#pragma unroll
        for (int u = 0; u < U; ++u) { const int task = (t0 + u * nw < NT) ? t0 + u * nw : t0; const bool isq = task < MROWS; const int r = isq ? task : task - MROWS;
            if (isq) {
#pragma unroll
                for (int c = 0; c < 3; ++c) prepb_unpack(__builtin_nontemporal_load((const u32x4*)(QRAW + (size_t)r * 1536 + h * 192 + 64 * c + 8 * sub)), v[u][c]); }
            else {
#pragma unroll
                for (int c = 0; c < 2; ++c) prepb_unpack(__builtin_nontemporal_load((const u32x4*)(KNRAW + (size_t)r * 1024 + h * 128 + 64 * c + 8 * sub)), v[u][c]);
                const float* kp = (r < MROWS) ? INF + (size_t)r * LDF + F_KPE + 8 * sub : C.in[3] + ((size_t)(((r - MROWS) >> 8) * 2 + l) * 256 + ((r - MROWS) & 255)) * 64 + 8 * sub;
                const f32x4 a = *(const f32x4*)kp, b = *(const f32x4*)(kp + 4);
                v[u][2][0] = a[0]; v[u][2][1] = a[1]; v[u][2][2] = a[2]; v[u][2][3] = a[3]; v[u][2][4] = b[0]; v[u][2][5] = b[1]; v[u][2][6] = b[2]; v[u][2][7] = b[3]; } }
        float ss[U];
#pragma unroll
        for (int u = 0; u < U; ++u) { ss[u] = 0.f;
#pragma unroll
            for (int c = 0; c < 3; ++c)
#pragma unroll
                for (int j = 0; j < 8; ++j) ss[u] += v[u][c][j] * v[u][c][j]; }
#pragma unroll
        for (int o = 1; o < 8; o <<= 1) {
#pragma unroll
            for (int u = 0; u < U; ++u) ss[u] += __shfl_xor(ss[u], o); }
#pragma unroll
        for (int u = 0; u < U; ++u) { const int task = t0 + u * nw; const bool isq = task < MROWS; const int r = isq ? task : task - MROWS;
            const float rs = rsqrtf(ss[u] * (1.0f / 192.0f) + EPS);
#pragma unroll
            for (int c = 0; c < 3; ++c)
#pragma unroll
                for (int j = 0; j < 8; ++j) v[u][c][j] *= rs * (isq ? gq[c][j] : gk[c][j]);
            const bool rope = (r >= MPROMPT) && (r < MROWS);
            const int t = (r - MPROMPT) & 2047, pos = (sub & 4) ? (t & 63) : (t >> 6);
            const float* cp = ROPE + pos * 16 + 8 * (sub & 1); const f32x4 c0 = *(const f32x4*)cp, c1 = *(const f32x4*)(cp + 4), s0 = *(const f32x4*)(cp + 1024), s1 = *(const f32x4*)(cp + 1028);
            float y[8];
#pragma unroll
            for (int j = 0; j < 8; ++j) { const float x = v[u][2][j], oth = __shfl_xor(x, 2), cc = j < 4 ? c0[j & 3] : c1[j & 3], sn = j < 4 ? s0[j & 3] : s1[j & 3];
                const float rot = (sub & 2) ? (oth * sn + x * cc) : (x * cc - oth * sn); y[j] = rope ? rot : x; }
            if (task < NT) {
                bf16_t* o = (isq ? WSP(bf16_t, WS_QM) : WSP(bf16_t, WS_KM)) + (size_t)r * 1536 + h * 192 + 8 * sub; const float sc = isq ? MLA_QSCALE : 1.0f;
                *(u32x4*)o = prepb_pack(v[u][0], sc); *(u32x4*)(o + 64) = prepb_pack(v[u][1], sc); *(u32x4*)(o + 128) = prepb_pack(y, sc); } }
    }
}

__device__ __forceinline__ void phase_post(const Ctx& C) {
    const int lane = C.lane; const float* g = LIN(29, 256) + lane * 4;
    const float* OF = WSP(float, WS_OG); const float* OB = WSP(float, WS_OG + SZ_OG1); const bf16_t* IN = WSP(bf16_t, WS_IN); bf16_t* OGN = WSP(bf16_t, WS_OGN);
    const f32x4 gv = *(const f32x4*)g; constexpr int U = 4, NT = MROWS * 4; const int nw = C.G * NWAVES;
    for (int t0 = C.bid * NWAVES + C.wave; t0 < NT; t0 += U * nw) {
        f32x4 v[U]; u32x2 gw[U]; float ss[U];
#pragma unroll
        for (int u = 0; u < U; ++u) { const int task = t0 + u * nw < NT ? t0 + u * nw : t0; const int r = task >> 2, h = task & 3; const size_t o = (size_t)r * 1024 + h * 256 + lane * 4;
            v[u] = __builtin_nontemporal_load((const f32x4*)(OF + o)) + __builtin_nontemporal_load((const f32x4*)(OB + o)); gw[u] = __builtin_nontemporal_load((const u32x2*)(IN + (size_t)r * NIN + C_GOUT + h * 256 + lane * 4));
            ss[u] = (v[u][0] * v[u][0] + v[u][1] * v[u][1]) + (v[u][2] * v[u][2] + v[u][3] * v[u][3]); }
#pragma unroll
        for (int o = 1; o < 64; o <<= 1) {
#pragma unroll
            for (int u = 0; u < U; ++u) ss[u] += __shfl_xor(ss[u], o); }
#pragma unroll
        for (int u = 0; u < U; ++u) { const int task = t0 + u * nw; if (task < NT) { const int r = task >> 2, h = task & 3; const size_t o = (size_t)r * 1024 + h * 256 + lane * 4;
            const float rs = rsqrtf(ss[u] * (1.0f / 256.0f) + EPS);
            const f32x4 y = v[u] * rs * gv * (f32x4){siluf_(bf_lo(gw[u].x)), siluf_(bf_hi(gw[u].x)), siluf_(bf_lo(gw[u].y)), siluf_(bf_hi(gw[u].y))};
            u32x2 ow; ow.x = cvt_pk_bf16(y[0], y[1]); ow.y = cvt_pk_bf16(y[2], y[3]); *(u32x2*)(OGN + o) = ow; } }
    }
}

struct AttnSeg { const bf16_t* K; const bf16_t* VT; int kstride, vtstride, nk, kpos0; };
template <int DQK, int DV>
__device__ __forceinline__ void attn_item(ldsp lds, int tid, const bf16_t* Qw, int qstride, int qpos0, const AttnSeg s0, const AttnSeg s1, bool window,
                                          float m_init, float l_init, bf16_t* Ow, int ostride, const int variant = 0  ) {
    constexpr int KST = DQK * 2 + 32  , VST = 160, KT_BYTES = 64 * KST, VT_BYTES = DV * VST, BUF = KT_BYTES + VT_BYTES;
    constexpr int NKK = DQK / 32, NDVB = DV / 16, KPR = DQK / 8, KP = (64 * KPR) / NTHR, VP = (DV * 8) / NTHR;
    static_assert((64 * KPR) % NTHR == 0 && (DV * 8) % NTHR == 0 && 2 * BUF <= 131072, "attn tile geometry");
    const int lane = tid & 63, fr = lane & 15, fq = lane >> 4;
    bf16x8 qf[2][NKK];
#pragma unroll
    for (int rb = 0; rb < 2; ++rb)
#pragma unroll
        for (int kk = 0; kk < NKK; ++kk) qf[rb][kk] = *(const bf16x8*)(Qw + (size_t)(rb * 16 + fr) * qstride + kk * 32 + fq * 8);
    f32x4 o[NDVB][2];
#pragma unroll
    for (int d = 0; d < NDVB; ++d) { o[d][0] = (f32x4){0.f, 0.f, 0.f, 0.f}; o[d][1] = (f32x4){0.f, 0.f, 0.f, 0.f}; }
    float mrun[2] = {m_init, m_init}, lrun[2] = {fq == 0 ? l_init : 0.f, fq == 0 ? l_init : 0.f};
    const int nt0 = s0.nk >> 6, nt = nt0 + (s1.nk >> 6);
    u32x4 kreg[KP], vreg[VP];
#define ATT_LOAD(t) do { const bool _a = (t) < nt0; const bf16_t* _K = _a ? s0.K : s1.K; const bf16_t* _V = _a ? s0.VT : s1.VT; const int _ks = _a ? s0.kstride : s1.kstride, _vs = _a ? s0.vtstride : s1.vtstride; \
        const int _k0 = (_a ? (t) : (t) - nt0) * 64; \
        _Pragma("unroll") for (int _j = 0; _j < KP; ++_j) { const int _pi = tid + NTHR * _j, _row = _pi / KPR, _cp = _pi - _row * KPR; kreg[_j] = *(const u32x4*)(_K + (size_t)(_k0 + _row) * _ks + _cp * 8); } \
        _Pragma("unroll") for (int _j = 0; _j < VP; ++_j) { const int _pi = tid + NTHR * _j, _row = _pi >> 3, _cp = _pi & 7; vreg[_j] = *(const u32x4*)(_V + (size_t)_row * _vs + _k0 + _cp * 8); } } while (0)
#define ATT_STORE(buf) do { ldsp _b = lds + (buf) * BUF; \
        _Pragma("unroll") for (int _j = 0; _j < KP; ++_j) { const int _pi = tid + NTHR * _j, _row = _pi / KPR, _cp = _pi - _row * KPR; *(LAS u32x4*)(_b + ATT_KROW(_row) * KST + _cp * 16) = kreg[_j]; } \
        _Pragma("unroll") for (int _j = 0; _j < VP; ++_j) { const int _pi = tid + NTHR * _j, _row = _pi >> 3, _cp = _pi & 7; *(LAS u32x4*)(_b + KT_BYTES + _row * VST + _cp * 16) = vreg[_j]; } } while (0)
#define ATT_KROW(key) (((((key) >> 5) * 2 + (((key) >> 2) & 1)) << 4) + ((((key) >> 3) & 3) << 2) + ((key) & 3))
    ATT_LOAD(0); ATT_STORE(0);
    __syncthreads();
    for (int t = 0; t < nt; ++t) {
        if (t + 1 < nt && !(variant & 4)) ATT_LOAD(t + 1);
        ldsp kb_ = lds + (t & 1) * BUF; ldsp vb_ = kb_ + KT_BYTES;
        f32x4 s[4][2];
#pragma unroll
        for (int kb = 0; kb < 4; ++kb) { s[kb][0] = (f32x4){0.f, 0.f, 0.f, 0.f}; s[kb][1] = (f32x4){0.f, 0.f, 0.f, 0.f}; }
        __builtin_amdgcn_s_setprio(1);
        {
            constexpr int NG = 4 * NKK, KD = 4; bf16x8 af[KD + 1];
#define ATT_KOFF(g) ((((g) / (2 * NKK)) * 2 + ((g) & 1)) * 16 * KST + (((g) >> 1) % NKK) * 64)
#pragma unroll
            for (int j = 0; j < KD; ++j) af[j] = *(const LAS bf16x8*)(kb_ + ATT_KOFF(j) + fr * KST + fq * 16);
#pragma unroll
            for (int g = 0; g < NG; ++g) {
                if (g + KD < NG) af[(g + KD) % (KD + 1)] = *(const LAS bf16x8*)(kb_ + ATT_KOFF(g + KD) + fr * KST + fq * 16);
                __builtin_amdgcn_sched_barrier(0);
                { const int kb = (g / (2 * NKK)) * 2 + (g & 1), kk = (g >> 1) % NKK;
                  if (variant & 2) { s[kb][0][0] += (float)af[g % (KD + 1)][0]; }
                  else { s[kb][0] = __builtin_amdgcn_mfma_f32_16x16x32_bf16(af[g % (KD + 1)], qf[0][kk], s[kb][0], 0, 0, 0);
                         s[kb][1] = __builtin_amdgcn_mfma_f32_16x16x32_bf16(af[g % (KD + 1)], qf[1][kk], s[kb][1], 0, 0, 0); } }
                __builtin_amdgcn_sched_barrier(0);
            }
#undef ATT_KOFF
        }
        __builtin_amdgcn_s_setprio(0);
#pragma unroll
        for (int hf = 0; hf < 2; ++hf) {
            if (window && t < nt0) {
                const int kp0 = s0.kpos0 + t * 64 + fq * 8;
#pragma unroll
                for (int rb = 0; rb < 2; ++rb) { const int qp = qpos0 + rb * 16 + fr;
#pragma unroll
                    for (int kb = 2 * hf; kb < 2 * hf + 2; ++kb)
#pragma unroll
                        for (int i = 0; i < 4; ++i) { const int dlt = qp - (kp0 + (kb >> 1) * 32 + (kb & 1) * 4 + i); if (dlt > 128 || dlt < -128) s[kb][rb][i] = -1e30f; } }
            }
            bf16x8 pb[2];
#pragma unroll
            for (int rb = 0; rb < 2; ++rb) {
                if (variant & 1) { union { u32x4 u; bf16x8 b; } cv; cv.u.x = cvt_pk_bf16(s[2 * hf][rb][0], s[2 * hf][rb][1]); cv.u.y = cvt_pk_bf16(s[2 * hf][rb][2], s[2 * hf][rb][3]);
                    cv.u.z = cvt_pk_bf16(s[2 * hf + 1][rb][0], s[2 * hf + 1][rb][1]); cv.u.w = cvt_pk_bf16(s[2 * hf + 1][rb][2], s[2 * hf + 1][rb][3]); pb[rb] = cv.b; continue; }
                float mx = fmaxf(fmaxf(fmaxf(s[2 * hf][rb][0], s[2 * hf][rb][1]), fmaxf(s[2 * hf][rb][2], s[2 * hf][rb][3])), fmaxf(fmaxf(s[2 * hf + 1][rb][0], s[2 * hf + 1][rb][1]), fmaxf(s[2 * hf + 1][rb][2], s[2 * hf + 1][rb][3])));
                mx = fmaxf(mx, __shfl_xor(mx, 16)); mx = fmaxf(mx, __shfl_xor(mx, 32));
                const float mn = fmaxf(mrun[rb], mx);
                if (__builtin_amdgcn_ballot_w64(mn > mrun[rb]) != 0ull) {
                    const float alpha = fast_exp2(mrun[rb] - mn); lrun[rb] *= alpha;
#pragma unroll
                    for (int d = 0; d < NDVB; ++d) o[d][rb] = o[d][rb] * alpha; }
                mrun[rb] = mn;
                float ps = 0.f;
#pragma unroll
                for (int kb = 2 * hf; kb < 2 * hf + 2; ++kb)
#pragma unroll
                    for (int i = 0; i < 4; ++i) { const float p = fast_exp2(s[kb][rb][i] - mn); s[kb][rb][i] = p; ps += p; }
                lrun[rb] += ps;
                union { u32x4 u; bf16x8 b; } cv;
                cv.u.x = cvt_pk_bf16(s[2 * hf][rb][0], s[2 * hf][rb][1]); cv.u.y = cvt_pk_bf16(s[2 * hf][rb][2], s[2 * hf][rb][3]);
                cv.u.z = cvt_pk_bf16(s[2 * hf + 1][rb][0], s[2 * hf + 1][rb][1]); cv.u.w = cvt_pk_bf16(s[2 * hf + 1][rb][2], s[2 * hf + 1][rb][3]);
                pb[rb] = cv.b;
            }
            __builtin_amdgcn_sched_barrier(0);
            __builtin_amdgcn_s_setprio(1);
            {
                constexpr int VD = NDVB < 4 ? NDVB : 4; bf16x8 vf[VD + 1];
#define ATT_VREAD(d) (*(const LAS bf16x8*)(vb_ + ((d) * 16 + fr) * VST + (hf * 32 + fq * 8) * 2))
#pragma unroll
                for (int j = 0; j < VD; ++j) vf[j] = ATT_VREAD(j);
#pragma unroll
                for (int d = 0; d < NDVB; ++d) {
                    if (d + VD < NDVB) vf[(d + VD) % (VD + 1)] = ATT_VREAD(d + VD);
                    __builtin_amdgcn_sched_barrier(0);
                    if (variant & 2) { o[d][0][0] += (float)vf[d % (VD + 1)][0]; }
                    else { o[d][0] = __builtin_amdgcn_mfma_f32_16x16x32_bf16(vf[d % (VD + 1)], pb[0], o[d][0], 0, 0, 0);
                           o[d][1] = __builtin_amdgcn_mfma_f32_16x16x32_bf16(vf[d % (VD + 1)], pb[1], o[d][1], 0, 0, 0); }
                    __builtin_amdgcn_sched_barrier(0);
                }
#undef ATT_VREAD
            }
            __builtin_amdgcn_s_setprio(0);
        }
        if (t + 1 < nt && !(variant & 4)) ATT_STORE((t + 1) & 1);
        __syncthreads();
    }
#undef ATT_LOAD
#undef ATT_STORE
#undef ATT_KROW
#pragma unroll
    for (int rb = 0; rb < 2; ++rb) { float lt = lrun[rb]; lt += __shfl_xor(lt, 16); lt += __shfl_xor(lt, 32); const float inv = 1.0f / lt;
        bf16_t* orow = Ow + (size_t)(rb * 16 + fr) * ostride + fq * 4;
#pragma unroll
        for (int d = 0; d < NDVB; ++d) { const f32x4 v = o[d][rb] * inv; u32x2 w; w.x = cvt_pk_bf16(v[0], v[1]); w.y = cvt_pk_bf16(v[2], v[3]); *(u32x2*)(orow + d * 16) = w; } }
}

namespace gla {
constexpr int QST = 288, HST = 160, VST = 144, SST = 288;
constexpr int OFF_Q = 0, OFF_K = 64 * QST, OFF_KH = OFF_K + 64 * QST, OFF_V = OFF_KH + 128 * HST, OFF_S = OFF_V + 64 * VST, SBYTES = 64 * SST;
static_assert(OFF_S + 2 * SBYTES <= 131072, "gla lds");
struct Regs { u32x4 q[2], k[2], h[2], v; float dec; };
__device__ __forceinline__ void load(Regs& R, const bf16_t* QG, const bf16_t* KG, const bf16_t* KHT, const bf16_t* VT, const float* DEC, size_t r0, int h, int tid) {
    R.dec = DEC[(r0 >> 6) * 1024];
#pragma unroll
    for (int j = 0; j < 2; ++j) { const int pi = tid + NTHR * j, row = pi >> 4, cp = pi & 15;
        R.q[j] = *(const u32x4*)(QG + (r0 + row) * 512 + h * 128 + cp * 8); R.k[j] = *(const u32x4*)(KG + (r0 + row) * 512 + h * 128 + cp * 8);
        const int hr = pi >> 3, hc = pi & 7; R.h[j] = *(const u32x4*)(KHT + (size_t)(h * 128 + hr) * MROWS + r0 + hc * 8); }
    { const int row = tid >> 3, cp = tid & 7; R.v = *(const u32x4*)(VT + (size_t)row * MROWS + r0 + cp * 8); }
}
__device__ __forceinline__ void store(const Regs& R, ldsp lds, int tid) {
#pragma unroll
    for (int j = 0; j < 2; ++j) { const int pi = tid + NTHR * j, row = pi >> 4, cp = pi & 15;
        *(LAS u32x4*)(lds + OFF_Q + row * QST + cp * 16) = R.q[j]; *(LAS u32x4*)(lds + OFF_K + row * QST + cp * 16) = R.k[j];
        const int hr = pi >> 3, hc = pi & 7; *(LAS u32x4*)(lds + OFF_KH + hr * HST + hc * 16) = R.h[j]; }
    { const int row = tid >> 3, cp = tid & 7; *(LAS u32x4*)(lds + OFF_V + row * VST + cp * 16) = R.v; }
}
__device__ __forceinline__ void puts(const f32x4 (&st)[4], ldsp lds, int buf, int w, int fr, int fq) {
    ldsp s = lds + OFF_S + buf * SBYTES;
#pragma unroll
    for (int d = 0; d < 4; ++d)
#pragma unroll
        for (int i = 0; i < 4; ++i) *(LAS bf16_t*)(s + (d * 16 + fq * 4 + i) * SST + (w * 16 + fr) * 2) = f2bf(st[d][i]);
}
__device__ __forceinline__ void chunk(f32x4 (&st)[4], ldsp lds, int cur, float dec, int dir, float* og  , int w, int fr, int fq) {
    const int pbk = w >> 1, dh = w & 1;
    bf16x8 qf[4];
#pragma unroll
    for (int kk = 0; kk < 4; ++kk) qf[kk] = *(const LAS bf16x8*)(lds + OFF_Q + (pbk * 16 + fr) * QST + kk * 64 + fq * 16);
    f32x4 at[4];
#pragma unroll
    for (int sb = 0; sb < 4; ++sb) { at[sb] = (f32x4){0.f, 0.f, 0.f, 0.f};
#pragma unroll
        for (int kk = 0; kk < 4; ++kk) { const bf16x8 a = *(const LAS bf16x8*)(lds + OFF_K + (sb * 16 + fr) * QST + kk * 64 + fq * 16); at[sb] = __builtin_amdgcn_mfma_f32_16x16x32_bf16(a, qf[kk], at[sb], 0, 0, 0); }
        const int pt = pbk * 16 + fr;
#pragma unroll
        for (int i = 0; i < 4; ++i) { const int stok = sb * 16 + fq * 4 + i; const bool keep = dir ? (stok >= pt) : (stok <= pt); if (!keep) at[sb][i] = 0.f; } }
    bf16x8 pT[2];
#pragma unroll
    for (int ks = 0; ks < 2; ++ks) { union { u32x4 u; bf16x8 b; } cv;
        cv.u.x = cvt_pk_bf16(at[2 * ks][0], at[2 * ks][1]); cv.u.y = cvt_pk_bf16(at[2 * ks][2], at[2 * ks][3]); cv.u.z = cvt_pk_bf16(at[2 * ks + 1][0], at[2 * ks + 1][1]); cv.u.w = cvt_pk_bf16(at[2 * ks + 1][2], at[2 * ks + 1][3]); pT[ks] = cv.b; }
    const ldsp sb_ = lds + OFF_S + cur * SBYTES;
#pragma unroll
    for (int dd = 0; dd < 2; ++dd) { const int dvb = dh * 2 + dd; f32x4 oacc = (f32x4){0.f, 0.f, 0.f, 0.f};
#pragma unroll
        for (int ks = 0; ks < 2; ++ks) { union { u32x4 u; bf16x8 b; } av;
            const u32x2 lo = *(const LAS u32x2*)(lds + OFF_V + (dvb * 16 + fr) * VST + ((2 * ks) * 16 + fq * 4) * 2), hi = *(const LAS u32x2*)(lds + OFF_V + (dvb * 16 + fr) * VST + ((2 * ks + 1) * 16 + fq * 4) * 2);
            av.u.x = lo.x; av.u.y = lo.y; av.u.z = hi.x; av.u.w = hi.y;
            oacc = __builtin_amdgcn_mfma_f32_16x16x32_bf16(av.b, pT[ks], oacc, 0, 0, 0); }
#pragma unroll
        for (int kk = 0; kk < 4; ++kk) { const bf16x8 a = *(const LAS bf16x8*)(sb_ + (dvb * 16 + fr) * SST + kk * 64 + fq * 16); oacc = __builtin_amdgcn_mfma_f32_16x16x32_bf16(a, qf[kk], oacc, 0, 0, 0); }
        *(f32x4*)(og + (size_t)(pbk * 16 + fr) * 1024 + dvb * 16 + fq * 4) = oacc; }
    bf16x8 hb[2];
#pragma unroll
    for (int ks = 0; ks < 2; ++ks) hb[ks] = *(const LAS bf16x8*)(lds + OFF_KH + (w * 16 + fr) * HST + ks * 64 + fq * 16);
#pragma unroll
    for (int d = 0; d < 4; ++d) { st[d] = st[d] * dec;
#pragma unroll
        for (int ks = 0; ks < 2; ++ks) { const bf16x8 a = *(const LAS bf16x8*)(lds + OFF_V + (d * 16 + fr) * VST + ks * 64 + fq * 16); st[d] = __builtin_amdgcn_mfma_f32_16x16x32_bf16(a, hb[ks], st[d], 0, 0, 0); } }
    puts(st, lds, cur ^ 1, w, fr, fq);
}
}
__device__ __forceinline__ void gla_item(const Ctx& C, const int tid, int row0, int nchunk  , int h, int dir, int dvs, const float* s0, float* sout) {
    ldsp lds = C.lds; const int lane = tid & 63, w = C.wave, fr = lane & 15, fq = lane >> 4;
    const bf16_t* QG = WSP(bf16_t, WS_QG + (size_t)dir * SZ_G1); const bf16_t* KG = WSP(bf16_t, WS_KG + (size_t)dir * SZ_G1); const bf16_t* KHT = WSP(bf16_t, WS_KHT + (size_t)dir * SZ_G1);
    const bf16_t* VT = WSP(bf16_t, WS_VT) + (size_t)(h * 256 + dvs * 64) * MROWS; const float* DEC = WSP(float, WS_DEC) + (size_t)dir * 512 + h * 128 + w * 16 + fr;
    float* OG = WSP(float, WS_OG + (size_t)dir * SZ_OG1) + h * 256 + dvs * 64;
    f32x4 st[4];
#pragma unroll
    for (int d = 0; d < 4; ++d) st[d] = s0 ? *(const f32x4*)(s0 + (size_t)(w * 16 + fr) * 256 + dvs * 64 + d * 16 + fq * 4) : (f32x4){0.f, 0.f, 0.f, 0.f};
    const int c_first = dir ? nchunk - 1 : 0, c_step = dir ? -1 : 1;
#define GLA_ROW(n) ((size_t)row0 + (size_t)(c_first + (n) * c_step) * 64)
    gla::Regs RA, RB;
    gla::load(RA, QG, KG, KHT, VT, DEC, GLA_ROW(0), h, tid); gla::store(RA, lds, tid); float dec_cur = RA.dec;
    gla::load(RA, QG, KG, KHT, VT, DEC, GLA_ROW(1), h, tid);
    if (nchunk > 2) gla::load(RB, QG, KG, KHT, VT, DEC, GLA_ROW(2), h, tid);
    gla::puts(st, lds, 0, w, fr, fq);
    __syncthreads();
    for (int n = 0; n < nchunk; n += 2) {
        gla::chunk(st, lds, 0, dec_cur, dir, OG + GLA_ROW(n) * 1024, w, fr, fq);
        __syncthreads();
        gla::store(RA, lds, tid); dec_cur = RA.dec;
        if (n + 3 < nchunk) gla::load(RA, QG, KG, KHT, VT, DEC, GLA_ROW(n + 3), h, tid);
        __syncthreads();
        gla::chunk(st, lds, 1, dec_cur, dir, OG + GLA_ROW(n + 1) * 1024, w, fr, fq);
        __syncthreads();
        if (n + 2 < nchunk) { gla::store(RB, lds, tid); dec_cur = RB.dec;
            if (n + 4 < nchunk) gla::load(RB, QG, KG, KHT, VT, DEC, GLA_ROW(n + 4), h, tid); }
        __syncthreads();
    }
#undef GLA_ROW
    if (sout) {
#pragma unroll
        for (int d = 0; d < 4; ++d) *(f32x4*)(sout + (size_t)(w * 16 + fr) * 256 + dvs * 64 + d * 16 + fq * 4) = st[d]; }
}

#ifdef MIX_ONLY
#define MIXEN(k) ((k) == MIX_ONLY)
#else
#define MIXEN(k) true
#endif
__device__ __forceinline__ void phase_mixer(const Ctx& C, const int rep, const int mask, const int variant) {
    const int w = C.wave, l = C.l;
    unsigned* head = WSP(unsigned, WS_CTL) + CW_QUEUE + 64 * (l + 2 * rep);
    volatile LAS int* slot = (volatile LAS int*)(C.lds + LDS_MISC + 16);
    constexpr int N_GS = 64, N_MS = 128, N_SS = 256, N_GP = 512, N_MP = 128, N_SP = 256, NTOT = N_GS + N_MS + N_SS + N_GP + N_MP + N_SP;
    const bf16_t* QM = WSP(bf16_t, WS_QM); const bf16_t* KM = WSP(bf16_t, WS_KM); const bf16_t* VMT = WSP(bf16_t, WS_VMT); bf16_t* OMLA = WSP(bf16_t, WS_OMLA);
    const bf16_t* QS = WSP(bf16_t, WS_QS); const bf16_t* KS = WSP(bf16_t, WS_KS); const bf16_t* VT = WSP(bf16_t, WS_VT); const bf16_t* VSCT = WSP(bf16_t, WS_VSCT); bf16_t* OSWA = WSP(bf16_t, WS_OSWA);
    for (;;) {
        __syncthreads();
        if (C.tid == 0) *slot = (int)__hip_atomic_fetch_add(head, 1u, __ATOMIC_RELAXED, __HIP_MEMORY_SCOPE_AGENT);
        __syncthreads();
        int it = *slot;
        if (it >= NTOT) break;
        int tid = C.tid; asm volatile("" : "+v"(tid));
        if (it < N_MS + N_GS) it = (it < N_MS) ? it + N_GS : it - N_MS;
        if (it < N_GS) {
            const int b = it >> 5, h = (it >> 3) & 3, dir = (it >> 2) & 1, dvs = it & 3;
            if (MIXEN(0) && (mask & 1)) gla_item(C, tid, MPROMPT + b * 2048, 32, h, dir, dvs, C.in[6] + ((((size_t)(b * 2 + l) * 2 + dir) * 4 + h) * 128) * 256, nullptr);
            continue; }
        it -= N_GS;
        if (it < N_MS) {
            const int b = it >> 6, h = (it >> 3) & 7, qt = it & 7; const int rq = MPROMPT + b * 2048 + qt * 256 + w * 32;
            AttnSeg a0{KM + (size_t)(MPROMPT + b * 2048) * 1536 + h * 192, VMT + (size_t)(h * 128) * MKV + MPROMPT + b * 2048, 1536, MKV, 2048, 0};
            AttnSeg a1{KM + (size_t)(MROWS + b * 256) * 1536 + h * 192, VMT + (size_t)(h * 128) * MKV + MROWS + b * 256, 1536, MKV, 256, 0};
            if (MIXEN(1) && (mask & 2)) attn_item<192, 128>(C.lds, tid, QM + (size_t)rq * 1536 + h * 192, 1536, 0, a0, a1, false, -1e30f, 0.f, (rep ? WSP(bf16_t, WS_ACT) : OMLA) + (size_t)rq * 1024 + h * 128, 1024, rep ? variant : 0);
            continue; }
        it -= N_MS;
        if (it < N_SS) {
            const int b = it >> 7, kvh = (it >> 5) & 3, qt = it & 31; const int g = w >> 1, t0 = qt * 64, tq0 = t0 + (w & 1) * 32; const int rq = MPROMPT + b * 2048 + tq0, hd = kvh * 4 + g;
            const int tlo = (qt - 2 < 0 ? 0 : qt - 2), thi = (qt + 2 > 31 ? 31 : qt + 2);
            AttnSeg a0{KS + (size_t)(MPROMPT + b * 2048 + tlo * 64) * 256 + kvh * 64, VT + (size_t)(1024 + kvh * 64) * MROWS + MPROMPT + b * 2048 + tlo * 64, 256, MROWS, (thi - tlo + 1) * 64, tlo * 64};
            AttnSeg a1{KS + (size_t)(MROWS + b * 256) * 256 + kvh * 64, VSCT + ((size_t)b * 256 + kvh * 64) * 256, 256, 256, 256, 0};
            if (MIXEN(2) && (mask & 4)) attn_item<64, 64>(C.lds, tid, QS + (size_t)rq * 1024 + hd * 64, 1024, tq0, a0, a1, true, LIN(32, 16)[hd] * LOG2E, 1.0f, OSWA + (size_t)rq * 1024 + hd * 64, 1024);
            continue; }
        it -= N_SS;
        if (it < N_GP) {
            const int b = it >> 5, h = (it >> 3) & 3, dir = (it >> 2) & 1, dvs = it & 3;
            if (MIXEN(0) && (mask & 1)) gla_item(C, tid, b * 256, 4, h, dir, dvs, nullptr, C.out + O_SG + ((((size_t)(b * 2 + l) * 2 + dir) * 4 + h) * 128) * 256);
            continue; }
        it -= N_GP;
        if (it < N_MP) {
            const int b = it >> 3, h = it & 7; const int rq = b * 256 + w * 32;
            AttnSeg a0{KM + (size_t)(b * 256) * 1536 + h * 192, VMT + (size_t)(h * 128) * MKV + b * 256, 1536, MKV, 256, 0};
            AttnSeg a1{KM, VMT, 1536, MKV, 0, 0};
            if (MIXEN(1) && (mask & 2)) attn_item<192, 128>(C.lds, tid, QM + (size_t)rq * 1536 + h * 192, 1536, 0, a0, a1, false, -1e30f, 0.f, OMLA + (size_t)rq * 1024 + h * 128, 1024);
            continue; }
        it -= N_MP;
        {
            const int b = it >> 4, kvh = (it >> 2) & 3, qt = it & 3; const int g = w >> 1, tq0 = qt * 64 + (w & 1) * 32; const int rq = b * 256 + tq0, hd = kvh * 4 + g;
            AttnSeg a0{KS + (size_t)(b * 256) * 256 + kvh * 64, VT + (size_t)(1024 + kvh * 64) * MROWS + b * 256, 256, MROWS, 256, 0};
            AttnSeg a1{KS, VT, 256, MROWS, 0, 0};
            if (MIXEN(2) && (mask & 4)) attn_item<64, 64>(C.lds, tid, QS + (size_t)rq * 1024 + hd * 64, 1024, tq0, a0, a1, false, LIN(32, 16)[hd] * LOG2E, 1.0f, OSWA + (size_t)rq * 1024 + hd * 64, 1024);
        }
    }
}
#define MK_PER_PHASE 0

#ifndef PREP_REP_MODE
#define PREP_REP_MODE 0
#endif
#ifndef MK_PER_PHASE
#define MK_PER_PHASE 0
#endif
constexpr int NPH = 16;
struct Args { const float* in[37]; float* out; unsigned char* ws; int ph_lo, ph_hi; };

__global__ void __launch_bounds__(NTHR, 2) fwd_kernel(Args a) {
    extern __shared__ __attribute__((aligned(16))) unsigned char lds_raw[];
    Ctx C{a.in, a.out, a.ws, (ldsp)lds_raw, 0, 0, 0, 0, 0, 0};
    C.tid = threadIdx.x; C.lane = C.tid & 63; C.wave = __builtin_amdgcn_readfirstlane(C.tid >> 6); C.G = gridDim.x; C.bid = blockIdx.x; C.l = 0;
    if (C.tid < 16) ((LAS unsigned*)(C.lds + LDS_MISC))[C.tid] = 0u;
    __syncthreads();
    unsigned* ctl = (unsigned*)(a.ws + WS_CTL);
    XcdBarrier bar = xcd_barrier_post(ctl + CW_BAR, (volatile LAS unsigned*)(C.lds + LDS_MISC));
    const int lo = a.ph_lo, hi = a.ph_hi;
#define SITE(L) Ctx L = C; { int t_ = C.tid; asm volatile("" : "+v"(t_)); L.tid = t_; L.lane = t_ & 63; L.wave = __builtin_amdgcn_readfirstlane(t_ >> 6); }
    bf16_t* H = WSP(bf16_t, WS_H); bf16_t* ACT = WSP(bf16_t, WS_ACT); bf16_t* IN = WSP(bf16_t, WS_IN);
    for (int l = 0; l < 2; ++l) {
        C.l = l;
        const float* modl = WSP(float, WS_MOD) + (size_t)l * 3 * NMOD; const size_t wl = (size_t)l * SZ_WLAYER;
#ifdef ONLY_SITE
#define EN(s) ((s) == ONLY_SITE)
#else
#define EN(s) true
#endif
#define PH(k) (lo <= l * NPH + (k) && l * NPH + (k) < hi)
#define SEAM(k) do { if (PH(k) && (l * NPH + (k) + 1 < hi)) xcd_barrier(bar); } while (0)
#ifdef REPEAT_SITE
#define REPBEGIN(s) for (int rep = 0; rep < ((s) == REPEAT_SITE ? 2 : 1); ++rep) { if (rep) xcd_barrier(bar);
#define REPEND }
#else
#define REPBEGIN(s) { const int rep = 0; (void)rep;
#define REPEND }
#endif
        REPBEGIN(0) if (EN(0) && PH(0) && l == 0) { SITE(L); phase_prep(L); };
        REPEND if (l == 0) SEAM(0);
        for (int f = 0; f < 2; ++f) {
            const int kb = f ? 13 : 1;
            REPBEGIN(1) if (EN(1) && PH(kb)) { SITE(L); phase_norm(L, f ? 13 : 11, f ? 2 : 0, l == 0 && f == 0); }
            REPEND SEAM(kb);
            REPBEGIN(2) if (EN(2) && PH(kb + 1)) { pg8::MultiOrder<false> S{H, H, H, WSP(bf16_t, (f ? WS_WGU2 : WS_WGU1) + wl), nullptr, nullptr, MROWS / 256, NGU / 256, 0, 0, 0, 0, 1, C.G, C.bid}; pg8::EpiSwiglu E{ACT, DFF, rep};
                pg8::gemm_phase<pg8::EpiSwiglu, pg8::MultiOrder<false>, true, true>(C.lds, 2048, S, E);
                { const int ci = 2 * l + f; if (rep == 0 && ci < 3) { SITE(L); conv_queue(L, (ci + 1) >> 1, ci == 1 ? 0 : 1, 8 + ci, 1 << 30); } } }
            REPEND SEAM(kb + 1);
            REPBEGIN(3) if (EN(3) && PH(kb + 2)) { pg8::MultiOrder<false> S{ACT, ACT, ACT, WSP(bf16_t, (f ? WS_WD2 : WS_WD1) + wl), nullptr, nullptr, MROWS / 256, 2048 / 256, 0, 0, 0, 0, 1, C.G, C.bid}; const bool first = (l == 0 && f == 0 && rep == 0); pg8::EpiResid E{C.out, first ? a.in[0] : C.out, first ? a.in[1] - (size_t)MPROMPT * D : C.out, modl, f ? 8 : 2, rep ? 0.f : 0.5f};
                pg8::gemm_phase<pg8::EpiResid, pg8::MultiOrder<false>, true, true>(C.lds, DFF, S, E); }
            REPEND SEAM(kb + 2);
            if (f == 1) break;
#if defined(REPEAT_SITE) && REPEAT_SITE == 20
            for (int xb = 0; xb < 10; ++xb) xcd_barrier(bar);
#endif
            REPBEGIN(4) if (EN(4) && PH(4)) { SITE(L); phase_norm(L, 12, 1, false); }
            REPEND SEAM(4);
            REPBEGIN(5) if (EN(5) && PH(5)) {
                pg8::MultiOrder<false> S{H, WSP(bf16_t, WS_WINS + wl), nullptr, WSP(bf16_t, WS_WIN + wl), H, nullptr, MROWS / 256, C_GATE / 256, NSW / 256, MROWS / 256, 0, 0, 2, C.G, C.bid};
                pg8::EpiIn E{IN, WSP(float, WS_INF), WSP(bf16_t, WS_VT), rep};
                pg8::gemm_phase<pg8::EpiIn, pg8::MultiOrder<false>, true, true>(C.lds, 2048, S, E); }
            REPEND SEAM(5);
            REPBEGIN(6) if (EN(6) && PH(6)) { SITE(L); phase_prepa(L, rep ? PREP_REP_MODE : 7); };
            REPEND SEAM(6);
            REPBEGIN(7) if (EN(7) && PH(7)) {
                pg8::MultiOrder<false> S{WSP(bf16_t, WS_CQN), WSP(bf16_t, WS_CKVN), WSP(bf16_t, WS_WUV + wl), WSP(bf16_t, WS_WUQ + wl), WSP(bf16_t, WS_WUK + wl), WSP(bf16_t, WS_CKVN),
                                         MROWS / 256, 1536 / 256, MKV / 256, 1024 / 256, 1024 / 256, MKV / 256, 3, C.G, C.bid};
                pg8::EpiBf E{WSP(bf16_t, WS_QRAW), WSP(bf16_t, WS_KNRAW), WSP(bf16_t, WS_VMT), 1536, 1024, MKV};
                pg8::gemm_phase<pg8::EpiBf, pg8::MultiOrder<false>, true, true>(C.lds, 512, S, E); }
            REPEND SEAM(7);
            REPBEGIN(8) if (EN(8) && PH(8)) { SITE(L); phase_prepb(L); };
            REPEND SEAM(8);
            REPBEGIN(9) if (EN(9) && PH(9)) { SITE(L); phase_mixer(L, rep, rep ? (PREP_REP_MODE & 7) : 7, PREP_REP_MODE >> 4); };
            REPEND SEAM(9);
            REPBEGIN(10) if (EN(10) && PH(10)) { SITE(L); phase_post(L); };
            REPEND SEAM(10);
            REPBEGIN(11) if (EN(11) && PH(11)) {
                { const bf16_t* WG = WSP(bf16_t, WS_WIN + wl) + (size_t)C_GATE * 2048;
                  pg8::MultiOrder<true> S1{H, H, H, WG, WG + (size_t)2048 * 2048, WG + (size_t)4096 * 2048, MROWS / 256, 2048 / 256, MROWS / 256, 2048 / 256, MROWS / 256, 2048 / 256, 3, C.G, C.bid};
                  pg8::EpiGate E1{IN + C_GATE, NIN};
                  pg8::gemm_phase<pg8::EpiGate, pg8::MultiOrder<true>, true, true>(C.lds, 2048, S1, E1); }
                pg8::MultiOrder<true> S{WSP(bf16_t, WS_OMLA), WSP(bf16_t, WS_OGN), WSP(bf16_t, WS_OSWA), WSP(bf16_t, WS_WBR + wl), WSP(bf16_t, WS_WBR + SZ_WBR + wl), WSP(bf16_t, WS_WBR + 2 * SZ_WBR + wl),
                                        MROWS / 256, 2048 / 256, MROWS / 256, 2048 / 256, MROWS / 256, 2048 / 256, 3, C.G, C.bid};
                pg8::EpiBranch E{IN + C_GATE, NIN, ACT};
                pg8::gemm_phase<pg8::EpiBranch, pg8::MultiOrder<true>, true, true>(C.lds, 1024, S, E); }
            REPEND SEAM(11);
            REPBEGIN(12) if (EN(12) && PH(12)) { pg8::MultiOrder<false> S{ACT, ACT, ACT, WSP(bf16_t, WS_WOUT + wl), nullptr, nullptr, MROWS / 256, 2048 / 256, 0, 0, 0, 0, 1, C.G, C.bid}; pg8::EpiResid E{C.out, C.out, C.out, modl, 5, rep ? 0.f : 1.0f};
                pg8::gemm_phase<pg8::EpiResid, pg8::MultiOrder<false>, true, true>(C.lds, 2048, S, E); }
            REPEND SEAM(12);
        }
#undef PH
#undef EN
#undef SEAM
    }
}

extern "C" void kernel_launch(void* const* d_in, const int* in_sizes, int n_in, void* d_out, int out_size, void* d_ws, size_t ws_size, hipStream_t stream) {
    static int grid = 0;
    if (grid == 0) {
        if (n_in != 37 || out_size != (int)O_END || ws_size < WS_END) { fprintf(stderr, "kernel_launch: unexpected sizes n_in %d out %d ws %zu (need %zu)\n", n_in, out_size, ws_size, (size_t)WS_END); grid = -1; return; }
        int dev = 0, cus = 0, per_cu = 0;
        if (hipGetDevice(&dev) != hipSuccess || hipDeviceGetAttribute(&cus, hipDeviceAttributeMultiprocessorCount, dev) != hipSuccess) { grid = -1; return; }
        if (hipFuncSetAttribute((const void*)fwd_kernel, hipFuncAttributeMaxDynamicSharedMemorySize, LDS_BYTES) != hipSuccess) { fprintf(stderr, "kernel_launch: hipFuncSetAttribute failed\n"); grid = -1; return; }
        if (hipOccupancyMaxActiveBlocksPerMultiprocessor(&per_cu, (const void*)fwd_kernel, NTHR, LDS_BYTES) != hipSuccess || per_cu < 1) { fprintf(stderr, "kernel_launch: occupancy query says %d blocks per CU\n", per_cu); }
        (void)hipGetLastError();
        grid = cus;
    }
    if (grid < 0) return;
    if (hipMemsetAsync((char*)d_ws + WS_CTL, 0, SZ_CTL, stream) != hipSuccess) return;
    Args a{};
    for (int i = 0; i < 37; ++i) a.in[i] = (const float*)d_in[i];
    a.out = (float*)d_out; a.ws = (unsigned char*)d_ws;
#if MK_PER_PHASE
    for (int p = 0; p < 2 * NPH; ++p) { a.ph_lo = p; a.ph_hi = p + 1; hipLaunchKernelGGL(fwd_kernel, dim3(grid), dim3(NTHR), LDS_BYTES, stream, a); }
#else
    a.ph_lo = 0; a.ph_hi = 2 * NPH;
    hipLaunchKernelGGL(fwd_kernel, dim3(grid), dim3(NTHR), LDS_BYTES, stream, a);
#endif
    (void)in_sizes;
}
```
